# Optimizing an MI355X kernel written in HIP

```python
import math
import jax
import jax.numpy as jnp
from jax import lax
import numpy as np

D_MODEL = 2048
BATCH = 4
SEQ = 2048
DEPTH = 2

GRID_W = 64
CTX_LEN = 256
HEAD_DIM = 128
HY_WIDTH = D_MODEL // 4
HY_SHORT = 3
HY_FILTER_HIDDEN = 64
HY_POS_BANDS = 16
HY_POS_EMB = 1 + 2 * HY_POS_BANDS
HY_DECAY_TARGET = 1e-2
HY_FAST_DECAY = 0.3
HY_SLOW_DECAY = 1.5
MLA_HEADS = (D_MODEL // 2) // HEAD_DIM
MLA_NOPE = HEAD_DIM
MLA_ROPE = 64
MLA_V = HEAD_DIM
Q_LORA = 3 * D_MODEL // 8
KV_LORA = D_MODEL // 4
MLA_BLOCK = 128
MLA_SCALE = (MLA_NOPE + MLA_ROPE) ** -0.5
NA_HEADS = (D_MODEL // 4) // HEAD_DIM
NA_KH = 8
NA_KW = 16
NA_QB = 16
NA_KB = 2 * NA_KW
NA_SCALE = HEAD_DIM ** -0.5
FFN_HIDDEN = ((8 * D_MODEL + 3 * 256 - 1) // (3 * 256)) * 256
ROPE_THETA = 10000.0
RMS_EPS = 1e-6
MASK_VALUE = -1e30
IN_SPLITS = (3 * HY_WIDTH, Q_LORA, KV_LORA, MLA_ROPE, 3 * NA_HEADS * HEAD_DIM)
IN_COLS = sum(IN_SPLITS)

kernel_name = 'hybrid_hyena_mla_natten_dit_block'


def rmsnorm(x, g):
    xf = x.astype(jnp.float32)
    y = xf * lax.rsqrt(jnp.mean(xf * xf, axis=-1, keepdims=True) + RMS_EPS)
    return (y * g.astype(jnp.float32)).astype(x.dtype)


def modulate(x, g, shift, scale):
    return rmsnorm(x, g) * (1 + scale) + shift


def split_in(p):
    idx = [int(i) for i in np.cumsum(IN_SPLITS)[:-1]]
    return jnp.split(p, idx, axis=-1)


def axial_rope(n_tok):
    t = jnp.arange(n_tok)
    row = (t // GRID_W).astype(jnp.float32)
    col = (t % GRID_W).astype(jnp.float32)
    n_freq = MLA_ROPE // 4
    inv = ROPE_THETA ** (-jnp.arange(n_freq, dtype=jnp.float32) / n_freq)
    ang = jnp.concatenate([row[:, None] * inv, col[:, None] * inv], axis=-1)
    return jnp.cos(ang), jnp.sin(ang)


def apply_rope(x, cos, sin):
    half = x.shape[-1] // 2
    xf = x.astype(jnp.float32)
    x1, x2 = xf[..., :half], xf[..., half:]
    return jnp.concatenate([x1 * cos - x2 * sin, x2 * cos + x1 * sin], axis=-1).astype(x.dtype)


def short_conv(u, w, b):
    n = u.shape[1]
    up = jnp.pad(u, ((0, 0), (1, 1), (0, 0)))
    return up[:, :n] * w[0] + up[:, 1:n + 1] * w[1] + up[:, 2:] * w[2] + b


def hyena_filters(n, f_w1, f_b1, f_w2, f_b2, f_w3, f_freq):
    pos = jnp.arange(n, dtype=jnp.float32)
    t = jnp.linspace(0.0, 1.0, n, dtype=jnp.float32)
    bands = jnp.linspace(1e-4, HY_POS_BANDS - 1, HY_POS_BANDS, dtype=jnp.float32)
    ang = (2.0 * math.pi / n) * pos[:, None] * bands[None, :]
    z = jnp.concatenate([t[:, None], jnp.cos(ang), -jnp.sin(ang)], axis=-1)
    fr = f_freq.astype(jnp.float32)
    h = jnp.sin(fr * (z @ f_w1.astype(jnp.float32) + f_b1.astype(jnp.float32)))
    h = jnp.sin(fr * (h @ f_w2.astype(jnp.float32) + f_b2.astype(jnp.float32)))
    h = h @ f_w3.astype(jnp.float32)
    deltas = jnp.abs(jnp.linspace(math.log(HY_DECAY_TARGET) / HY_FAST_DECAY, math.log(HY_DECAY_TARGET) / HY_SLOW_DECAY, HY_WIDTH, dtype=jnp.float32))
    decay = jnp.exp(-t[:, None] * deltas[None, :])
    h = h.reshape(n, 2, HY_WIDTH) * decay[:, None, :]
    return h[:, 0], h[:, 1]


def hyena_mix(p, conv_w, conv_b, f_w1, f_b1, f_w2, f_b2, f_w3, f_freq, bias):
    n = p.shape[1]
    u = short_conv(p, conv_w, conv_b)
    v, x1, x2 = jnp.split(u, 3, axis=-1)
    h_fwd, h_bwd = hyena_filters(n, f_w1, f_b1, f_w2, f_b2, f_w3, f_freq)
    k_two = jnp.concatenate([h_fwd, jnp.zeros((1, HY_WIDTH), jnp.float32), h_bwd[:0:-1]], axis=0)
    zin = (x1 * v).astype(jnp.float32)
    y = jnp.fft.irfft(jnp.fft.rfft(zin, n=2 * n, axis=1) * jnp.fft.rfft(k_two, axis=0)[None], n=2 * n, axis=1)[:, :n]
    y = y + zin * bias.astype(jnp.float32)
    return (x2.astype(jnp.float32) * y).astype(p.dtype)


def mla_queries(cq, g_q, w_uq):
    b, n = cq.shape[0], cq.shape[1]
    q = (rmsnorm(cq, g_q) @ w_uq).reshape(b, n, MLA_HEADS, MLA_NOPE + MLA_ROPE)
    return q[..., :MLA_NOPE], q[..., MLA_NOPE:]


def mla_keys(ckv, g_kv, w_ukv):
    b, n = ckv.shape[0], ckv.shape[1]
    kv = (rmsnorm(ckv, g_kv) @ w_ukv).reshape(b, n, MLA_HEADS, MLA_NOPE + MLA_V)
    return kv[..., :MLA_NOPE], kv[..., MLA_NOPE:]


def mla_attend(qn, qr, kn, kr, v):
    s = jnp.einsum('bqhd,bkhd->bhqk', qn, kn) + jnp.einsum('bqhr,bkr->bhqk', qr, kr)
    p = jax.nn.softmax(s.astype(jnp.float32) * MLA_SCALE, axis=-1).astype(v.dtype)
    return jnp.einsum('bhqk,bkhd->bqhd', p, v)


def mla_latent(qn, qr, kn, kr, v):
    b, n = qn.shape[0], qn.shape[1]
    nb = n // MLA_BLOCK
    qn_b = jnp.moveaxis(qn.reshape(b, nb, MLA_BLOCK, MLA_HEADS, MLA_NOPE), 1, 0)
    qr_b = jnp.moveaxis(qr.reshape(b, nb, MLA_BLOCK, MLA_HEADS, MLA_ROPE), 1, 0)
    out = lax.map(lambda qq: mla_attend(qq[0], qq[1], kn, kr, v), (qn_b, qr_b))
    return jnp.moveaxis(out, 0, 1).reshape(b, n, MLA_HEADS * MLA_V)


def dense_attend(q, k, v, scale):
    s = jnp.einsum('bqhd,bkhd->bhqk', q, k).astype(jnp.float32) * scale
    p = jax.nn.softmax(s, axis=-1).astype(v.dtype)
    return jnp.einsum('bhqk,bkhd->bqhd', p, v)


def natten_latent(q, k, v, k_ctx, v_ctx, rpb):
    b, n_tok = q.shape[0], q.shape[1]
    rows = n_tok // GRID_W
    kh = min(NA_KH, rows)
    n_cb = GRID_W // NA_QB
    q_col = np.arange(GRID_W).reshape(n_cb, NA_QB)
    c_start = np.clip(q_col - NA_KW // 2, 0, GRID_W - NA_KW)
    k_col = np.clip(c_start[:, :1], 0, GRID_W - NA_KB) + np.arange(NA_KB)
    col_ok = (k_col[:, None, :] >= c_start[:, :, None]) & (k_col[:, None, :] < c_start[:, :, None] + NA_KW)
    col_idx = np.clip(k_col[:, None, :] - q_col[:, :, None] + NA_KW - 1, 0, 2 * NA_KW - 2)
    rpb_cols = rpb.astype(jnp.float32)[:, :, col_idx]
    qg = q.reshape(b, rows, GRID_W, NA_HEADS, HEAD_DIM)
    kg = k.reshape(b, rows, GRID_W, NA_HEADS, HEAD_DIM)
    vg = v.reshape(b, rows, GRID_W, NA_HEADS, HEAD_DIM)
    n_loc = kh * NA_KB

    def one_row(r):
        r0 = jnp.clip(r - kh // 2, 0, rows - kh)
        k_blk = lax.dynamic_slice_in_dim(kg, r0, kh, axis=1)[:, :, k_col]
        v_blk = lax.dynamic_slice_in_dim(vg, r0, kh, axis=1)[:, :, k_col]
        q_blk = lax.dynamic_index_in_dim(qg, r, axis=1, keepdims=False).reshape(b, n_cb, NA_QB, NA_HEADS, HEAD_DIM)
        s_loc = jnp.einsum('bnqhd,bknchd->bhnqkc', q_blk, k_blk).astype(jnp.float32) * NA_SCALE
        bias = jnp.take(rpb_cols, r0 + jnp.arange(kh) - r + NA_KH - 1, axis=1).transpose(0, 2, 3, 1, 4)
        s_loc = jnp.where(col_ok[:, :, None, :], s_loc + bias, MASK_VALUE)
        s_ctx = jnp.einsum('bnqhd,bchd->bhnqc', q_blk, k_ctx).astype(jnp.float32) * NA_SCALE
        s_all = jnp.concatenate([s_loc.reshape(s_loc.shape[:4] + (n_loc,)), s_ctx], axis=-1)
        p = jax.nn.softmax(s_all, axis=-1).astype(v.dtype)
        p_loc = p[..., :n_loc].reshape(s_loc.shape)
        o = jnp.einsum('bhnqkc,bknchd->bnqhd', p_loc, v_blk) + jnp.einsum('bhnqc,bchd->bnqhd', p[..., n_loc:], v_ctx)
        return o.reshape(b, GRID_W, NA_HEADS, HEAD_DIM)

    out = lax.map(one_row, jnp.arange(rows))
    return jnp.moveaxis(out, 0, 1).reshape(b, n_tok, NA_HEADS * HEAD_DIM)


def swiglu(h, w_gate, w_up, w_down):
    return (jax.nn.silu(h @ w_gate) * (h @ w_up)) @ w_down


def trunk_layer(x, ctx, c, c_ctx, w_ada, b_ada, g_attn_pre, g_attn_post, g_ffn_pre, g_ffn_post, w_in,
                hy_conv_w, hy_conv_b, hy_f_w1, hy_f_b1, hy_f_w2, hy_f_b2, hy_f_w3, hy_f_freq, hy_bias,
                mla_g_q, mla_w_uq, mla_g_kv, mla_w_ukv, na_rpb, w_out, w_ffn_gate, w_ffn_up, w_ffn_down, ctx_out):
    b, n = x.shape[0], x.shape[1]
    n_ctx = ctx.shape[1]
    mx = [m[:, None, :] for m in jnp.split(jax.nn.silu(c) @ w_ada + b_ada, 6, axis=-1)]
    mc = [m[None, None, :] for m in jnp.split(jax.nn.silu(c_ctx) @ w_ada + b_ada, 6, axis=-1)]

    hx, cqx, ckvx, krx, nax = split_in(modulate(x, g_attn_pre, mx[0], mx[1]) @ w_in)
    hc, cqc, ckvc, krc, nac = split_in(modulate(ctx, g_attn_pre, mc[0], mc[1]) @ w_in)

    cos, sin = axial_rope(n)
    qn_x, qr_x = mla_queries(cqx, mla_g_q, mla_w_uq)
    qr_x = apply_rope(qr_x, cos[:, None, :], sin[:, None, :])
    kn_x, v_x = mla_keys(ckvx, mla_g_kv, mla_w_ukv)
    kr_x = apply_rope(krx, cos, sin)
    kn_c, v_c = mla_keys(ckvc, mla_g_kv, mla_w_ukv)
    mla_x = mla_latent(qn_x, qr_x, jnp.concatenate([kn_x, kn_c], axis=1), jnp.concatenate([kr_x, krc], axis=1),
                       jnp.concatenate([v_x, v_c], axis=1))

    q_na, k_na, v_na = [t.reshape(b, n, NA_HEADS, HEAD_DIM) for t in jnp.split(nax, 3, axis=-1)]
    qc_na, kc_na, vc_na = [t.reshape(b, n_ctx, NA_HEADS, HEAD_DIM) for t in jnp.split(nac, 3, axis=-1)]
    na_x = natten_latent(q_na, k_na, v_na, kc_na, vc_na, na_rpb)

    hy_args = (hy_conv_w, hy_conv_b, hy_f_w1, hy_f_b1, hy_f_w2, hy_f_b2, hy_f_w3, hy_f_freq, hy_bias)
    hy_x = hyena_mix(hx, *hy_args)

    y = jnp.concatenate([hy_x, mla_x, na_x], axis=-1) @ w_out
    x_new = x + mx[2] * rmsnorm(y, g_attn_post)
    x_new = x_new + mx[5] * rmsnorm(swiglu(modulate(x_new, g_ffn_pre, mx[3], mx[4]), w_ffn_gate, w_ffn_up, w_ffn_down), g_ffn_post)

    if ctx_out:
        qn_c, qr_c = mla_queries(cqc, mla_g_q, mla_w_uq)
        mla_c = mla_attend(qn_c, qr_c, kn_c, krc, v_c).reshape(b, n_ctx, MLA_HEADS * MLA_V)
        na_c = dense_attend(qc_na, kc_na, vc_na, NA_SCALE).reshape(b, n_ctx, NA_HEADS * HEAD_DIM)
        hy_c = hyena_mix(hc, *hy_args)
        yc = jnp.concatenate([hy_c, mla_c, na_c], axis=-1) @ w_out
        ctx = ctx + mc[2] * rmsnorm(yc, g_attn_post)
        ctx = ctx + mc[5] * rmsnorm(swiglu(modulate(ctx, g_ffn_pre, mc[3], mc[4]), w_ffn_gate, w_ffn_up, w_ffn_down), g_ffn_post)
    return x_new, ctx


def setup_inputs(seed: int = 0) -> dict:
    key = jax.random.key(seed)
    ks = iter(jax.random.split(key, 32))
    D = D_MODEL

    def nrm(shape, scale):
        return scale * jax.random.normal(next(ks), shape, jnp.float32)

    def gain(shape):
        return 1.0 + nrm(shape, 0.05)

    return {
        'x': nrm((BATCH, SEQ, D), 1.0),
        'c': nrm((BATCH, D), 1.0),
        'ctx': nrm((BATCH, CTX_LEN, D), 1.0),
        'c_ctx': nrm((D,), 1.0),
        'w_ada': nrm((DEPTH, D, 6 * D), 0.5 * D ** -0.5),
        'b_ada': nrm((DEPTH, 6 * D), 0.01),
        'g_attn_pre': gain((DEPTH, D)),
        'g_attn_post': gain((DEPTH, D)),
        'g_ffn_pre': gain((DEPTH, D)),
        'g_ffn_post': gain((DEPTH, D)),
        'w_in': nrm((DEPTH, D, IN_COLS), D ** -0.5),
        'hy_conv_w': nrm((DEPTH, HY_SHORT, 3 * HY_WIDTH), HY_SHORT ** -0.5),
        'hy_conv_b': nrm((DEPTH, 3 * HY_WIDTH), 0.01),
        'hy_f_w1': nrm((DEPTH, HY_POS_EMB, HY_FILTER_HIDDEN), HY_POS_EMB ** -0.5),
        'hy_f_b1': nrm((DEPTH, HY_FILTER_HIDDEN), 0.1),
        'hy_f_w2': nrm((DEPTH, HY_FILTER_HIDDEN, HY_FILTER_HIDDEN), HY_FILTER_HIDDEN ** -0.5),
        'hy_f_b2': nrm((DEPTH, HY_FILTER_HIDDEN), 0.1),
        'hy_f_w3': nrm((DEPTH, HY_FILTER_HIDDEN, 2 * HY_WIDTH), 0.02),
        'hy_f_freq': gain((DEPTH, HY_FILTER_HIDDEN)),
        'hy_bias': nrm((DEPTH, HY_WIDTH), 0.5),
        'mla_g_q': gain((DEPTH, Q_LORA)),
        'mla_w_uq': nrm((DEPTH, Q_LORA, MLA_HEADS * (MLA_NOPE + MLA_ROPE)), Q_LORA ** -0.5),
        'mla_g_kv': gain((DEPTH, KV_LORA)),
        'mla_w_ukv': nrm((DEPTH, KV_LORA, MLA_HEADS * (MLA_NOPE + MLA_V)), KV_LORA ** -0.5),
        'na_rpb': nrm((DEPTH, NA_HEADS, 2 * NA_KH - 1, 2 * NA_KW - 1), 0.1),
        'w_out': nrm((DEPTH, D, D), D ** -0.5),
        'w_ffn_gate': nrm((DEPTH, D, FFN_HIDDEN), D ** -0.5),
        'w_ffn_up': nrm((DEPTH, D, FFN_HIDDEN), D ** -0.5),
        'w_ffn_down': nrm((DEPTH, FFN_HIDDEN, D), FFN_HIDDEN ** -0.5),
    }


def reference(x, c, ctx, c_ctx, w_ada, b_ada, g_attn_pre, g_attn_post, g_ffn_pre, g_ffn_post, w_in,
              hy_conv_w, hy_conv_b, hy_f_w1, hy_f_b1, hy_f_w2, hy_f_b2, hy_f_w3, hy_f_freq, hy_bias,
              mla_g_q, mla_w_uq, mla_g_kv, mla_w_ukv, na_rpb, w_out, w_ffn_gate, w_ffn_up, w_ffn_down):
    for l in range(DEPTH):
        x, ctx = trunk_layer(x, ctx, c, c_ctx, w_ada[l], b_ada[l], g_attn_pre[l], g_attn_post[l], g_ffn_pre[l], g_ffn_post[l],
                             w_in[l], hy_conv_w[l], hy_conv_b[l], hy_f_w1[l], hy_f_b1[l], hy_f_w2[l], hy_f_b2[l], hy_f_w3[l],
                             hy_f_freq[l], hy_bias[l], mla_g_q[l], mla_w_uq[l], mla_g_kv[l], mla_w_ukv[l], na_rpb[l],
                             w_out[l], w_ffn_gate[l], w_ffn_up[l], w_ffn_down[l], l < DEPTH - 1)
    return x
```

```cpp
#include <hip/hip_runtime.h>
#include <hip/hip_cooperative_groups.h>
#include <cstdio>
#include <cstdint>
namespace cg = cooperative_groups;

#define LAS __attribute__((address_space(3)))
typedef unsigned short bf16_t;
typedef short bf16x8 __attribute__((ext_vector_type(8)));
typedef short s16x4 __attribute__((ext_vector_type(4)));
typedef float f32x4 __attribute__((ext_vector_type(4)));
typedef float f32x2 __attribute__((ext_vector_type(2)));
typedef float f32x16 __attribute__((ext_vector_type(16)));
typedef unsigned u32x4 __attribute__((ext_vector_type(4)));
typedef unsigned u32x2 __attribute__((ext_vector_type(2)));

constexpr int DM = 2048, NBATCH = 4, SEQ = 2048, CTXL = 256, NLAT = NBATCH * SEQ, NCTX = NBATCH * CTXL, TOK = NLAT + NCTX;
constexpr int INC = 4416, HYW = 512, QLORA = 768, KVLORA = 512, FF = 5632, ADA = 6 * DM;
constexpr int PRW = 3072;
constexpr int PR_KR = 1280, PR_NAQ = 1344, PR_NAK = 1856, PR_NAV = 2368;
constexpr float RMS_EPS = 1e-6f;
constexpr float MLA_SCALE = 0.07216878364870322f;
constexpr float NA_SCALE = 0.08838834764831845f;

constexpr size_t MiB = 1u << 20;
constexpr size_t WL_STRIDE = 98 * MiB;
constexpr size_t W_INR = 0, W_INH = 12 * MiB, W_UQ = 18 * MiB, W_UKV = 21 * MiB, W_OUT = 23 * MiB, W_GU = 31 * MiB, W_DN = 75 * MiB;
constexpr size_t A_H = 196 * MiB, A_YC = 232 * MiB, A_YF = 268 * MiB, A_XR = 340 * MiB, A_PR = 412 * MiB, A_PT = 466 * MiB, A_Q = 493 * MiB, A_KV = 520 * MiB, A_ACT = 412 * MiB;
constexpr size_t S_MOD = 556 * MiB, S_ROPE = 557 * MiB, S_SSQ = 558 * MiB, S_SSQY = 559 * MiB, S_FILT = 561 * MiB, S_FILTC = 578 * MiB, WS_NEED = 580 * MiB;
constexpr int FLEN = 2 * SEQ + 64, FLENC = 2 * CTXL + 64;

constexpr int LDS_BYTES = 147456;
#ifndef PHMASK
#define PHMASK 0xFFFFFFFFu
#endif
#define PH(n) ((PHMASK >> (n)) & 1u)

__device__ __forceinline__ unsigned cvt_pk_bf16(float lo, float hi) { unsigned r; asm volatile("v_cvt_pk_bf16_f32 %0, %1, %2" : "=v"(r) : "v"(lo), "v"(hi)); return r; }
__device__ __forceinline__ bf16_t f2bf(float f) { return (bf16_t)(cvt_pk_bf16(f, 0.f) & 0xffffu); }
__device__ __forceinline__ float bf2f(bf16_t h) { return __uint_as_float(((unsigned)h) << 16); }
__device__ __forceinline__ float wave_sum(float v) {
#pragma unroll
    for (int o = 1; o < 64; o <<= 1) v += __shfl_xor(v, o);
    return v;
}

namespace pg8 {
constexpr int BM = 256, BK = 64, HALF = 128, HTB = HALF * BK * 2, STAGE_BYTES = 8 * HTB, NXCD = 8, WGM = 8;
__host__ __device__ __forceinline__ int lds_byte(int r, int c) { const int st = (r >> 4) * 2 + (c >> 5), rr = r & 15, cc = c & 31, ob = rr * 64 + cc * 2; return st * 1024 + (ob ^ (((ob >> 9) & 1) << 5)); }
__host__ __device__ __forceinline__ void stage_rc(int b, int& R, int& C) { const int st = b / 1024, sb = b % 1024, swz = sb ^ (((sb >> 9) & 1) << 5); R = (st >> 1) * 16 + swz / 64; C = (st & 1) * 32 + (swz % 64) / 2; }
__host__ __device__ __forceinline__ int perm32(int rho) { const int n = rho >> 4, i = rho & 15; return 8 * (i >> 2) + 4 * n + (i & 3); }

struct Unit { int pm, pn; };
struct Gemm { const bf16_t* A; const bf16_t* Bt; int M, N, K, lda; };

struct StaticOrder {
    int nM, nN, nwg, G, c;
    __host__ __device__ void init(int M, int N, int G_, int c_) { nM = M / BM; nN = N / BM; nwg = nM * nN; G = G_; c = c_; }
    __host__ __device__ bool next(int i, Unit& u) const {
        const long L = (long)i * G + c; if (L >= nwg) return false;
        int wgid = (int)L; { const int q = nwg / NXCD, r = nwg % NXCD, xcd = wgid % NXCD, off = wgid / NXCD; wgid = (xcd < r ? xcd * (q + 1) : r * (q + 1) + (xcd - r) * q) + off; }
        const int nig = WGM * nN, gid = wgid / nig, fm = gid * WGM, gsz = (nM - fm) < WGM ? (nM - fm) : WGM;
        u.pm = fm + ((wgid % nig) % gsz); u.pn = (wgid % nig) / gsz; return true;
    }
};

template <class Epi>
__device__ __forceinline__ void gemm_phase(LAS unsigned char* lds, const Gemm g, const StaticOrder& S, const Epi& E) {
    int tid = threadIdx.x; asm volatile("" : "+v"(tid));
    const int wid = __builtin_amdgcn_readfirstlane(tid >> 6), lane = tid & 63, wr = wid >> 2, wc = wid & 3, fr = lane & 15, fq = lane >> 4;
    const int K = g.K, nt = K / BK;
    unsigned voffA[2], voffB[2];
#pragma unroll
    for (int i = 0; i < 2; ++i) { int R, C; stage_rc(tid * 16 + i * 8192, R, C); const int Rb = Epi::PERM ? ((R & ~31) + perm32(R & 31)) : R;
        voffA[i] = (unsigned)(R * g.lda + C) * 2u; voffB[i] = (unsigned)(Rb * K + C) * 2u; }
    const size_t kstep = (size_t)(BK * 2);
    const size_t hstepA = (size_t)HALF * g.lda * 2, hstepB = (size_t)HALF * K * 2;
    const size_t tstepA = 2 * hstepA, tstepB = 2 * hstepB;
    const unsigned ldsw = (unsigned)wid * 1024u;
    const int aoff = lds_byte(wr * 64 + fr, fq * 8), boff = lds_byte(wc * 32 + fr, fq * 8);
#define PG8_SA(b, h) (((b) * 2 + (h)) * HTB)
#define PG8_SB(b, h) ((4 + (b) * 2 + (h)) * HTB)
#define PG8_STAGE(bufoff, gbase, voff) do { _Pragma("unroll") for (int _i = 0; _i < 2; ++_i) \
        __builtin_amdgcn_global_load_lds((const unsigned*)((const char*)(gbase) + (voff)[_i]), (LAS unsigned*)(lds + (bufoff) + ldsw + _i * 8192), 16, 0, 0); } while (0)
#define PG8_LDA(dst, b, h) do { _Pragma("unroll") for (int m = 0; m < 4; ++m) _Pragma("unroll") for (int k = 0; k < 2; ++k) dst[m][k] = *(const LAS bf16x8*)(lds + PG8_SA(b, h) + aoff + m * 2048 + k * 1024); } while (0)
#define PG8_LDB(dst, b, h) do { _Pragma("unroll") for (int n = 0; n < 2; ++n) _Pragma("unroll") for (int k = 0; k < 2; ++k) dst[n][k] = *(const LAS bf16x8*)(lds + PG8_SB(b, h) + boff + n * 2048 + k * 1024); } while (0)
#define PG8_MMA(ai, bj, At, Bt) do { __builtin_amdgcn_s_setprio(1); _Pragma("unroll") for (int m = 0; m < 4; ++m) _Pragma("unroll") for (int n = 0; n < 2; ++n) _Pragma("unroll") for (int k = 0; k < 2; ++k) \
        acc[ai][bj][m][n] = __builtin_amdgcn_mfma_f32_16x16x32_bf16(Bt[n][k], At[m][k], acc[ai][bj][m][n], 0, 0, 0); __builtin_amdgcn_s_setprio(0); } while (0)
#define PG8_WAIT_V(n) asm volatile("s_waitcnt vmcnt(" #n ")" ::: "memory")
#define PG8_WAIT_L(n) asm volatile("s_waitcnt lgkmcnt(" #n ")" ::: "memory")
#define PG8_BAR __builtin_amdgcn_s_barrier()
#define PG8_SCHED __builtin_amdgcn_sched_barrier(0)
    Unit cur, nxt; int ui = 0;
    if (!S.next(0, cur)) return;
    f32x4 acc[2][2][4][2];
#pragma unroll
    for (int a = 0; a < 2; ++a)
#pragma unroll
        for (int b = 0; b < 2; ++b)
#pragma unroll
            for (int m = 0; m < 4; ++m)
#pragma unroll
                for (int n = 0; n < 2; ++n) acc[a][b][m][n] = (f32x4){0.f, 0.f, 0.f, 0.f};
    bf16x8 At[4][2], B0[2][2], B1[2][2];
    const char* cA = (const char*)g.A + (size_t)cur.pm * tstepA; const char* cB = (const char*)g.Bt + (size_t)cur.pn * tstepB;
    PG8_STAGE(PG8_SB(0, 0), cB, voffB); PG8_STAGE(PG8_SB(0, 1), cB + hstepB, voffB); PG8_STAGE(PG8_SA(0, 0), cA, voffA); PG8_STAGE(PG8_SA(0, 1), cA + hstepA, voffA);
    if (wr == 1) PG8_BAR;
    PG8_WAIT_V(2); PG8_BAR;
    PG8_STAGE(PG8_SB(1, 0), cB + kstep, voffB); PG8_STAGE(PG8_SA(1, 0), cA + kstep, voffA); PG8_STAGE(PG8_SB(1, 1), cB + hstepB + kstep, voffB);
    PG8_WAIT_V(6); PG8_BAR;
    for (;;) {
        const bool has_next = S.next(ui + 1, nxt);
        const char* nA = has_next ? (const char*)g.A + (size_t)nxt.pm * tstepA : cA; const char* nB = has_next ? (const char*)g.Bt + (size_t)nxt.pn * tstepB : cB;
        for (int t = 0; t < nt; t += 2) {
            const bool last = (t == nt - 2);
            const char* a1 = cA + (size_t)(t + 1) * kstep;
            const char* a2 = last ? nA : cA + (size_t)(t + 2) * kstep; const char* b2 = last ? nB : cB + (size_t)(t + 2) * kstep;
            const char* a3 = a2 + kstep; const char* b3 = b2 + kstep;
            PG8_LDB(B0, 0, 0); PG8_LDB(B1, 0, 1); PG8_SCHED; PG8_LDA(At, 0, 0); PG8_STAGE(PG8_SA(1, 1), a1 + hstepA, voffA);
            PG8_WAIT_V(8); PG8_WAIT_L(0); PG8_BAR; PG8_MMA(0, 0, At, B0); PG8_MMA(0, 1, At, B1); PG8_BAR; PG8_SCHED;
            PG8_LDA(At, 0, 1); PG8_STAGE(PG8_SB(0, 0), b2, voffB); PG8_STAGE(PG8_SB(0, 1), b2 + hstepB, voffB); PG8_STAGE(PG8_SA(0, 0), a2, voffA);
            PG8_WAIT_V(8); PG8_WAIT_L(0); PG8_BAR; PG8_MMA(1, 0, At, B0); PG8_MMA(1, 1, At, B1); PG8_BAR; PG8_SCHED;
            PG8_LDB(B0, 1, 0); PG8_LDB(B1, 1, 1); PG8_SCHED; PG8_LDA(At, 1, 0); PG8_STAGE(PG8_SA(0, 1), a2 + hstepA, voffA);
            PG8_WAIT_V(8); PG8_WAIT_L(0); PG8_BAR; PG8_MMA(0, 0, At, B0); PG8_MMA(0, 1, At, B1); PG8_BAR; PG8_SCHED;
            PG8_LDA(At, 1, 1); PG8_STAGE(PG8_SB(1, 0), b3, voffB); PG8_STAGE(PG8_SB(1, 1), b3 + hstepB, voffB); PG8_STAGE(PG8_SA(1, 0), a3, voffA);
            PG8_WAIT_V(8); PG8_WAIT_L(0); PG8_BAR; PG8_MMA(1, 0, At, B0); PG8_MMA(1, 1, At, B1); PG8_BAR; PG8_SCHED;
        }
        if (wr == 0) PG8_BAR;
        E(acc, cur, wr, wc, fr, fq);
        if (!has_next) break;
#pragma unroll
        for (int a = 0; a < 2; ++a)
#pragma unroll
            for (int b = 0; b < 2; ++b)
#pragma unroll
                for (int m = 0; m < 4; ++m)
#pragma unroll
                    for (int n = 0; n < 2; ++n) acc[a][b][m][n] = (f32x4){0.f, 0.f, 0.f, 0.f};
        cur = nxt; cA = nA; cB = nB; ++ui;
        if (wr == 1) PG8_BAR;
    }
    PG8_WAIT_V(0);
    PG8_BAR;
#undef PG8_SA
#undef PG8_SB
#undef PG8_STAGE
#undef PG8_LDA
#undef PG8_LDB
#undef PG8_MMA
#undef PG8_WAIT_V
#undef PG8_WAIT_L
#undef PG8_BAR
#undef PG8_SCHED
}

__device__ __forceinline__ float dot4(f32x4 v) { return (v[0] * v[0] + v[1] * v[1]) + (v[2] * v[2] + v[3] * v[3]); }
__device__ __forceinline__ void rope4(f32x4& v, const float* rope_row, int i0) {
    const f32x4 cs = *(const f32x4*)(rope_row + 2 * i0);
    const float a0 = v[0] * cs[0] - v[1] * cs[1], b0 = v[1] * cs[0] + v[0] * cs[1];
    const float a1 = v[2] * cs[2] - v[3] * cs[3], b1 = v[3] * cs[2] + v[2] * cs[3];
    v = (f32x4){a0, b0, a1, b1};
}
__device__ __forceinline__ u32x4 pack8(f32x4 v0, f32x4 v1) { u32x4 w; w.x = cvt_pk_bf16(v0[0], v0[1]); w.y = cvt_pk_bf16(v0[2], v0[3]); w.z = cvt_pk_bf16(v1[0], v1[1]); w.w = cvt_pk_bf16(v1[2], v1[3]); return w; }

struct EpiBf16 {
    static constexpr bool PERM = true;
    bf16_t* O; int ldc;
    __device__ __forceinline__ void operator()(const f32x4 (&acc)[2][2][4][2], const Unit& u, int wr, int wc, int fr, int fq) const {
        const int row0 = u.pm * BM + wr * 64 + fr, col0 = u.pn * BM + wc * 32 + 8 * fq;
#pragma unroll
        for (int ai = 0; ai < 2; ++ai)
#pragma unroll
            for (int m = 0; m < 4; ++m) { bf16_t* rowp = O + (size_t)(row0 + ai * HALF + m * 16) * ldc + col0;
#pragma unroll
                for (int bj = 0; bj < 2; ++bj) *(u32x4*)(rowp + bj * HALF) = pack8(acc[ai][bj][m][0], acc[ai][bj][m][1]); }
    }
};
struct EpiPR {
    static constexpr bool PERM = true;
    bf16_t* O; float* ssq; const float* rope;
    __device__ __forceinline__ void operator()(const f32x4 (&acc)[2][2][4][2], const Unit& u, int wr, int wc, int fr, int fq) const {
        const int row0 = u.pm * BM + wr * 64 + fr, col0 = u.pn * BM + wc * 32 + 8 * fq;
        const bool dorope = (u.pn == 5) && (wc < 2);
#pragma unroll
        for (int ai = 0; ai < 2; ++ai)
#pragma unroll
            for (int m = 0; m < 4; ++m) { const int row = row0 + ai * HALF + m * 16; bf16_t* rowp = O + (size_t)row * PRW + col0; float ss = 0.f;
#pragma unroll
                for (int bj = 0; bj < 2; ++bj) { f32x4 v0 = acc[ai][bj][m][0], v1 = acc[ai][bj][m][1];
                    if (bj == 0 && dorope && row < NLAT) { const float* rr = rope + (size_t)(row & (SEQ - 1)) * 64; const int i0 = 16 * wc + 4 * fq; rope4(v0, rr, i0); rope4(v1, rr, i0 + 2); }
                    ss += dot4(v0) + dot4(v1);
                    *(u32x4*)(rowp + bj * HALF) = pack8(v0, v1); }
                if (u.pn < 5) { ss += __shfl_xor(ss, 16); ss += __shfl_xor(ss, 32); if (fq == 0) ssq[(size_t)row * 20 + u.pn * 4 + wc] = ss; }
                asm volatile("" ::: "memory"); }
    }
};
struct EpiQ {
    static constexpr bool PERM = true;
    bf16_t* O; const float* ssq; const float* rope;
    __device__ __forceinline__ void operator()(const f32x4 (&acc)[2][2][4][2], const Unit& u, int wr, int wc, int fr, int fq) const {
        const int row0 = u.pm * BM + wr * 64 + fr, col0 = u.pn * BM + wc * 32 + 8 * fq;
#pragma unroll
        for (int ai = 0; ai < 2; ++ai)
#pragma unroll
            for (int m = 0; m < 4; ++m) { const int row = row0 + ai * HALF + m * 16; bf16_t* rowp = O + (size_t)row * 1536 + col0;
                const f32x4* sp = (const f32x4*)(ssq + (size_t)row * 20); const f32x4 s0 = sp[0], s1 = sp[1], s2 = sp[2];
                const float tot = ((s0[0] + s0[1]) + (s0[2] + s0[3])) + ((s1[0] + s1[1]) + (s1[2] + s1[3])) + ((s2[0] + s2[1]) + (s2[2] + s2[3]));
                const float rs = 1.0f / sqrtf(tot * (1.0f / QLORA) + RMS_EPS);
#pragma unroll
                for (int bj = 0; bj < 2; ++bj) { f32x4 v0 = acc[ai][bj][m][0] * rs, v1 = acc[ai][bj][m][1] * rs;
                    const int j0 = (col0 + bj * HALF) % 192;
                    if (j0 >= 128 && row < NLAT) { const float* rr = rope + (size_t)(row & (SEQ - 1)) * 64; const int i0 = (j0 - 128) >> 1; rope4(v0, rr, i0); rope4(v1, rr, i0 + 2); }
                    *(u32x4*)(rowp + bj * HALF) = pack8(v0, v1); }
                asm volatile("" ::: "memory"); }
    }
};
struct EpiKV {
    static constexpr bool PERM = true;
    bf16_t* O; const float* ssq;
    __device__ __forceinline__ void operator()(const f32x4 (&acc)[2][2][4][2], const Unit& u, int wr, int wc, int fr, int fq) const {
        const int row0 = u.pm * BM + wr * 64 + fr, col0 = u.pn * BM + wc * 32 + 8 * fq;
#pragma unroll
        for (int ai = 0; ai < 2; ++ai)
#pragma unroll
            for (int m = 0; m < 4; ++m) { const int row = row0 + ai * HALF + m * 16; bf16_t* rowp = O + (size_t)row * 2048 + col0;
                const f32x4* sp = (const f32x4*)(ssq + (size_t)row * 20 + 12); const f32x4 s0 = sp[0], s1 = sp[1];
                const float tot = ((s0[0] + s0[1]) + (s0[2] + s0[3])) + ((s1[0] + s1[1]) + (s1[2] + s1[3]));
                const float rs = 1.0f / sqrtf(tot * (1.0f / KVLORA) + RMS_EPS);
#pragma unroll
                for (int bj = 0; bj < 2; ++bj) *(u32x4*)(rowp + bj * HALF) = pack8(acc[ai][bj][m][0] * rs, acc[ai][bj][m][1] * rs);
                asm volatile("" ::: "memory"); }
    }
};
struct EpiF32S {
    static constexpr bool PERM = false;
    float* C; float* ssq;
    __device__ __forceinline__ void operator()(const f32x4 (&acc)[2][2][4][2], const Unit& u, int wr, int wc, int fr, int fq) const {
        const int row0 = u.pm * BM + wr * 64 + fr, col0 = u.pn * BM + wc * 32 + 4 * fq;
#pragma unroll
        for (int ai = 0; ai < 2; ++ai)
#pragma unroll
            for (int m = 0; m < 4; ++m) { const int row = row0 + ai * HALF + m * 16; float* rowp = C + (size_t)row * DM + col0; float ss = 0.f;
#pragma unroll
                for (int bj = 0; bj < 2; ++bj)
#pragma unroll
                    for (int n = 0; n < 2; ++n) { const f32x4 v = acc[ai][bj][m][n]; ss += dot4(v); *(f32x4*)(rowp + bj * HALF + n * 16) = v; }
                ss += __shfl_xor(ss, 16); ss += __shfl_xor(ss, 32); if (fq == 0) ssq[(size_t)row * 32 + u.pn * 4 + wc] = ss; }
    }
};
struct EpiSwiGLU {
    static constexpr bool PERM = true;
    bf16_t* O;
    __device__ __forceinline__ void operator()(const f32x4 (&acc)[2][2][4][2], const Unit& u, int wr, int wc, int fr, int fq) const {
        const int row0 = u.pm * BM + wr * 64 + fr, col0 = u.pn * HALF + wc * 32 + 8 * fq;
#pragma unroll
        for (int ai = 0; ai < 2; ++ai)
#pragma unroll
            for (int m = 0; m < 4; ++m) { bf16_t* rowp = O + (size_t)(row0 + ai * HALF + m * 16) * FF + col0; f32x4 r[2];
#pragma unroll
                for (int n = 0; n < 2; ++n) { const f32x4 gt = acc[ai][0][m][n], up = acc[ai][1][m][n];
#pragma unroll
                    for (int e = 0; e < 4; ++e) { const float sg = __builtin_amdgcn_rcpf(1.0f + __builtin_amdgcn_exp2f(-1.4426950408889634f * gt[e])); r[n][e] = gt[e] * sg * up[e]; } }
                *(u32x4*)rowp = pack8(r[0], r[1]); }
    }
};
}

namespace att {
constexpr int NW = 8, QBLK = 32, KVBLK = 64;
#define SBAR() __builtin_amdgcn_sched_barrier(0)
__device__ __forceinline__ int crow(int r, int hi) { return (r & 3) + 8 * (r >> 2) + 4 * hi; }
__device__ __forceinline__ int v_st(int k, int c) { const int kk = (k & ~0xC) | ((k & 4) << 1) | ((k & 8) >> 1); return ((kk >> 3) * 4 + (c >> 5)) * 512 + ((kk & 7) * 32 + (c & 31)) * 2; }
__device__ __forceinline__ int v_rd_base(int lane) { return ((lane & 3) << 3) | (((lane >> 2) & 3) << 6) | (((lane >> 4) & 1) << 5) | (((lane >> 5) & 1) << 8); }
constexpr int v_rd_off(int d0, int ks, int half) { return d0 * 512 + ks * 4096 + half * 2048; }
template <int OFF> __device__ __forceinline__ s16x4 tr_read(int vb) { s16x4 r; asm volatile("ds_read_b64_tr_b16 %0, %1 offset:%2" : "=&v"(r) : "v"(vb), "i"(OFF) : "memory"); return r; }
template <int D0> __device__ __forceinline__ void pv_one(f32x16& od, int vb, bf16x8 pa0, bf16x8 pa1, bf16x8 pa2, bf16x8 pa3) {
    const s16x4 l0 = tr_read<v_rd_off(D0, 0, 0)>(vb), h0 = tr_read<v_rd_off(D0, 0, 1)>(vb), l1 = tr_read<v_rd_off(D0, 1, 0)>(vb), h1 = tr_read<v_rd_off(D0, 1, 1)>(vb);
    const s16x4 l2 = tr_read<v_rd_off(D0, 2, 0)>(vb), h2 = tr_read<v_rd_off(D0, 2, 1)>(vb), l3 = tr_read<v_rd_off(D0, 3, 0)>(vb), h3 = tr_read<v_rd_off(D0, 3, 1)>(vb);
    asm volatile("s_waitcnt lgkmcnt(0)" ::: "memory"); SBAR();
#define PKV(L, H) (bf16x8){L[0], L[1], L[2], L[3], H[0], H[1], H[2], H[3]}
    od = __builtin_amdgcn_mfma_f32_32x32x16_bf16(pa0, PKV(l0, h0), od, 0, 0, 0);
    od = __builtin_amdgcn_mfma_f32_32x32x16_bf16(pa1, PKV(l1, h1), od, 0, 0, 0);
    od = __builtin_amdgcn_mfma_f32_32x32x16_bf16(pa2, PKV(l2, h2), od, 0, 0, 0);
    od = __builtin_amdgcn_mfma_f32_32x32x16_bf16(pa3, PKV(l3, h3), od, 0, 0, 0);
#undef PKV
}
__device__ __forceinline__ void pv_d0(f32x16* o, int vb, bf16x8 pa0, bf16x8 pa1, bf16x8 pa2, bf16x8 pa3) {
    pv_one<0>(o[0], vb, pa0, pa1, pa2, pa3); pv_one<1>(o[1], vb, pa0, pa1, pa2, pa3); pv_one<2>(o[2], vb, pa0, pa1, pa2, pa3); pv_one<3>(o[3], vb, pa0, pa1, pa2, pa3);
}
__device__ __forceinline__ void partialSM(f32x16& p0, f32x16& p1, float& m_reg, float& alpha, float C, float thr) {
    float pmax = p0[0];
#pragma unroll
    for (int r = 1; r < 16; ++r) pmax = fmaxf(pmax, p0[r]);
#pragma unroll
    for (int r = 0; r < 16; ++r) pmax = fmaxf(pmax, p1[r]);
    { auto rr = __builtin_amdgcn_permlane32_swap(__float_as_uint(pmax), __float_as_uint(pmax), false, false); pmax = fmaxf(__uint_as_float(rr[0]), __uint_as_float(rr[1])); }
    float mn;
    if (__builtin_expect(__all(pmax - m_reg <= thr), 1)) { mn = m_reg; alpha = 1.f; }
    else { mn = fmaxf(m_reg, pmax); alpha = __builtin_amdgcn_exp2f((m_reg - mn) * C); m_reg = mn; }
    const float mnC = -mn * C;
#pragma unroll
    for (int r = 0; r < 16; ++r) p0[r] = fmaf(p0[r], C, mnC);
#pragma unroll
    for (int r = 0; r < 16; ++r) p1[r] = fmaf(p1[r], C, mnC);
#pragma unroll
    for (int r = 0; r < 16; ++r) p0[r] = __builtin_amdgcn_exp2f(p0[r]);
}
__device__ __forceinline__ void finishSM(f32x16& p0, f32x16& p1, float alpha, float& l_reg, bf16x8& pa0, bf16x8& pa1, bf16x8& pa2, bf16x8& pa3) {
#pragma unroll
    for (int r = 0; r < 16; ++r) p1[r] = __builtin_amdgcn_exp2f(p1[r]);
    float ps = 0;
#pragma unroll
    for (int r = 0; r < 16; ++r) ps += p0[r];
#pragma unroll
    for (int r = 0; r < 16; ++r) ps += p1[r];
    { auto rr = __builtin_amdgcn_permlane32_swap(__float_as_uint(ps), __float_as_uint(ps), false, false); ps = __uint_as_float(rr[0]) + __uint_as_float(rr[1]); }
    l_reg = l_reg * alpha + ps;
#define PK4(P, BASE, OUT) do { unsigned a0 = cvt_pk_bf16(P[BASE + 0], P[BASE + 1]), a1 = cvt_pk_bf16(P[BASE + 2], P[BASE + 3]);   \
    unsigned b0 = cvt_pk_bf16(P[BASE + 4], P[BASE + 5]), b1 = cvt_pk_bf16(P[BASE + 6], P[BASE + 7]);                              \
    auto r0 = __builtin_amdgcn_permlane32_swap(a0, b0, false, false); auto r1 = __builtin_amdgcn_permlane32_swap(a1, b1, false, false); \
    u32x4 w = {r0[0], r1[0], r0[1], r1[1]}; OUT = __builtin_bit_cast(bf16x8, w); } while (0)
    PK4(p0, 0, pa0); PK4(p0, 8, pa1); PK4(p1, 0, pa2); PK4(p1, 8, pa3);
#undef PK4
}

struct Args {
    const bf16_t* Q; int ldq;
    const bf16_t* Kn; int ldk;
    const bf16_t* Kr; int ldkr;
    const bf16_t* V; int ldv;
    bf16_t* O; int ldo;
    int nt, n1, base1, base2;
    float scale;
    int g, rlo; const float* bias;
};

template <int DQK, bool NA>
__device__ __forceinline__ void unit(const Args& a, char* lds) {
    constexpr int ND = DQK / 16, KROW = DQK * 2, SHM_V = KVBLK * 128 * 2, SHM_K = KVBLK * KROW;
#define KSWZ(row, colB) ((row) * KROW + ((colB) ^ (((row) & 7) << 4)))
    int tid = threadIdx.x; asm volatile("" : "+v"(tid));
    const int wid = tid >> 6, lane = tid & 63, r32 = lane & 31, hi = lane >> 5;
    char* V_lds = lds; char* K_lds = lds + 2 * SHM_V;
    float* ws = (float*)(lds + 2 * SHM_V + 2 * SHM_K) + wid * 64; float* li_l = ws; float* al_l = ws + 32;
    float* bt = (float*)(lds + 2 * SHM_V + 2 * SHM_K + NW * 256);
    const float C = a.scale * 1.4426950408889634f, thr = 8.0f / a.scale;
    __syncthreads();
    if (NA) { const float inv = 1.0f / a.scale; for (int i = tid; i < 15 * 32; i += 512) { const int c = i & 31; bt[i] = (c < 31) ? a.bias[(i >> 5) * 31 + c] * inv : 0.f; } }
    float m_reg = -1e30f, l_reg = 0; f32x16 o[4] = {}; bf16x8 qr[ND];
    { const bf16_t* Qw = a.Q + (size_t)(wid * QBLK + r32) * a.ldq + hi * 8;
#pragma unroll
      for (int d0 = 0; d0 < ND; ++d0) qr[d0] = *(const bf16x8*)(Qw + d0 * 16); }
    const int sr = tid >> 4, sc = (tid & 15) * 8, vst0 = v_st(sr, sc), vst1 = v_st(32 + sr, sc);
    const int krr = tid >> 3, krc = (tid & 7) * 8;
    const int vb0 = (int)(uintptr_t)V_lds + v_rd_base(lane);
    const int qidx = wid * 32 + r32, qr_row = 4 * a.g + (qidx >> 6), qc = qidx & 63;
    const int r0w = min(max(qr_row - 4, 0), 24), csw = min(max(qc - 8, 0), 48);
    bf16x8 vs0, vs1, ks0, ks1, kr0;
#define TOKOF(j) ((j) < a.n1 ? a.base1 + 64 * (j) : a.base2 + 64 * ((j) - a.n1))
#define SLOAD(j) do { const int t0_ = TOKOF(j); \
    vs0 = *(const bf16x8*)(a.V + (size_t)(t0_ + sr) * a.ldv + sc); vs1 = *(const bf16x8*)(a.V + (size_t)(t0_ + 32 + sr) * a.ldv + sc); \
    ks0 = *(const bf16x8*)(a.Kn + (size_t)(t0_ + sr) * a.ldk + sc); ks1 = *(const bf16x8*)(a.Kn + (size_t)(t0_ + 32 + sr) * a.ldk + sc); \
    if (DQK == 192) kr0 = *(const bf16x8*)(a.Kr + (size_t)(t0_ + krr) * a.ldkr + krc); } while (0)
#define SWRITE(b) do { *(bf16x8*)(V_lds + (b) * SHM_V + vst0) = vs0; *(bf16x8*)(V_lds + (b) * SHM_V + vst1) = vs1; \
    *(bf16x8*)(K_lds + (b) * SHM_K + KSWZ(sr, sc * 2)) = ks0; *(bf16x8*)(K_lds + (b) * SHM_K + KSWZ(32 + sr, sc * 2)) = ks1; \
    if (DQK == 192) *(bf16x8*)(K_lds + (b) * SHM_K + KSWZ(krr, 256 + krc * 2)) = kr0; } while (0)
#define QKT(P0, P1, b) do { P0 = f32x16{}; P1 = f32x16{}; const char* Ks_ = K_lds + (b) * SHM_K; \
    _Pragma("unroll") for (int d0 = 0; d0 < ND; ++d0) { const int cb = (d0 * 16 + hi * 8) * 2; \
      const bf16x8 b0_ = *(const bf16x8*)(Ks_ + KSWZ(r32, cb)); const bf16x8 b1_ = *(const bf16x8*)(Ks_ + KSWZ(32 + r32, cb)); \
      P0 = __builtin_amdgcn_mfma_f32_32x32x16_bf16(b0_, qr[d0], P0, 0, 0, 0); P1 = __builtin_amdgcn_mfma_f32_32x32x16_bf16(b1_, qr[d0], P1, 0, 0, 0); } } while (0)
#define MASK(P0, P1, j) do { if (NA && (j) >= a.n1) { const int rr_ = a.rlo + (j) - a.n1; const bool rowok_ = (rr_ >= r0w) && (rr_ < r0w + 8); \
      const int drow_ = min(max(rr_ - qr_row + 7, 0), 14) * 32; \
      _Pragma("unroll") for (int i = 0; i < 16; ++i) { const int kc_ = crow(i, hi); \
        { const bool ok_ = rowok_ && (kc_ >= csw) && (kc_ < csw + 16); const float bv_ = bt[drow_ + min(max(kc_ - qc + 15, 0), 30)]; P0[i] = ok_ ? P0[i] + bv_ : -INFINITY; } \
        { const int k2_ = kc_ + 32; const bool ok_ = rowok_ && (k2_ >= csw) && (k2_ < csw + 16); const float bv_ = bt[drow_ + min(max(k2_ - qc + 15, 0), 30)]; P1[i] = ok_ ? P1[i] + bv_ : -INFINITY; } } } } while (0)
#define RESC(al) do { if (__any((al) < 1.f)) { if (hi == 0) al_l[r32] = (al); asm volatile("s_waitcnt lgkmcnt(0)" ::: "memory"); \
    _Pragma("unroll") for (int d = 0; d < 4; ++d) _Pragma("unroll") for (int r = 0; r < 16; ++r) o[d][r] *= al_l[crow(r, hi)]; } } while (0)
    f32x16 p0, p1; float al; bf16x8 pa0, pa1, pa2, pa3; const int NT = a.nt;
    SLOAD(0); SWRITE(0); __syncthreads();
    for (int j = 0; j < NT; ++j) {
        const int cb_ = j & 1;
        if (j + 1 < NT) SLOAD(j + 1);
        SBAR(); QKT(p0, p1, cb_); MASK(p0, p1, j);
        partialSM(p0, p1, m_reg, al, C, thr);
        RESC(al);
        finishSM(p0, p1, al, l_reg, pa0, pa1, pa2, pa3); SBAR();
        pv_d0(o, vb0 + cb_ * SHM_V, pa0, pa1, pa2, pa3);
        if (j + 1 < NT) SWRITE(cb_ ^ 1);
        __syncthreads();
    }
    if (hi == 0) li_l[r32] = l_reg; asm volatile("s_waitcnt lgkmcnt(0)" ::: "memory");
    float rli[16];
#pragma unroll
    for (int r = 0; r < 16; ++r) rli[r] = __builtin_amdgcn_rcpf(li_l[crow(r, hi)]);
    bf16_t* Ow = a.O + (size_t)(wid * QBLK) * a.ldo;
#pragma unroll
    for (int r = 0; r < 16; ++r) { const int orow = crow(r, hi);
#pragma unroll
        for (int d0 = 0; d0 < 4; ++d0) Ow[(size_t)orow * a.ldo + d0 * 32 + r32] = f2bf(o[d0][r] * rli[r]); }
#undef KSWZ
#undef TOKOF
#undef SLOAD
#undef SWRITE
#undef QKT
#undef MASK
#undef RESC
}
#undef SBAR
}

struct Params { const float* in[29]; float* out; unsigned char* ws; };
enum { I_X = 0, I_C, I_CTX, I_CCTX, I_WADA, I_BADA, I_GAPRE, I_GAPOST, I_GFPRE, I_GFPOST, I_WIN, I_HCW, I_HCB, I_FW1, I_FB1, I_FW2, I_FB2, I_FW3, I_FFREQ, I_HBIAS,
       I_GQ, I_WUQ, I_GKV, I_WUKV, I_RPB, I_WOUT, I_WG, I_WU, I_WD };

__device__ __forceinline__ const float* INP(int i) { int j = i; asm volatile("" : "+s"(j)); return ((const float* const __attribute__((address_space(4)))*)__builtin_amdgcn_kernarg_segment_ptr())[j]; }
template <class Map>
__device__ __forceinline__ void transpose_item(const float* W, int K, int N, bf16_t* WT, const float* kscale, LAS float* scr, int item, int lane, const Map& map) {
    const int nblk = N / 32, kb = item / nblk, nb = item % nblk, k0 = 64 * kb, n0 = 32 * nb;
#pragma unroll 8
    for (int i = 0; i < 32; ++i) { const int kk = 2 * i + (lane >> 5); float v = W[(size_t)(k0 + kk) * N + n0 + (lane & 31)]; if (kscale) v *= kscale[k0 + kk]; scr[kk * 33 + (lane & 31)] = v; }
    asm volatile("s_waitcnt lgkmcnt(0)" ::: "memory");
    const int c = lane & 7;
#pragma unroll
    for (int j = 0; j < 4; ++j) { const int n = (lane >> 3) + 8 * j; const LAS float* s = scr + (8 * c) * 33 + n;
        u32x4 o; o.x = cvt_pk_bf16(s[0 * 33], s[1 * 33]); o.y = cvt_pk_bf16(s[2 * 33], s[3 * 33]); o.z = cvt_pk_bf16(s[4 * 33], s[5 * 33]); o.w = cvt_pk_bf16(s[6 * 33], s[7 * 33]);
        const int drow = map(n0 + n);
        if (drow >= 0) *(u32x4*)(WT + (size_t)drow * K + k0 + 8 * c) = o; }
    asm volatile("s_waitcnt lgkmcnt(0)" ::: "memory");
}
struct MapIdent { __device__ int operator()(int n) const { return n; } };
struct MapInH   { __device__ int operator()(int n) const { return n < 1536 ? n : -1; } };
struct MapInR   { __device__ int operator()(int n) const { if (n < 1536) return -1; const int r = n - 1536; if (r >= PR_KR && r < PR_KR + 64) { const int i = r - PR_KR; return PR_KR + (i < 32 ? 2 * i : 2 * (i - 32) + 1); } return r; } };
struct MapUQ    { __device__ int operator()(int n) const { const int h = n / 192, j = n % 192; if (j < 128) return n; const int i = j - 128; return h * 192 + 128 + (i < 32 ? 2 * i : 2 * (i - 32) + 1); } };
struct MapGate  { __device__ int operator()(int n) const { return 256 * (n >> 7) + (n & 127); } };
struct MapUp    { __device__ int operator()(int n) const { return 256 * (n >> 7) + 128 + (n & 127); } };

__global__ void __launch_bounds__(512, 2) fwd_mega(Params p) {
    extern __shared__ __attribute__((aligned(16))) unsigned char lds[];
    cg::grid_group grid = cg::this_grid();
    LAS unsigned char* ldsl = (LAS unsigned char*)lds;
    const int wave = __builtin_amdgcn_readfirstlane(threadIdx.x >> 6);
    const int G = gridDim.x, bx = blockIdx.x;
    const int vcu = (G % 8 == 0) ? (bx % 8) * (G / 8) + bx / 8 : bx;
    const int gw = vcu * 8 + wave, NGW = G * 8;
#define DECL_PTRS(L) unsigned char* ws = (unsigned char*)INP(30); asm volatile("" : "+s"(ws)); int tid = threadIdx.x; asm volatile("" : "+v"(tid)); const int lane = tid & 63; (void)lane; \
    float* MOD = (float*)(ws + S_MOD); float* ROPE = (float*)(ws + S_ROPE); float* SSQ = (float*)(ws + S_SSQ); float* SSQY = (float*)(ws + S_SSQY); \
    bf16_t* FILT = (bf16_t*)(ws + S_FILT); bf16_t* FILTC = (bf16_t*)(ws + S_FILTC); \
    bf16_t* Hb = (bf16_t*)(ws + A_H); bf16_t* YC = (bf16_t*)(ws + A_YC); float* YF = (float*)(ws + A_YF); float* XR = (float*)(ws + A_XR); \
    bf16_t* PR = (bf16_t*)(ws + A_PR); bf16_t* PT = (bf16_t*)(ws + A_PT); bf16_t* Qb = (bf16_t*)(ws + A_Q); bf16_t* KVb = (bf16_t*)(ws + A_KV); bf16_t* ACT = (bf16_t*)(ws + A_ACT); \
    unsigned char* wl = ws + (size_t)(L) * WL_STRIDE; const float* mod = MOD + (size_t)(L) * 5 * ADA; \
    (void)ROPE; (void)SSQ; (void)SSQY; (void)FILT; (void)FILTC; (void)Hb; (void)YC; (void)YF; (void)XR; (void)PR; (void)PT; (void)Qb; (void)KVb; (void)ACT; (void)wl; (void)mod;

    {
        DECL_PTRS(0)
        if (PH(14)) {
        LAS float* sS = (LAS float*)ldsl;
        LAS float* red = (LAS float*)(ldsl + 5 * 2048 * 4);
        for (int i = tid; i < 5 * DM; i += 512) { const int m = i / DM, k = i % DM; const float v = (m < 4) ? INP(I_C)[m * DM + k] : INP(I_CCTX)[k]; sS[i] = v / (1.0f + __expf(-v)); }
        __syncthreads();
        for (int item = vcu; item < 2 * (ADA / 32); item += G) {
            const int l = item / (ADA / 32), n0 = (item % (ADA / 32)) * 32;
            const float* W = INP(I_WADA) + (size_t)l * DM * ADA + n0 + (lane & 31);
            float acc[5] = {0.f, 0.f, 0.f, 0.f, 0.f};
            const int kbase = wave * 256 + (lane >> 5);
#pragma unroll 16
            for (int kk = 0; kk < 128; ++kk) { const int k = kbase + 2 * kk; const float w = W[(size_t)k * ADA];
#pragma unroll
                for (int m = 0; m < 5; ++m) acc[m] += sS[m * DM + k] * w; }
#pragma unroll
            for (int m = 0; m < 5; ++m) { acc[m] += __shfl_xor(acc[m], 32); if (lane < 32) red[(wave * 5 + m) * 32 + lane] = acc[m]; }
            __syncthreads();
            if (tid < 160) { const int m = tid >> 5, c = tid & 31; float s = 0.f;
#pragma unroll
                for (int w = 0; w < 8; ++w) s += red[(w * 5 + m) * 32 + c];
                MOD[((size_t)l * 5 + m) * ADA + n0 + c] = s + INP(I_BADA)[(size_t)l * ADA + n0 + c]; }
            __syncthreads();
        }
        }
        for (int i = bx * 512 + tid; i < SEQ * 32; i += G * 512) { const int t = i >> 5, f = i & 31; const float pos = (f < 16) ? (float)(t >> 6) : (float)(t & 63);
            const float inv = powf(10000.0f, -(float)(f & 15) / 16.0f); const float ang = pos * inv; ROPE[2 * i] = cosf(ang); ROPE[2 * i + 1] = sinf(ang); }
        for (int l = 0; l < 2; ++l) { u32x4* z = (u32x4*)(ws + l * WL_STRIDE + W_INR + (size_t)2880 * DM * 2); const int n16 = 192 * DM * 2 / 16;
            for (int i = bx * 512 + tid; i < n16; i += G * 512) z[i] = (u32x4){0u, 0u, 0u, 0u}; }
        for (int i = bx * 512 + tid; i < 2 * HYW * 2 * 128; i += G * 512) {
            const int s = i & 127, cd = i >> 7, d = (cd & 1) * 4; bf16_t* f = FILT + (size_t)cd * FLEN;
            if (s < 64) { if (s <= d + 32) f[s] = 0; } else { const int ii = FLEN - 128 + s; if (ii >= d + 2 * SEQ + 32) f[ii] = 0; } }
        for (int i = bx * 512 + tid; i < HYW * 2 * 128; i += G * 512) {
            const int s = i & 127, cd = i >> 7, d = (cd & 1) * 4; bf16_t* f = FILTC + (size_t)cd * FLENC;
            if (s < 64) { if (s <= d + 32) f[s] = 0; } else { const int ii = FLENC - 128 + s; if (ii >= d + 2 * CTXL + 32) f[ii] = 0; } }
        __syncthreads();
        if (PH(15))
        {
            LAS float* hb = (LAS float*)(ldsl + wave * 16384);
            constexpr int ITEMS_LAT = (SEQ / 64) * 16, ITEMS_CTX = (CTXL / 64) * 16, NIT = 2 * ITEMS_LAT + ITEMS_CTX;
            for (int it = gw; it < NIT; it += NGW) {
                int set, r; if (it < ITEMS_LAT) { set = 0; r = it; } else if (it < 2 * ITEMS_LAT) { set = 1; r = it - ITEMS_LAT; } else { set = 2; r = it - 2 * ITEMS_LAT; }
                const int l = (set == 1) ? 1 : 0, n = (set == 2) ? CTXL : SEQ, pos = (r >> 4) * 64 + lane, c0 = (r & 15) * 64;
                const float* w1 = INP(I_FW1) + l * 33 * 64; const float* b1 = INP(I_FB1) + l * 64; const float* w2 = INP(I_FW2) + l * 64 * 64; const float* b2 = INP(I_FB2) + l * 64;
                const float* w3 = INP(I_FW3) + (size_t)l * 64 * 1024; const float* fr = INP(I_FFREQ) + l * 64;
                const float tt = (float)pos / (float)(n - 1);
                constexpr float INV2PI = 0.15915494309189535f;
                hb[lane] = tt;
#pragma unroll
                for (int i = 0; i < 16; ++i) { const float band = 1e-4f + (float)i * ((15.0f - 1e-4f) / 15.0f); const float rev = (float)pos * band / (float)n;
                    hb[(1 + i) * 64 + lane] = __builtin_amdgcn_cosf(rev); hb[(17 + i) * 64 + lane] = -__builtin_amdgcn_sinf(rev); }
                float h1[64];
#pragma unroll
                for (int j = 0; j < 64; ++j) h1[j] = b1[j];
                for (int i = 0; i < 33; ++i) { const float zi = hb[i * 64 + lane];
#pragma unroll
                    for (int j = 0; j < 64; ++j) h1[j] += zi * w1[i * 64 + j]; }
#pragma unroll
                for (int j = 0; j < 64; ++j) hb[j * 64 + lane] = __builtin_amdgcn_sinf(fr[j] * h1[j] * INV2PI);
#pragma unroll
                for (int j = 0; j < 64; ++j) h1[j] = b2[j];
                for (int i = 0; i < 64; ++i) { const float zi = hb[i * 64 + lane];
#pragma unroll
                    for (int j = 0; j < 64; ++j) h1[j] += zi * w2[i * 64 + j]; }
#pragma unroll
                for (int j = 0; j < 64; ++j) hb[j * 64 + lane] = __builtin_amdgcn_sinf(fr[j] * h1[j] * INV2PI);
#pragma unroll
                for (int j = 0; j < 64; ++j) h1[j] = 0.f;
                for (int i = 0; i < 64; ++i) { const float zi = hb[i * 64 + lane];
#pragma unroll
                    for (int j = 0; j < 64; ++j) h1[j] += zi * w3[i * 1024 + c0 + j]; }
                const bool bwd = c0 >= HYW; const int cb = bwd ? c0 - HYW : c0;
                bf16_t* F = (set == 2) ? FILTC : FILT + (size_t)l * HYW * 2 * FLEN; const int flen = (set == 2) ? FLENC : FLEN;
#pragma unroll
                for (int j = 0; j < 64; ++j) { const int c = cb + j;
                    const float delta = fabsf(-15.350567286626973f + (float)c * ((-3.0701134573253945f + 15.350567286626973f) / 511.0f));
                    const float kv = h1[j] * __expf(-tt * delta); const bf16_t kb = f2bf(kv);
                    bf16_t* f0 = F + (size_t)(c * 2) * flen;
                    if (!bwd) { f0[n + 32 - pos] = kb; f0[flen + 4 + n + 32 - pos] = kb; }
                    else if (pos >= 1) { f0[n + 32 + pos] = kb; f0[flen + 4 + n + 32 + pos] = kb; } }
            }
        }
        __syncthreads();
        if (PH(16))
        {
            LAS float* scr = (LAS float*)(ldsl + wave * 16384);
            constexpr int I_IN = 32 * (INC / 32), I_UQ = (QLORA / 64) * (1536 / 32), I_UKV = (KVLORA / 64) * (2048 / 32), I_OUT = 32 * 64, I_G = 32 * (FF / 32), I_D = (FF / 64) * 64;
            constexpr int PER_L = I_IN + I_UQ + I_UKV + I_OUT + 2 * I_G + I_D;
            for (int it = gw; it < 2 * PER_L; it += NGW) {
                const int l = it / PER_L; int r = it % PER_L; unsigned char* wl = ws + (size_t)l * WL_STRIDE;
                if (r < I_IN) { const int nb = r % (INC / 32); const float* W = INP(I_WIN) + (size_t)l * DM * INC;
                    if (nb < 48) transpose_item(W, DM, INC, (bf16_t*)(wl + W_INH), nullptr, scr, r, lane, MapInH()); else transpose_item(W, DM, INC, (bf16_t*)(wl + W_INR), nullptr, scr, r, lane, MapInR()); continue; } r -= I_IN;
                if (r < I_UQ) { transpose_item(INP(I_WUQ) + (size_t)l * QLORA * 1536, QLORA, 1536, (bf16_t*)(wl + W_UQ), INP(I_GQ) + l * QLORA, scr, r, lane, MapUQ()); continue; } r -= I_UQ;
                if (r < I_UKV) { transpose_item(INP(I_WUKV) + (size_t)l * KVLORA * 2048, KVLORA, 2048, (bf16_t*)(wl + W_UKV), INP(I_GKV) + l * KVLORA, scr, r, lane, MapIdent()); continue; } r -= I_UKV;
                if (r < I_OUT) { transpose_item(INP(I_WOUT) + (size_t)l * DM * DM, DM, DM, (bf16_t*)(wl + W_OUT), nullptr, scr, r, lane, MapIdent()); continue; } r -= I_OUT;
                if (r < I_G) { transpose_item(INP(I_WG) + (size_t)l * DM * FF, DM, FF, (bf16_t*)(wl + W_GU), nullptr, scr, r, lane, MapGate()); continue; } r -= I_G;
                if (r < I_G) { transpose_item(INP(I_WU) + (size_t)l * DM * FF, DM, FF, (bf16_t*)(wl + W_GU), nullptr, scr, r, lane, MapUp()); continue; } r -= I_G;
                transpose_item(INP(I_WD) + (size_t)l * FF * DM, FF, DM, (bf16_t*)(wl + W_DN), nullptr, scr, r, lane, MapIdent());
            }
        }
    }
    grid.sync();

    for (int l = 0; l < 2; ++l) {
        const int MR = (l == 0) ? TOK : NLAT;
        if (l == 0) {
            if (PH(1)) {
            DECL_PTRS(l)
            const float* gpre = INP(I_GAPRE);
            for (int row = gw; row < TOK; row += NGW) {
                const float* src = (row < NLAT) ? INP(I_X) + (size_t)row * DM : INP(I_CTX) + (size_t)(row - NLAT) * DM;
                const int bm = (row < NLAT) ? (row >> 11) : 4; const float* mrow = mod + (size_t)bm * ADA;
                f32x4 v[8]; float ss = 0.f;
#pragma unroll
                for (int j = 0; j < 8; ++j) { v[j] = *(const f32x4*)(src + 4 * lane + 256 * j); ss += pg8::dot4(v[j]); }
                const float rs = 1.0f / sqrtf(wave_sum(ss) * (1.0f / DM) + RMS_EPS);
#pragma unroll
                for (int j = 0; j < 8; ++j) { const int k = 4 * lane + 256 * j; const f32x4 gg = *(const f32x4*)(gpre + k), sh = *(const f32x4*)(mrow + k), sc = *(const f32x4*)(mrow + DM + k);
                    const f32x4 hh = v[j] * rs * gg * (sc + 1.0f) + sh; u32x2 w; w.x = cvt_pk_bf16(hh[0], hh[1]); w.y = cvt_pk_bf16(hh[2], hh[3]); *(u32x2*)(Hb + (size_t)row * DM + k) = w; }
            }
            }
            grid.sync();
        }
        if (PH(2)) {
            DECL_PTRS(l)
            { pg8::Gemm g{Hb, (const bf16_t*)(wl + W_INR), TOK, PRW, DM, DM}; pg8::StaticOrder S; S.init(TOK, PRW, G, bx); pg8::EpiPR E{PR, SSQ, ROPE}; pg8::gemm_phase(ldsl, g, S, E); }
            { pg8::Gemm g{(const bf16_t*)(wl + W_INH), Hb, 1536, TOK, DM, DM}; pg8::StaticOrder S; S.init(1536, TOK, G, (bx + 176) % G); pg8::EpiBf16 E{PT, TOK}; pg8::gemm_phase(ldsl, g, S, E); }
        }
        grid.sync();
        if (PH(3)) {
            DECL_PTRS(l)
            const int MQ = (l == 0) ? TOK : NLAT;
            { pg8::Gemm g{PR, (const bf16_t*)(wl + W_UQ), MQ, 1536, QLORA, PRW}; pg8::StaticOrder S; S.init(MQ, 1536, G, bx); pg8::EpiQ E{Qb, SSQ, ROPE}; pg8::gemm_phase(ldsl, g, S, E); }
            { pg8::Gemm g{PR + QLORA, (const bf16_t*)(wl + W_UKV), TOK, 2048, KVLORA, PRW}; pg8::StaticOrder S; S.init(TOK, 2048, G, (bx + 40) % G); pg8::EpiKV E{KVb, SSQ}; pg8::gemm_phase(ldsl, g, S, E); }
        }
        grid.sync();
        {
            DECL_PTRS(l)
            char* al = (char*)lds;
            if (PH(10))
            for (int uidx = vcu; uidx < 256; uidx += G) {
                const int bh = uidx >> 3, qb = uidx & 7, b = bh >> 3, h = bh & 7; const int row0 = b * SEQ + qb * 256;
                att::Args a; a.Q = Qb + (size_t)row0 * 1536 + h * 192; a.ldq = 1536; a.Kn = KVb + h * 256; a.ldk = 2048; a.Kr = PR + PR_KR; a.ldkr = PRW; a.V = KVb + h * 256 + 128; a.ldv = 2048;
                a.O = YC + (size_t)row0 * DM + 512 + h * 128; a.ldo = DM; a.nt = 36; a.n1 = 32; a.base1 = b * SEQ; a.base2 = NLAT + b * CTXL; a.scale = MLA_SCALE; a.g = 0; a.rlo = 0; a.bias = nullptr;
                att::unit<192, false>(a, al);
            }
            const float* rpb = INP(I_RPB) + (size_t)l * 4 * 15 * 31;
            if (PH(11))
            for (int uidx = vcu; uidx < 128; uidx += G) {
                const int bh = uidx >> 3, gq = uidx & 7, b = bh >> 2, h = bh & 3; const int row0 = b * SEQ + gq * 256;
                const int rlo = min(max(4 * gq - 4, 0), 24), nr = (gq == 0 || gq == 7) ? 8 : 12;
                att::Args a; a.Q = PR + (size_t)row0 * PRW + PR_NAQ + h * 128; a.ldq = PRW; a.Kn = PR + PR_NAK + h * 128; a.ldk = PRW; a.Kr = nullptr; a.ldkr = 0; a.V = PR + PR_NAV + h * 128; a.ldv = PRW;
                a.O = YC + (size_t)row0 * DM + 1536 + h * 128; a.ldo = DM; a.nt = 4 + nr; a.n1 = 4; a.base1 = NLAT + b * CTXL; a.base2 = b * SEQ + rlo * 64; a.scale = NA_SCALE; a.g = gq; a.rlo = rlo; a.bias = rpb + h * 15 * 31;
                att::unit<128, true>(a, al);
            }
            if (l == 0 && PH(12)) {
                for (int uidx = vcu; uidx < 32; uidx += G) { const int b = uidx >> 3, h = uidx & 7; const int row0 = NLAT + b * CTXL;
                    att::Args a; a.Q = Qb + (size_t)row0 * 1536 + h * 192; a.ldq = 1536; a.Kn = KVb + h * 256; a.ldk = 2048; a.Kr = PR + PR_KR; a.ldkr = PRW; a.V = KVb + h * 256 + 128; a.ldv = 2048;
                    a.O = YC + (size_t)row0 * DM + 512 + h * 128; a.ldo = DM; a.nt = 4; a.n1 = 4; a.base1 = row0; a.base2 = row0; a.scale = MLA_SCALE; a.g = 0; a.rlo = 0; a.bias = nullptr;
                    att::unit<192, false>(a, al); }
                for (int uidx = vcu; uidx < 16; uidx += G) { const int b = uidx >> 2, h = uidx & 3; const int row0 = NLAT + b * CTXL;
                    att::Args a; a.Q = PR + (size_t)row0 * PRW + PR_NAQ + h * 128; a.ldq = PRW; a.Kn = PR + PR_NAK + h * 128; a.ldk = PRW; a.Kr = nullptr; a.ldkr = 0; a.V = PR + PR_NAV + h * 128; a.ldv = PRW;
                    a.O = YC + (size_t)row0 * DM + 1536 + h * 128; a.ldo = DM; a.nt = 4; a.n1 = 4; a.base1 = row0; a.base2 = row0; a.scale = NA_SCALE; a.g = 0; a.rlo = 0; a.bias = nullptr;
                    att::unit<128, false>(a, al); }
            }
            if (PH(13)) {
                const float* cw = INP(I_HCW) + (size_t)l * 3 * 1536; const float* cb = INP(I_HCB) + (size_t)l * 1536; const float* hbias = INP(I_HBIAS) + (size_t)l * HYW;
                const int nunits = (l == 0) ? 2 * HYW : HYW;
                for (int uidx = (vcu + 128) % G; uidx < nunits; uidx += G) {
                    const int set = uidx >= HYW ? 1 : 0, c = uidx - set * HYW, n = set ? CTXL : SEQ, col0 = set ? NLAT : 0, LZ = n + 40, flen = set ? FLENC : FLEN;
                    const bf16_t* filt = set ? FILTC + (size_t)c * 2 * FLENC : FILT + ((size_t)l * HYW + c) * 2 * FLEN;
                    bf16_t* ZS = (bf16_t*)lds;
                    bf16_t* RF = ZS + 16 * LZ;
                    bf16_t* X2S = RF + 2 * flen;
                    __syncthreads();
                    for (int i = tid; i < (16 * LZ) / 8; i += 512) ((u32x4*)ZS)[i] = (u32x4){0u, 0u, 0u, 0u};
                    for (int i = tid; i < (2 * flen) / 8; i += 512) ((u32x4*)RF)[i] = ((const u32x4*)filt)[i];
                    __syncthreads();
                    const float wv0 = cw[c], wv1 = cw[1536 + c], wv2 = cw[3072 + c], bv = cb[c];
                    const float wa0 = cw[HYW + c], wa1 = cw[1536 + HYW + c], wa2 = cw[3072 + HYW + c], ba = cb[HYW + c];
                    const float wx0 = cw[2 * HYW + c], wx1 = cw[1536 + 2 * HYW + c], wx2 = cw[3072 + 2 * HYW + c], bx2 = cb[2 * HYW + c];
                    const bf16_t* pv_ = PT + (size_t)c * TOK + col0; const bf16_t* pa_ = PT + (size_t)(HYW + c) * TOK + col0; const bf16_t* px_ = PT + (size_t)(2 * HYW + c) * TOK + col0;
                    for (int i = tid; i < n; i += 512) {
                        const int b = i / (n / 4), s0 = (i % (n / 4)) * 4; const size_t off = (size_t)b * n + s0;
                        float v[6], x1[6], x2[6];
                        { const u32x2 w = *(const u32x2*)(pv_ + off); v[1] = bf2f(w.x & 0xffff); v[2] = bf2f(w.x >> 16); v[3] = bf2f(w.y & 0xffff); v[4] = bf2f(w.y >> 16);
                          v[0] = s0 > 0 ? bf2f(pv_[off - 1]) : 0.f; v[5] = s0 + 4 < n ? bf2f(pv_[off + 4]) : 0.f; }
                        { const u32x2 w = *(const u32x2*)(pa_ + off); x1[1] = bf2f(w.x & 0xffff); x1[2] = bf2f(w.x >> 16); x1[3] = bf2f(w.y & 0xffff); x1[4] = bf2f(w.y >> 16);
                          x1[0] = s0 > 0 ? bf2f(pa_[off - 1]) : 0.f; x1[5] = s0 + 4 < n ? bf2f(pa_[off + 4]) : 0.f; }
                        { const u32x2 w = *(const u32x2*)(px_ + off); x2[1] = bf2f(w.x & 0xffff); x2[2] = bf2f(w.x >> 16); x2[3] = bf2f(w.y & 0xffff); x2[4] = bf2f(w.y >> 16);
                          x2[0] = s0 > 0 ? bf2f(px_[off - 1]) : 0.f; x2[5] = s0 + 4 < n ? bf2f(px_[off + 4]) : 0.f; }
#pragma unroll
                        for (int e = 0; e < 4; ++e) {
                            const float uv = wv0 * v[e] + wv1 * v[e + 1] + wv2 * v[e + 2] + bv, ua = wa0 * x1[e] + wa1 * x1[e + 1] + wa2 * x1[e + 2] + ba, ux = wx0 * x2[e] + wx1 * x2[e + 1] + wx2 * x2[e + 2] + bx2;
                            const bf16_t zb = f2bf(ua * uv); const int s = s0 + e;
#pragma unroll
                            for (int sg = 0; sg < 4; ++sg) ZS[(sg * 4 + b) * LZ + s + 32 - sg] = zb;
                            X2S[b * n + s] = f2bf(ux);
                        }
                    }
                    __syncthreads();
                    const int NT0 = n / 128, TPW = NT0 >= 8 ? NT0 / 8 : 1, nks = (n + 32) / 32;
                    if (wave * TPW < NT0) {
                        const int rho = lane & 15, gq4 = lane >> 4, colb = (lane & 15) >> 2, sg = lane & 3;
                        const bf16_t* zrow = ZS + (sg * 4 + colb) * LZ + 8 * gq4;
                        f32x4 acc[2][2] = {{{0.f, 0.f, 0.f, 0.f}, {0.f, 0.f, 0.f, 0.f}}, {{0.f, 0.f, 0.f, 0.f}, {0.f, 0.f, 0.f, 0.f}}};
                        const int T0a = 128 * (wave * TPW);
                        const bf16_t* ra = RF + (n - T0a - 8 * rho + 8 * gq4);
                        for (int ks = 0; ks < nks; ++ks) {
                            const bf16x8 bfr = *(const bf16x8*)(zrow + 32 * ks);
                            const bf16x8 a00 = *(const bf16x8*)(ra + 32 * ks), a01 = *(const bf16x8*)(ra + flen + 32 * ks);
                            acc[0][0] = __builtin_amdgcn_mfma_f32_16x16x32_bf16(a00, bfr, acc[0][0], 0, 0, 0);
                            acc[0][1] = __builtin_amdgcn_mfma_f32_16x16x32_bf16(a01, bfr, acc[0][1], 0, 0, 0);
                            if (TPW == 2) {
                                const bf16x8 a10 = *(const bf16x8*)(ra - 128 + 32 * ks), a11 = *(const bf16x8*)(ra - 128 + flen + 32 * ks);
                                acc[1][0] = __builtin_amdgcn_mfma_f32_16x16x32_bf16(a10, bfr, acc[1][0], 0, 0, 0);
                                acc[1][1] = __builtin_amdgcn_mfma_f32_16x16x32_bf16(a11, bfr, acc[1][1], 0, 0, 0);
                            }
                        }
                        const float hb_ = hbias[c];
#pragma unroll
                        for (int ti = 0; ti < 2; ++ti) { if (ti < TPW) {
#pragma unroll
                            for (int di = 0; di < 2; ++di)
#pragma unroll
                                for (int rg = 0; rg < 4; ++rg) { const int t = T0a + 128 * ti + 8 * (4 * gq4 + rg) + 4 * di + sg;
                                    const float zt = bf2f(ZS[colb * LZ + t + 32]), x2v = bf2f(X2S[colb * n + t]);
                                    YC[(size_t)(col0 + colb * n + t) * DM + c] = f2bf(x2v * (acc[ti][di][rg] + zt * hb_)); } } }
                    }
                }
            }
        }
        grid.sync();
        if (PH(5)) { DECL_PTRS(l) pg8::Gemm g{YC, (const bf16_t*)(wl + W_OUT), MR, DM, DM, DM}; pg8::StaticOrder S; S.init(MR, DM, G, bx); pg8::EpiF32S E{YF, SSQY}; pg8::gemm_phase(ldsl, g, S, E); }
        grid.sync();
        if (PH(6)) {
            DECL_PTRS(l)
            const float* gpost = INP(I_GAPOST) + l * DM; const float* gfpre = INP(I_GFPRE) + l * DM;
            for (int row = gw; row < MR; row += NGW) {
                const float* xs = (l == 0) ? ((row < NLAT) ? INP(I_X) + (size_t)row * DM : INP(I_CTX) + (size_t)(row - NLAT) * DM) : XR + (size_t)row * DM;
                const int bm = (row < NLAT) ? (row >> 11) : 4; const float* mrow = mod + (size_t)bm * ADA;
                float sy = (lane < 32) ? SSQY[(size_t)row * 32 + lane] : 0.f; sy = wave_sum(sy);
                const float rsy = 1.0f / sqrtf(sy * (1.0f / DM) + RMS_EPS);
                f32x4 v[8]; float ss = 0.f;
#pragma unroll
                for (int j = 0; j < 8; ++j) { const int k = 4 * lane + 256 * j; const f32x4 xv = *(const f32x4*)(xs + k), yv = *(const f32x4*)(YF + (size_t)row * DM + k), gg = *(const f32x4*)(gpost + k), gt = *(const f32x4*)(mrow + 2 * DM + k);
                    v[j] = xv + gt * (yv * rsy * gg); ss += pg8::dot4(v[j]); *(f32x4*)(XR + (size_t)row * DM + k) = v[j]; }
                const float rs = 1.0f / sqrtf(wave_sum(ss) * (1.0f / DM) + RMS_EPS);
#pragma unroll
                for (int j = 0; j < 8; ++j) { const int k = 4 * lane + 256 * j; const f32x4 gg = *(const f32x4*)(gfpre + k), sh = *(const f32x4*)(mrow + 3 * DM + k), sc = *(const f32x4*)(mrow + 4 * DM + k);
                    const f32x4 hh = v[j] * rs * gg * (sc + 1.0f) + sh; u32x2 w; w.x = cvt_pk_bf16(hh[0], hh[1]); w.y = cvt_pk_bf16(hh[2], hh[3]); *(u32x2*)(Hb + (size_t)row * DM + k) = w; }
            }
        }
        grid.sync();
        if (PH(7)) { DECL_PTRS(l) pg8::Gemm g{Hb, (const bf16_t*)(wl + W_GU), MR, 2 * FF, DM, DM}; pg8::StaticOrder S; S.init(MR, 2 * FF, G, bx); pg8::EpiSwiGLU E{ACT}; pg8::gemm_phase(ldsl, g, S, E); }
        grid.sync();
        if (PH(8)) { DECL_PTRS(l) pg8::Gemm g{ACT, (const bf16_t*)(wl + W_DN), MR, DM, FF, FF}; pg8::StaticOrder S; S.init(MR, DM, G, bx); pg8::EpiF32S E{YF, SSQY}; pg8::gemm_phase(ldsl, g, S, E); }
        grid.sync();
        if (PH(9)) {
            DECL_PTRS(l)
            const float* gpost = INP(I_GFPOST) + l * DM; const float* gnext = INP(I_GAPRE) + DM; const float* modn = MOD + (size_t)5 * ADA;
            for (int row = gw; row < MR; row += NGW) {
                const int bm = (row < NLAT) ? (row >> 11) : 4; const float* mrow = mod + (size_t)bm * ADA; const float* mnext = modn + (size_t)bm * ADA;
                float sy = (lane < 32) ? SSQY[(size_t)row * 32 + lane] : 0.f; sy = wave_sum(sy);
                const float rsy = 1.0f / sqrtf(sy * (1.0f / DM) + RMS_EPS);
                f32x4 v[8]; float ss = 0.f;
                float* dst = (l == 0) ? XR + (size_t)row * DM : (float*)INP(29) + (size_t)row * DM;
#pragma unroll
                for (int j = 0; j < 8; ++j) { const int k = 4 * lane + 256 * j; const f32x4 xv = *(const f32x4*)(XR + (size_t)row * DM + k), yv = *(const f32x4*)(YF + (size_t)row * DM + k), gg = *(const f32x4*)(gpost + k), gt = *(const f32x4*)(mrow + 5 * DM + k);
                    v[j] = xv + gt * (yv * rsy * gg); ss += pg8::dot4(v[j]); *(f32x4*)(dst + k) = v[j]; }
                if (l == 0) {
                    const float rs = 1.0f / sqrtf(wave_sum(ss) * (1.0f / DM) + RMS_EPS);
#pragma unroll
                    for (int j = 0; j < 8; ++j) { const int k = 4 * lane + 256 * j; const f32x4 gg = *(const f32x4*)(gnext + k), sh = *(const f32x4*)(mnext + k), sc = *(const f32x4*)(mnext + DM + k);
                        const f32x4 hh = v[j] * rs * gg * (sc + 1.0f) + sh; u32x2 w; w.x = cvt_pk_bf16(hh[0], hh[1]); w.y = cvt_pk_bf16(hh[2], hh[3]); *(u32x2*)(Hb + (size_t)row * DM + k) = w; }
                }
            }
        }
        if (l == 0) grid.sync();
    }
}

extern "C" void kernel_launch(void* const* d_in, const int* in_sizes, int n_in, void* d_out, int out_size, void* d_ws, size_t ws_size, hipStream_t stream) {
    static int grid = 0;
    if (grid == 0) {
        if (n_in != 29 || out_size != NLAT * DM || ws_size < WS_NEED) { fprintf(stderr, "kernel_launch: unexpected shapes: n_in %d out %d ws %zu\n", n_in, out_size, ws_size); grid = -1; return; }
        int dev = 0, cus = 0, per_cu = 0;
        (void)hipGetDevice(&dev); (void)hipDeviceGetAttribute(&cus, hipDeviceAttributeMultiprocessorCount, dev);
        (void)hipFuncSetAttribute((const void*)fwd_mega, hipFuncAttributeMaxDynamicSharedMemorySize, LDS_BYTES);
        (void)hipOccupancyMaxActiveBlocksPerMultiprocessor(&per_cu, (const void*)fwd_mega, 512, LDS_BYTES);
        if (per_cu < 1) { fprintf(stderr, "kernel_launch: occupancy query reports %d blocks per CU\n", per_cu); }
        grid = cus;
    }
    if (grid < 0) return;
    Params p{};
    for (int i = 0; i < 29; ++i) p.in[i] = (const float*)d_in[i];
    p.out = (float*)d_out; p.ws = (unsigned char*)d_ws;
    void* args[] = {&p};
    hipError_t e = hipLaunchCooperativeKernel((const void*)fwd_mega, dim3(grid), dim3(512), args, LDS_BYTES, stream);
    if (e != hipSuccess) fprintf(stderr, "cooperative launch failed: %s (grid %d)\n", hipGetErrorString(e), grid);
}
```

```cpp
#include <hip/hip_runtime.h>
#include <hip/hip_cooperative_groups.h>
#include <cstdio>
#include <cstdint>
namespace cg = cooperative_groups;

#define LAS __attribute__((address_space(3)))
typedef unsigned short bf16_t;
typedef short bf16x8 __attribute__((ext_vector_type(8)));
typedef short s16x4 __attribute__((ext_vector_type(4)));
typedef float f32x4 __attribute__((ext_vector_type(4)));
typedef float f32x2 __attribute__((ext_vector_type(2)));
typedef float f32x16 __attribute__((ext_vector_type(16)));
typedef unsigned u32x4 __attribute__((ext_vector_type(4)));
typedef unsigned u32x2 __attribute__((ext_vector_type(2)));

constexpr int DM = 2048, NBATCH = 4, SEQ = 2048, CTXL = 256, NLAT = NBATCH * SEQ, NCTX = NBATCH * CTXL, TOK = NLAT + NCTX;
constexpr int INC = 4416, HYW = 512, QLORA = 768, KVLORA = 512, FF = 5632, ADA = 6 * DM;
constexpr int PRW = 3072;
constexpr int PR_KR = 1280, PR_NAQ = 1344, PR_NAK = 1856, PR_NAV = 2368;
constexpr float RMS_EPS = 1e-6f;
constexpr float MLA_SCALE = 0.07216878364870322f;
constexpr float NA_SCALE = 0.08838834764831845f;

constexpr size_t MiB = 1u << 20;
constexpr size_t WL_STRIDE = 98 * MiB;
constexpr size_t W_INR = 0, W_INH = 12 * MiB, W_UQ = 18 * MiB, W_UKV = 21 * MiB, W_OUT = 23 * MiB, W_GU = 31 * MiB, W_DN = 75 * MiB;
constexpr size_t A_H = 196 * MiB, A_YC = 232 * MiB, A_YF = 268 * MiB, A_XR = 340 * MiB, A_PR = 412 * MiB, A_PT = 466 * MiB, A_Q = 493 * MiB, A_KV = 520 * MiB, A_ACT = 412 * MiB;
constexpr size_t S_MOD = 556 * MiB, S_ROPE = 557 * MiB, S_SSQ = 558 * MiB, S_SSQY = 559 * MiB, S_FILT = 561 * MiB, S_FILTC = 578 * MiB, S_CTL = 580 * MiB, WS_NEED = 581 * MiB;
constexpr int FLEN = 2 * SEQ + 64, FLENC = 2 * CTXL + 64;

constexpr int LDS_BYTES = 147456;
#ifndef PHMASK
#define PHMASK 0xFFFFFFFFu
#endif
#define PH(n) ((PHMASK >> (n)) & 1u)

__device__ __forceinline__ unsigned cvt_pk_bf16(float lo, float hi) { unsigned r; asm volatile("v_cvt_pk_bf16_f32 %0, %1, %2" : "=v"(r) : "v"(lo), "v"(hi)); return r; }
__device__ __forceinline__ bf16_t f2bf(float f) { return (bf16_t)(cvt_pk_bf16(f, 0.f) & 0xffffu); }
__device__ __forceinline__ float bf2f(bf16_t h) { return __uint_as_float(((unsigned)h) << 16); }
__device__ __forceinline__ float wave_sum(float v) {
#pragma unroll
    for (int o = 1; o < 64; o <<= 1) v += __shfl_xor(v, o);
    return v;
}

namespace pg8 {
constexpr int BM = 256, BK = 64, HALF = 128, HTB = HALF * BK * 2, STAGE_BYTES = 8 * HTB, NXCD = 8, WGM = 8;
__host__ __device__ __forceinline__ int lds_byte(int r, int c) { const int st = (r >> 4) * 2 + (c >> 5), rr = r & 15, cc = c & 31, ob = rr * 64 + cc * 2; return st * 1024 + (ob ^ (((ob >> 9) & 1) << 5)); }
__host__ __device__ __forceinline__ void stage_rc(int b, int& R, int& C) { const int st = b / 1024, sb = b % 1024, swz = sb ^ (((sb >> 9) & 1) << 5); R = (st >> 1) * 16 + swz / 64; C = (st & 1) * 32 + (swz % 64) / 2; }
__host__ __device__ __forceinline__ int perm32(int rho) { const int n = rho >> 4, i = rho & 15; return 8 * (i >> 2) + 4 * n + (i & 3); }

struct Unit { int pm, pn; };
struct Gemm { const bf16_t* A; const bf16_t* Bt; int M, N, K, lda; };

struct StaticOrder {
    int nM, nN, nwg, G, c;
    __host__ __device__ void init(int M, int N, int G_, int c_) { nM = M / BM; nN = N / BM; nwg = nM * nN; G = G_; c = c_; }
    __host__ __device__ bool next(int i, Unit& u) const {
        const long L = (long)i * G + c; if (L >= nwg) return false;
        int wgid = (int)L; { const int q = nwg / NXCD, r = nwg % NXCD, xcd = wgid % NXCD, off = wgid / NXCD; wgid = (xcd < r ? xcd * (q + 1) : r * (q + 1) + (xcd - r) * q) + off; }
        const int nig = WGM * nN, gid = wgid / nig, fm = gid * WGM, gsz = (nM - fm) < WGM ? (nM - fm) : WGM;
        u.pm = fm + ((wgid % nig) % gsz); u.pn = (wgid % nig) / gsz; return true;
    }
};

template <class Epi>
__device__ __forceinline__ void gemm_phase(LAS unsigned char* lds, const Gemm g, const StaticOrder& S, const Epi& E) {
    int tid = threadIdx.x; asm volatile("" : "+v"(tid));
    const int wid = __builtin_amdgcn_readfirstlane(tid >> 6), lane = tid & 63, wr = wid >> 2, wc = wid & 3, fr = lane & 15, fq = lane >> 4;
    const int K = g.K, nt = K / BK;
    unsigned voffA[2], voffB[2];
#pragma unroll
    for (int i = 0; i < 2; ++i) { int R, C; stage_rc(tid * 16 + i * 8192, R, C); const int Rb = Epi::PERM ? ((R & ~31) + perm32(R & 31)) : R;
        voffA[i] = (unsigned)(R * g.lda + C) * 2u; voffB[i] = (unsigned)(Rb * K + C) * 2u; }
    const size_t kstep = (size_t)(BK * 2);
    const size_t hstepA = (size_t)HALF * g.lda * 2, hstepB = (size_t)HALF * K * 2;
    const size_t tstepA = 2 * hstepA, tstepB = 2 * hstepB;
    const unsigned ldsw = (unsigned)wid * 1024u;
    const int aoff = lds_byte(wr * 64 + fr, fq * 8), boff = lds_byte(wc * 32 + fr, fq * 8);
#define PG8_SA(b, h) (((b) * 2 + (h)) * HTB)
#define PG8_SB(b, h) ((4 + (b) * 2 + (h)) * HTB)
#define PG8_STAGE(bufoff, gbase, voff) do { _Pragma("unroll") for (int _i = 0; _i < 2; ++_i) \
        __builtin_amdgcn_global_load_lds((const unsigned*)((const char*)(gbase) + (voff)[_i]), (LAS unsigned*)(lds + (bufoff) + ldsw + _i * 8192), 16, 0, 0); } while (0)
#define PG8_LDA(dst, b, h) do { _Pragma("unroll") for (int m = 0; m < 4; ++m) _Pragma("unroll") for (int k = 0; k < 2; ++k) dst[m][k] = *(const LAS bf16x8*)(lds + PG8_SA(b, h) + aoff + m * 2048 + k * 1024); } while (0)
#define PG8_LDB(dst, b, h) do { _Pragma("unroll") for (int n = 0; n < 2; ++n) _Pragma("unroll") for (int k = 0; k < 2; ++k) dst[n][k] = *(const LAS bf16x8*)(lds + PG8_SB(b, h) + boff + n * 2048 + k * 1024); } while (0)
#define PG8_MMA(ai, bj, At, Bt) do { __builtin_amdgcn_s_setprio(1); _Pragma("unroll") for (int m = 0; m < 4; ++m) _Pragma("unroll") for (int n = 0; n < 2; ++n) _Pragma("unroll") for (int k = 0; k < 2; ++k) \
        acc[ai][bj][m][n] = __builtin_amdgcn_mfma_f32_16x16x32_bf16(Bt[n][k], At[m][k], acc[ai][bj][m][n], 0, 0, 0); __builtin_amdgcn_s_setprio(0); } while (0)
#define PG8_WAIT_V(n) asm volatile("s_waitcnt vmcnt(" #n ")" ::: "memory")
#define PG8_WAIT_L(n) asm volatile("s_waitcnt lgkmcnt(" #n ")" ::: "memory")
#define PG8_BAR __builtin_amdgcn_s_barrier()
#define PG8_SCHED __builtin_amdgcn_sched_barrier(0)
    Unit cur, nxt; int ui = 0;
    if (!S.next(0, cur)) return;
    f32x4 acc[2][2][4][2];
#pragma unroll
    for (int a = 0; a < 2; ++a)
#pragma unroll
        for (int b = 0; b < 2; ++b)
#pragma unroll
            for (int m = 0; m < 4; ++m)
#pragma unroll
                for (int n = 0; n < 2; ++n) acc[a][b][m][n] = (f32x4){0.f, 0.f, 0.f, 0.f};
    bf16x8 At[4][2], B0[2][2], B1[2][2];
    const char* cA = (const char*)g.A + (size_t)cur.pm * tstepA; const char* cB = (const char*)g.Bt + (size_t)cur.pn * tstepB;
    PG8_STAGE(PG8_SB(0, 0), cB, voffB); PG8_STAGE(PG8_SB(0, 1), cB + hstepB, voffB); PG8_STAGE(PG8_SA(0, 0), cA, voffA); PG8_STAGE(PG8_SA(0, 1), cA + hstepA, voffA);
    if (wr == 1) PG8_BAR;
    PG8_WAIT_V(2); PG8_BAR;
    PG8_STAGE(PG8_SB(1, 0), cB + kstep, voffB); PG8_STAGE(PG8_SA(1, 0), cA + kstep, voffA); PG8_STAGE(PG8_SB(1, 1), cB + hstepB + kstep, voffB);
    PG8_WAIT_V(6); PG8_BAR;
    for (;;) {
        const bool has_next = S.next(ui + 1, nxt);
        const char* nA = has_next ? (const char*)g.A + (size_t)nxt.pm * tstepA : cA; const char* nB = has_next ? (const char*)g.Bt + (size_t)nxt.pn * tstepB : cB;
        for (int t = 0; t < nt; t += 2) {
            const bool last = (t == nt - 2);
            const char* a1 = cA + (size_t)(t + 1) * kstep;
            const char* a2 = last ? nA : cA + (size_t)(t + 2) * kstep; const char* b2 = last ? nB : cB + (size_t)(t + 2) * kstep;
            const char* a3 = a2 + kstep; const char* b3 = b2 + kstep;
            PG8_LDB(B0, 0, 0); PG8_LDB(B1, 0, 1); PG8_SCHED; PG8_LDA(At, 0, 0); PG8_STAGE(PG8_SA(1, 1), a1 + hstepA, voffA);
            PG8_WAIT_V(8); PG8_WAIT_L(0); PG8_BAR; PG8_MMA(0, 0, At, B0); PG8_MMA(0, 1, At, B1); PG8_BAR; PG8_SCHED;
            PG8_LDA(At, 0, 1); PG8_STAGE(PG8_SB(0, 0), b2, voffB); PG8_STAGE(PG8_SB(0, 1), b2 + hstepB, voffB); PG8_STAGE(PG8_SA(0, 0), a2, voffA);
            PG8_WAIT_V(8); PG8_WAIT_L(0); PG8_BAR; PG8_MMA(1, 0, At, B0); PG8_MMA(1, 1, At, B1); PG8_BAR; PG8_SCHED;
            PG8_LDB(B0, 1, 0); PG8_LDB(B1, 1, 1); PG8_SCHED; PG8_LDA(At, 1, 0); PG8_STAGE(PG8_SA(0, 1), a2 + hstepA, voffA);
            PG8_WAIT_V(8); PG8_WAIT_L(0); PG8_BAR; PG8_MMA(0, 0, At, B0); PG8_MMA(0, 1, At, B1); PG8_BAR; PG8_SCHED;
            PG8_LDA(At, 1, 1); PG8_STAGE(PG8_SB(1, 0), b3, voffB); PG8_STAGE(PG8_SB(1, 1), b3 + hstepB, voffB); PG8_STAGE(PG8_SA(1, 0), a3, voffA);
            PG8_WAIT_V(8); PG8_WAIT_L(0); PG8_BAR; PG8_MMA(1, 0, At, B0); PG8_MMA(1, 1, At, B1); PG8_BAR; PG8_SCHED;
        }
        if (wr == 0) PG8_BAR;
        E(acc, cur, wr, wc, fr, fq);
        if (!has_next) break;
#pragma unroll
        for (int a = 0; a < 2; ++a)
#pragma unroll
            for (int b = 0; b < 2; ++b)
#pragma unroll
                for (int m = 0; m < 4; ++m)
#pragma unroll
                    for (int n = 0; n < 2; ++n) acc[a][b][m][n] = (f32x4){0.f, 0.f, 0.f, 0.f};
        cur = nxt; cA = nA; cB = nB; ++ui;
        if (wr == 1) PG8_BAR;
    }
    PG8_WAIT_V(0);
    PG8_BAR;
#undef PG8_SA
#undef PG8_SB
#undef PG8_STAGE
#undef PG8_LDA
#undef PG8_LDB
#undef PG8_MMA
#undef PG8_WAIT_V
#undef PG8_WAIT_L
#undef PG8_BAR
#undef PG8_SCHED
}

__device__ __forceinline__ float dot4(f32x4 v) { return (v[0] * v[0] + v[1] * v[1]) + (v[2] * v[2] + v[3] * v[3]); }
__device__ __forceinline__ void rope4(f32x4& v, const float* rope_row, int i0) {
    const f32x4 cs = *(const f32x4*)(rope_row + 2 * i0);
    const float a0 = v[0] * cs[0] - v[1] * cs[1], b0 = v[1] * cs[0] + v[0] * cs[1];
    const float a1 = v[2] * cs[2] - v[3] * cs[3], b1 = v[3] * cs[2] + v[2] * cs[3];
    v = (f32x4){a0, b0, a1, b1};
}
__device__ __forceinline__ u32x4 pack8(f32x4 v0, f32x4 v1) { u32x4 w; w.x = cvt_pk_bf16(v0[0], v0[1]); w.y = cvt_pk_bf16(v0[2], v0[3]); w.z = cvt_pk_bf16(v1[0], v1[1]); w.w = cvt_pk_bf16(v1[2], v1[3]); return w; }

struct EpiBf16 {
    static constexpr bool PERM = true;
    bf16_t* O; int ldc;
    __device__ __forceinline__ void operator()(const f32x4 (&acc)[2][2][4][2], const Unit& u, int wr, int wc, int fr, int fq) const {
        const int row0 = u.pm * BM + wr * 64 + fr, col0 = u.pn * BM + wc * 32 + 8 * fq;
#pragma unroll
        for (int ai = 0; ai < 2; ++ai)
#pragma unroll
            for (int m = 0; m < 4; ++m) { bf16_t* rowp = O + (size_t)(row0 + ai * HALF + m * 16) * ldc + col0;
#pragma unroll
                for (int bj = 0; bj < 2; ++bj) *(u32x4*)(rowp + bj * HALF) = pack8(acc[ai][bj][m][0], acc[ai][bj][m][1]); }
    }
};
struct EpiPR {
    static constexpr bool PERM = true;
    bf16_t* O; float* ssq; const float* rope;
    __device__ __forceinline__ void operator()(const f32x4 (&acc)[2][2][4][2], const Unit& u, int wr, int wc, int fr, int fq) const {
        const int row0 = u.pm * BM + wr * 64 + fr, col0 = u.pn * BM + wc * 32 + 8 * fq;
        const bool dorope = (u.pn == 5) && (wc < 2);
#pragma unroll
        for (int ai = 0; ai < 2; ++ai)
#pragma unroll
            for (int m = 0; m < 4; ++m) { const int row = row0 + ai * HALF + m * 16; bf16_t* rowp = O + (size_t)row * PRW + col0; float ss = 0.f;
#pragma unroll
                for (int bj = 0; bj < 2; ++bj) { f32x4 v0 = acc[ai][bj][m][0], v1 = acc[ai][bj][m][1];
                    if (bj == 0 && dorope && row < NLAT) { const float* rr = rope + (size_t)(row & (SEQ - 1)) * 64; const int i0 = 16 * wc + 4 * fq; rope4(v0, rr, i0); rope4(v1, rr, i0 + 2); }
                    ss += dot4(v0) + dot4(v1);
                    *(u32x4*)(rowp + bj * HALF) = pack8(v0, v1); }
                if (u.pn < 5) { ss += __shfl_xor(ss, 16); ss += __shfl_xor(ss, 32); if (fq == 0) ssq[(size_t)row * 20 + u.pn * 4 + wc] = ss; }
                asm volatile("" ::: "memory"); }
    }
};
struct EpiQ {
    static constexpr bool PERM = true;
    bf16_t* O; const float* ssq; const float* rope;
    __device__ __forceinline__ void operator()(const f32x4 (&acc)[2][2][4][2], const Unit& u, int wr, int wc, int fr, int fq) const {
        const int row0 = u.pm * BM + wr * 64 + fr, col0 = u.pn * BM + wc * 32 + 8 * fq;
#pragma unroll
        for (int ai = 0; ai < 2; ++ai)
#pragma unroll
            for (int m = 0; m < 4; ++m) { const int row = row0 + ai * HALF + m * 16; bf16_t* rowp = O + (size_t)row * 1536 + col0;
                const f32x4* sp = (const f32x4*)(ssq + (size_t)row * 20); const f32x4 s0 = sp[0], s1 = sp[1], s2 = sp[2];
                const float tot = ((s0[0] + s0[1]) + (s0[2] + s0[3])) + ((s1[0] + s1[1]) + (s1[2] + s1[3])) + ((s2[0] + s2[1]) + (s2[2] + s2[3]));
                const float rs = 1.0f / sqrtf(tot * (1.0f / QLORA) + RMS_EPS);
#pragma unroll
                for (int bj = 0; bj < 2; ++bj) { f32x4 v0 = acc[ai][bj][m][0] * rs, v1 = acc[ai][bj][m][1] * rs;
                    const int j0 = (col0 + bj * HALF) % 192;
                    if (j0 >= 128 && row < NLAT) { const float* rr = rope + (size_t)(row & (SEQ - 1)) * 64; const int i0 = (j0 - 128) >> 1; rope4(v0, rr, i0); rope4(v1, rr, i0 + 2); }
                    *(u32x4*)(rowp + bj * HALF) = pack8(v0, v1); }
                asm volatile("" ::: "memory"); }
    }
};
struct EpiKV {
    static constexpr bool PERM = true;
    bf16_t* O; const float* ssq;
    __device__ __forceinline__ void operator()(const f32x4 (&acc)[2][2][4][2], const Unit& u, int wr, int wc, int fr, int fq) const {
        const int row0 = u.pm * BM + wr * 64 + fr, col0 = u.pn * BM + wc * 32 + 8 * fq;
#pragma unroll
        for (int ai = 0; ai < 2; ++ai)
#pragma unroll
            for (int m = 0; m < 4; ++m) { const int row = row0 + ai * HALF + m * 16; bf16_t* rowp = O + (size_t)row * 2048 + col0;
                const f32x4* sp = (const f32x4*)(ssq + (size_t)row * 20 + 12); const f32x4 s0 = sp[0], s1 = sp[1];
                const float tot = ((s0[0] + s0[1]) + (s0[2] + s0[3])) + ((s1[0] + s1[1]) + (s1[2] + s1[3]));
                const float rs = 1.0f / sqrtf(tot * (1.0f / KVLORA) + RMS_EPS);
#pragma unroll
                for (int bj = 0; bj < 2; ++bj) *(u32x4*)(rowp + bj * HALF) = pack8(acc[ai][bj][m][0] * rs, acc[ai][bj][m][1] * rs);
                asm volatile("" ::: "memory"); }
    }
};
struct EpiF32S {
    static constexpr bool PERM = false;
    float* C; float* ssq;
    __device__ __forceinline__ void operator()(const f32x4 (&acc)[2][2][4][2], const Unit& u, int wr, int wc, int fr, int fq) const {
        const int row0 = u.pm * BM + wr * 64 + fr, col0 = u.pn * BM + wc * 32 + 4 * fq;
#pragma unroll
        for (int ai = 0; ai < 2; ++ai)
#pragma unroll
            for (int m = 0; m < 4; ++m) { const int row = row0 + ai * HALF + m * 16; float* rowp = C + (size_t)row * DM + col0; float ss = 0.f;
#pragma unroll
                for (int bj = 0; bj < 2; ++bj)
#pragma unroll
                    for (int n = 0; n < 2; ++n) { const f32x4 v = acc[ai][bj][m][n]; ss += dot4(v); *(f32x4*)(rowp + bj * HALF + n * 16) = v; }
                ss += __shfl_xor(ss, 16); ss += __shfl_xor(ss, 32); if (fq == 0) ssq[(size_t)row * 32 + u.pn * 4 + wc] = ss; }
    }
};
struct EpiSwiGLU {
    static constexpr bool PERM = true;
    bf16_t* O;
    __device__ __forceinline__ void operator()(const f32x4 (&acc)[2][2][4][2], const Unit& u, int wr, int wc, int fr, int fq) const {
        const int row0 = u.pm * BM + wr * 64 + fr, col0 = u.pn * HALF + wc * 32 + 8 * fq;
#pragma unroll
        for (int ai = 0; ai < 2; ++ai)
#pragma unroll
            for (int m = 0; m < 4; ++m) { bf16_t* rowp = O + (size_t)(row0 + ai * HALF + m * 16) * FF + col0; f32x4 r[2];
#pragma unroll
                for (int n = 0; n < 2; ++n) { const f32x4 gt = acc[ai][0][m][n], up = acc[ai][1][m][n];
#pragma unroll
                    for (int e = 0; e < 4; ++e) { const float sg = __builtin_amdgcn_rcpf(1.0f + __builtin_amdgcn_exp2f(-1.4426950408889634f * gt[e])); r[n][e] = gt[e] * sg * up[e]; } }
                *(u32x4*)rowp = pack8(r[0], r[1]); }
    }
};
}

namespace att {
constexpr int NW = 8, QBLK = 32, KVBLK = 64;
#define SBAR() __builtin_amdgcn_sched_barrier(0)
__device__ __forceinline__ int crow(int r, int hi) { return (r & 3) + 8 * (r >> 2) + 4 * hi; }
__device__ __forceinline__ int v_st(int k, int c) { const int kk = (k & ~0xC) | ((k & 4) << 1) | ((k & 8) >> 1); return ((kk >> 3) * 4 + (c >> 5)) * 512 + ((kk & 7) * 32 + (c & 31)) * 2; }
__device__ __forceinline__ int v_rd_base(int lane) { return ((lane & 3) << 3) | (((lane >> 2) & 3) << 6) | (((lane >> 4) & 1) << 5) | (((lane >> 5) & 1) << 8); }
constexpr int v_rd_off(int d0, int ks, int half) { return d0 * 512 + ks * 4096 + half * 2048; }
template <int OFF> __device__ __forceinline__ s16x4 tr_read(int vb) { s16x4 r; asm volatile("ds_read_b64_tr_b16 %0, %1 offset:%2" : "=&v"(r) : "v"(vb), "i"(OFF) : "memory"); return r; }
template <int D0> __device__ __forceinline__ void pv_one(f32x16& od, int vb, bf16x8 pa0, bf16x8 pa1, bf16x8 pa2, bf16x8 pa3) {
    const s16x4 l0 = tr_read<v_rd_off(D0, 0, 0)>(vb), h0 = tr_read<v_rd_off(D0, 0, 1)>(vb), l1 = tr_read<v_rd_off(D0, 1, 0)>(vb), h1 = tr_read<v_rd_off(D0, 1, 1)>(vb);
    const s16x4 l2 = tr_read<v_rd_off(D0, 2, 0)>(vb), h2 = tr_read<v_rd_off(D0, 2, 1)>(vb), l3 = tr_read<v_rd_off(D0, 3, 0)>(vb), h3 = tr_read<v_rd_off(D0, 3, 1)>(vb);
    asm volatile("s_waitcnt lgkmcnt(0)" ::: "memory"); SBAR();
#define PKV(L, H) (bf16x8){L[0], L[1], L[2], L[3], H[0], H[1], H[2], H[3]}
    od = __builtin_amdgcn_mfma_f32_32x32x16_bf16(pa0, PKV(l0, h0), od, 0, 0, 0);
    od = __builtin_amdgcn_mfma_f32_32x32x16_bf16(pa1, PKV(l1, h1), od, 0, 0, 0);
    od = __builtin_amdgcn_mfma_f32_32x32x16_bf16(pa2, PKV(l2, h2), od, 0, 0, 0);
    od = __builtin_amdgcn_mfma_f32_32x32x16_bf16(pa3, PKV(l3, h3), od, 0, 0, 0);
#undef PKV
}
__device__ __forceinline__ void pv_d0(f32x16* o, int vb, bf16x8 pa0, bf16x8 pa1, bf16x8 pa2, bf16x8 pa3) {
    pv_one<0>(o[0], vb, pa0, pa1, pa2, pa3); pv_one<1>(o[1], vb, pa0, pa1, pa2, pa3); pv_one<2>(o[2], vb, pa0, pa1, pa2, pa3); pv_one<3>(o[3], vb, pa0, pa1, pa2, pa3);
}
__device__ __forceinline__ void partialSM(f32x16& p0, f32x16& p1, float& m_reg, float& alpha, float C, float thr) {
    float pmax = p0[0];
#pragma unroll
    for (int r = 1; r < 16; ++r) pmax = fmaxf(pmax, p0[r]);
#pragma unroll
    for (int r = 0; r < 16; ++r) pmax = fmaxf(pmax, p1[r]);
    { auto rr = __builtin_amdgcn_permlane32_swap(__float_as_uint(pmax), __float_as_uint(pmax), false, false); pmax = fmaxf(__uint_as_float(rr[0]), __uint_as_float(rr[1])); }
    float mn;
    if (__builtin_expect(__all(pmax - m_reg <= thr), 1)) { mn = m_reg; alpha = 1.f; }
    else { mn = fmaxf(m_reg, pmax); alpha = __builtin_amdgcn_exp2f((m_reg - mn) * C); m_reg = mn; }
    const float mnC = -mn * C;
#pragma unroll
    for (int r = 0; r < 16; ++r) p0[r] = fmaf(p0[r], C, mnC);
#pragma unroll
    for (int r = 0; r < 16; ++r) p1[r] = fmaf(p1[r], C, mnC);
#pragma unroll
    for (int r = 0; r < 16; ++r) p0[r] = __builtin_amdgcn_exp2f(p0[r]);
}
__device__ __forceinline__ void finishSM(f32x16& p0, f32x16& p1, float alpha, float& l_reg, bf16x8& pa0, bf16x8& pa1, bf16x8& pa2, bf16x8& pa3) {
#pragma unroll
    for (int r = 0; r < 16; ++r) p1[r] = __builtin_amdgcn_exp2f(p1[r]);
    float ps = 0;
#pragma unroll
    for (int r = 0; r < 16; ++r) ps += p0[r];
#pragma unroll
    for (int r = 0; r < 16; ++r) ps += p1[r];
    { auto rr = __builtin_amdgcn_permlane32_swap(__float_as_uint(ps), __float_as_uint(ps), false, false); ps = __uint_as_float(rr[0]) + __uint_as_float(rr[1]); }
    l_reg = l_reg * alpha + ps;
#define PK4(P, BASE, OUT) do { unsigned a0 = cvt_pk_bf16(P[BASE + 0], P[BASE + 1]), a1 = cvt_pk_bf16(P[BASE + 2], P[BASE + 3]);   \
    unsigned b0 = cvt_pk_bf16(P[BASE + 4], P[BASE + 5]), b1 = cvt_pk_bf16(P[BASE + 6], P[BASE + 7]);                              \
    auto r0 = __builtin_amdgcn_permlane32_swap(a0, b0, false, false); auto r1 = __builtin_amdgcn_permlane32_swap(a1, b1, false, false); \
    u32x4 w = {r0[0], r1[0], r0[1], r1[1]}; OUT = __builtin_bit_cast(bf16x8, w); } while (0)
    PK4(p0, 0, pa0); PK4(p0, 8, pa1); PK4(p1, 0, pa2); PK4(p1, 8, pa3);
#undef PK4
}

struct Args {
    const bf16_t* Q; int ldq;
    const bf16_t* Kn; int ldk;
    const bf16_t* Kr; int ldkr;
    const bf16_t* V; int ldv;
    bf16_t* O; int ldo;
    int nt, n1, base1, base2;
    float scale;
    int g, rlo; const float* bias;
};

template <int DQK, bool NA>
__device__ __forceinline__ void unit(const Args& a, char* lds) {
    constexpr int ND = DQK / 16, KROW = DQK * 2, SHM_V = KVBLK * 128 * 2, SHM_K = KVBLK * KROW;
#define KSWZ(row, colB) ((row) * KROW + ((colB) ^ (((row) & 7) << 4)))
    int tid = threadIdx.x; asm volatile("" : "+v"(tid));
    const int wid = tid >> 6, lane = tid & 63, r32 = lane & 31, hi = lane >> 5;
    char* V_lds = lds; char* K_lds = lds + 2 * SHM_V;
    float* ws = (float*)(lds + 2 * SHM_V + 2 * SHM_K) + wid * 64; float* li_l = ws; float* al_l = ws + 32;
    float* bt = (float*)(lds + 2 * SHM_V + 2 * SHM_K + NW * 256);
    const float C = a.scale * 1.4426950408889634f, thr = 8.0f / a.scale;
    __syncthreads();
    if (NA) { const float inv = 1.0f / a.scale; for (int i = tid; i < 15 * 32; i += 512) { const int c = i & 31; bt[i] = (c < 31) ? a.bias[(i >> 5) * 31 + c] * inv : 0.f; } }
    float m_reg = -1e30f, l_reg = 0; f32x16 o[4] = {}; bf16x8 qr[ND];
    { const bf16_t* Qw = a.Q + (size_t)(wid * QBLK + r32) * a.ldq + hi * 8;
#pragma unroll
      for (int d0 = 0; d0 < ND; ++d0) qr[d0] = *(const bf16x8*)(Qw + d0 * 16); }
    const int sr = tid >> 4, sc = (tid & 15) * 8, vst0 = v_st(sr, sc), vst1 = v_st(32 + sr, sc);
    const int krr = tid >> 3, krc = (tid & 7) * 8;
    const int vb0 = (int)(uintptr_t)V_lds + v_rd_base(lane);
    const int qidx = wid * 32 + r32, qr_row = 4 * a.g + (qidx >> 6), qc = qidx & 63;
    const int r0w = min(max(qr_row - 4, 0), 24), csw = min(max(qc - 8, 0), 48);
    bf16x8 vs0, vs1, ks0, ks1, kr0;
#define TOKOF(j) ((j) < a.n1 ? a.base1 + 64 * (j) : a.base2 + 64 * ((j) - a.n1))
#define SLOAD(j) do { const int t0_ = TOKOF(j); \
    vs0 = *(const bf16x8*)(a.V + (size_t)(t0_ + sr) * a.ldv + sc); vs1 = *(const bf16x8*)(a.V + (size_t)(t0_ + 32 + sr) * a.ldv + sc); \
    ks0 = *(const bf16x8*)(a.Kn + (size_t)(t0_ + sr) * a.ldk + sc); ks1 = *(const bf16x8*)(a.Kn + (size_t)(t0_ + 32 + sr) * a.ldk + sc); \
    if (DQK == 192) kr0 = *(const bf16x8*)(a.Kr + (size_t)(t0_ + krr) * a.ldkr + krc); } while (0)
#define SWRITE(b) do { *(bf16x8*)(V_lds + (b) * SHM_V + vst0) = vs0; *(bf16x8*)(V_lds + (b) * SHM_V + vst1) = vs1; \
    *(bf16x8*)(K_lds + (b) * SHM_K + KSWZ(sr, sc * 2)) = ks0; *(bf16x8*)(K_lds + (b) * SHM_K + KSWZ(32 + sr, sc * 2)) = ks1; \
    if (DQK == 192) *(bf16x8*)(K_lds + (b) * SHM_K + KSWZ(krr, 256 + krc * 2)) = kr0; } while (0)
#define QKT(P0, P1, b) do { P0 = f32x16{}; P1 = f32x16{}; const char* Ks_ = K_lds + (b) * SHM_K; \
    _Pragma("unroll") for (int d0 = 0; d0 < ND; ++d0) { const int cb = (d0 * 16 + hi * 8) * 2; \
      const bf16x8 b0_ = *(const bf16x8*)(Ks_ + KSWZ(r32, cb)); const bf16x8 b1_ = *(const bf16x8*)(Ks_ + KSWZ(32 + r32, cb)); \
      P0 = __builtin_amdgcn_mfma_f32_32x32x16_bf16(b0_, qr[d0], P0, 0, 0, 0); P1 = __builtin_amdgcn_mfma_f32_32x32x16_bf16(b1_, qr[d0], P1, 0, 0, 0); } } while (0)
#define MASK(P0, P1, j) do { if (NA && (j) >= a.n1) { const int rr_ = a.rlo + (j) - a.n1; const bool rowok_ = (rr_ >= r0w) && (rr_ < r0w + 8); \
      const int drow_ = min(max(rr_ - qr_row + 7, 0), 14) * 32; \
      _Pragma("unroll") for (int i = 0; i < 16; ++i) { const int kc_ = crow(i, hi); \
        { const bool ok_ = rowok_ && (kc_ >= csw) && (kc_ < csw + 16); const float bv_ = bt[drow_ + min(max(kc_ - qc + 15, 0), 30)]; P0[i] = ok_ ? P0[i] + bv_ : -INFINITY; } \
        { const int k2_ = kc_ + 32; const bool ok_ = rowok_ && (k2_ >= csw) && (k2_ < csw + 16); const float bv_ = bt[drow_ + min(max(k2_ - qc + 15, 0), 30)]; P1[i] = ok_ ? P1[i] + bv_ : -INFINITY; } } } } while (0)
#define RESC(al) do { if (__any((al) < 1.f)) { if (hi == 0) al_l[r32] = (al); asm volatile("s_waitcnt lgkmcnt(0)" ::: "memory"); \
    _Pragma("unroll") for (int d = 0; d < 4; ++d) _Pragma("unroll") for (int r = 0; r < 16; ++r) o[d][r] *= al_l[crow(r, hi)]; } } while (0)
    f32x16 p0, p1; float al; bf16x8 pa0, pa1, pa2, pa3; const int NT = a.nt;
    SLOAD(0); SWRITE(0); __syncthreads();
    for (int j = 0; j < NT; ++j) {
        const int cb_ = j & 1;
        if (j + 1 < NT) SLOAD(j + 1);
        SBAR(); QKT(p0, p1, cb_); MASK(p0, p1, j);
        partialSM(p0, p1, m_reg, al, C, thr);
        RESC(al);
        finishSM(p0, p1, al, l_reg, pa0, pa1, pa2, pa3); SBAR();
        pv_d0(o, vb0 + cb_ * SHM_V, pa0, pa1, pa2, pa3);
        if (j + 1 < NT) SWRITE(cb_ ^ 1);
        __syncthreads();
    }
    if (hi == 0) li_l[r32] = l_reg; asm volatile("s_waitcnt lgkmcnt(0)" ::: "memory");
    float rli[16];
#pragma unroll
    for (int r = 0; r < 16; ++r) rli[r] = __builtin_amdgcn_rcpf(li_l[crow(r, hi)]);
    bf16_t* Ow = a.O + (size_t)(wid * QBLK) * a.ldo;
#pragma unroll
    for (int r = 0; r < 16; ++r) { const int orow = crow(r, hi);
#pragma unroll
        for (int d0 = 0; d0 < 4; ++d0) Ow[(size_t)orow * a.ldo + d0 * 32 + r32] = f2bf(o[d0][r] * rli[r]); }
#undef KSWZ
#undef TOKOF
#undef SLOAD
#undef SWRITE
#undef QKT
#undef MASK
#undef RESC
}
#undef SBAR
}

#define XB_TMO      128
#define XB_XCNT(j)  (256  + 64 * (j))
#define XB_XSUB(j)  (1280 + 64 * (j))
#define XB_XGEN(j)  (2304 + 64 * (j))
#define XB_TOP      3328
#define XB_TOPGEN   3392
#define XCD_BAR_WORDS 3456
#define XB_SPIN_CAP (1u << 18)
__device__ __forceinline__ unsigned xb_ld(unsigned* p)              { return __hip_atomic_load(p, __ATOMIC_RELAXED, __HIP_MEMORY_SCOPE_AGENT); }
__device__ __forceinline__ unsigned xb_add(unsigned* p, unsigned v) { return __hip_atomic_fetch_add(p, v, __ATOMIC_RELAXED, __HIP_MEMORY_SCOPE_AGENT); }
__device__ __forceinline__ unsigned xb_xcc_id() { return (unsigned)__builtin_amdgcn_s_getreg((3 << 11) | 20) & 0xFu; }
#define XB_SPIN(cond, bar) do { unsigned _sp = 0; while (cond) { __builtin_amdgcn_s_sleep(1); \
    if ((++_sp & 255u) == 0u) { if (xb_ld(&(bar)[XB_TMO])) break; if (_sp > XB_SPIN_CAP) { atomicAdd(&(bar)[XB_TMO], 1u); break; } } } } while (0)
struct XcdBarrier { unsigned* bar; unsigned x; volatile LAS unsigned* st; };
__device__ __forceinline__ XcdBarrier xcd_barrier_post(unsigned* bar, volatile LAS unsigned* st) {
    XcdBarrier b; b.bar = bar; b.x = xb_xcc_id(); b.st = st;
    if (threadIdx.x == 0) (void)xb_add(&bar[XB_XCNT(b.x)], 1u);
    return b;
}
__device__ __forceinline__ void xcd_barrier_complete(unsigned* bar, unsigned x, unsigned& nloc, unsigned& nx) {
    const unsigned G = gridDim.x * gridDim.y * gridDim.z;
    unsigned sum, cnt, mine, sp = 0u;
    for (;;) {
        sum = 0u; cnt = 0u; mine = 0u;
#pragma unroll
        for (unsigned j = 0; j < 16; ++j) { const unsigned c = xb_ld(&bar[XB_XCNT(j)]); sum += c; cnt += (c > 0u) ? 1u : 0u; mine = (j == x) ? c : mine; }
        if (sum == G) break;
        __builtin_amdgcn_s_sleep(1);
        if ((++sp & 255u) == 0u) { if (xb_ld(&bar[XB_TMO])) break; if (sp > XB_SPIN_CAP) { atomicAdd(&bar[XB_TMO], 1u); break; } }
    }
    nloc = mine > 0u ? mine : 1u; nx = cnt > 0u ? cnt : 1u;
}
__device__ __forceinline__ void xcd_barrier(const XcdBarrier& b) {
    asm volatile("s_waitcnt vmcnt(0)" ::: "memory");
    __syncthreads();
    if (threadIdx.x == 0) {
        unsigned* bar = b.bar;
        __builtin_amdgcn_s_waitcnt(0);
        unsigned nloc = b.st[0], nx = b.st[1];
        if (nloc == 0u) { xcd_barrier_complete(bar, b.x, nloc, nx); b.st[0] = nloc; b.st[1] = nx; }
        const unsigned old = xb_add(&bar[XB_XSUB(b.x)], 1u);
        const unsigned gen = old / nloc;
        if (old + 1u == (gen + 1u) * nloc) {
            __builtin_amdgcn_fence(__ATOMIC_RELEASE, "agent");
            asm volatile("s_waitcnt vmcnt(0)" ::: "memory");
            const unsigned og = xb_add(&bar[XB_TOP], 1u);
            const unsigned tg = og / nx;
            if (og + 1u == (tg + 1u) * nx) xb_add(&bar[XB_TOPGEN], 1u);
            else XB_SPIN(xb_ld(&bar[XB_TOPGEN]) == tg, bar);
            __builtin_amdgcn_fence(__ATOMIC_ACQUIRE, "agent");
            xb_add(&bar[XB_XGEN(b.x)], 1u);
            asm volatile("s_waitcnt vmcnt(0)" ::: "memory");
        } else {
            XB_SPIN(xb_ld(&bar[XB_XGEN(b.x)]) == gen, bar);
            __builtin_amdgcn_fence(__ATOMIC_ACQUIRE, "agent");
            asm volatile("s_waitcnt vmcnt(0)" ::: "memory");
        }
    }
    __syncthreads();
}

struct Params { const float* in[29]; float* out; unsigned char* ws; };
enum { I_X = 0, I_C, I_CTX, I_CCTX, I_WADA, I_BADA, I_GAPRE, I_GAPOST, I_GFPRE, I_GFPOST, I_WIN, I_HCW, I_HCB, I_FW1, I_FB1, I_FW2, I_FB2, I_FW3, I_FFREQ, I_HBIAS,
       I_GQ, I_WUQ, I_GKV, I_WUKV, I_RPB, I_WOUT, I_WG, I_WU, I_WD };

__device__ __forceinline__ const float* INP(int i) { int j = i; asm volatile("" : "+s"(j)); return ((const float* const __attribute__((address_space(4)))*)__builtin_amdgcn_kernarg_segment_ptr())[j]; }
template <class Map>
__device__ __forceinline__ void transpose_item(const float* W, int K, int N, bf16_t* WT, const float* kscale, LAS float* scr, int item, int lane, const Map& map) {
    const int nblk = N / 32, kb = item / nblk, nb = item % nblk, k0 = 64 * kb, n0 = 32 * nb;
#pragma unroll 8
    for (int i = 0; i < 32; ++i) { const int kk = 2 * i + (lane >> 5); float v = W[(size_t)(k0 + kk) * N + n0 + (lane & 31)]; if (kscale) v *= kscale[k0 + kk]; scr[kk * 33 + (lane & 31)] = v; }
    asm volatile("s_waitcnt lgkmcnt(0)" ::: "memory");
    const int c = lane & 7;
#pragma unroll
    for (int j = 0; j < 4; ++j) { const int n = (lane >> 3) + 8 * j; const LAS float* s = scr + (8 * c) * 33 + n;
        u32x4 o; o.x = cvt_pk_bf16(s[0 * 33], s[1 * 33]); o.y = cvt_pk_bf16(s[2 * 33], s[3 * 33]); o.z = cvt_pk_bf16(s[4 * 33], s[5 * 33]); o.w = cvt_pk_bf16(s[6 * 33], s[7 * 33]);
        const int drow = map(n0 + n);
        if (drow >= 0) *(u32x4*)(WT + (size_t)drow * K + k0 + 8 * c) = o; }
    asm volatile("s_waitcnt lgkmcnt(0)" ::: "memory");
}
struct MapIdent { __device__ int operator()(int n) const { return n; } };
struct MapInH   { __device__ int operator()(int n) const { return n < 1536 ? n : -1; } };
struct MapInR   { __device__ int operator()(int n) const { if (n < 1536) return -1; const int r = n - 1536; if (r >= PR_KR && r < PR_KR + 64) { const int i = r - PR_KR; return PR_KR + (i < 32 ? 2 * i : 2 * (i - 32) + 1); } return r; } };
struct MapUQ    { __device__ int operator()(int n) const { const int h = n / 192, j = n % 192; if (j < 128) return n; const int i = j - 128; return h * 192 + 128 + (i < 32 ? 2 * i : 2 * (i - 32) + 1); } };
struct MapGate  { __device__ int operator()(int n) const { return 256 * (n >> 7) + (n & 127); } };
struct MapUp    { __device__ int operator()(int n) const { return 256 * (n >> 7) + 128 + (n & 127); } };

__global__ void __launch_bounds__(512, 2) fwd_mega(Params p) {
    extern __shared__ __attribute__((aligned(16))) unsigned char lds[];
    cg::grid_group grid = cg::this_grid();
    LAS unsigned char* ldsl = (LAS unsigned char*)lds;
    const int wave = __builtin_amdgcn_readfirstlane(threadIdx.x >> 6);
    const int G = gridDim.x, bx = blockIdx.x;
    const int vcu = (G % 8 == 0) ? (bx % 8) * (G / 8) + bx / 8 : bx;
    const int gw = vcu * 8 + wave, NGW = G * 8;
#define DECL_PTRS(L) unsigned char* ws = (unsigned char*)INP(30); asm volatile("" : "+s"(ws)); int tid = threadIdx.x; asm volatile("" : "+v"(tid)); const int lane = tid & 63; (void)lane; \
    float* MOD = (float*)(ws + S_MOD); float* ROPE = (float*)(ws + S_ROPE); float* SSQ = (float*)(ws + S_SSQ); float* SSQY = (float*)(ws + S_SSQY); \
    bf16_t* FILT = (bf16_t*)(ws + S_FILT); bf16_t* FILTC = (bf16_t*)(ws + S_FILTC); \
    bf16_t* Hb = (bf16_t*)(ws + A_H); bf16_t* YC = (bf16_t*)(ws + A_YC); float* YF = (float*)(ws + A_YF); float* XR = (float*)(ws + A_XR); \
    bf16_t* PR = (bf16_t*)(ws + A_PR); bf16_t* PT = (bf16_t*)(ws + A_PT); bf16_t* Qb = (bf16_t*)(ws + A_Q); bf16_t* KVb = (bf16_t*)(ws + A_KV); bf16_t* ACT = (bf16_t*)(ws + A_ACT); \
    unsigned char* wl = ws + (size_t)(L) * WL_STRIDE; const float* mod = MOD + (size_t)(L) * 5 * ADA; \
    (void)ROPE; (void)SSQ; (void)SSQY; (void)FILT; (void)FILTC; (void)Hb; (void)YC; (void)YF; (void)XR; (void)PR; (void)PT; (void)Qb; (void)KVb; (void)ACT; (void)wl; (void)mod;

    volatile LAS unsigned* MISC = (volatile LAS unsigned*)(ldsl + 131072);
    if (threadIdx.x == 0) { MISC[0] = 0u; MISC[1] = 0u; }
    {
        DECL_PTRS(0)
        if (bx == 0) { unsigned* bz = (unsigned*)(ws + S_CTL); for (int i = tid; i < XCD_BAR_WORDS; i += 512) bz[i] = 0u; }
        if (PH(14)) {
        LAS float* sS = (LAS float*)ldsl;
        LAS float* red = (LAS float*)(ldsl + 5 * 2048 * 4);
        for (int i = tid; i < 5 * DM; i += 512) { const int m = i / DM, k = i % DM; const float v = (m < 4) ? INP(I_C)[m * DM + k] : INP(I_CCTX)[k]; sS[i] = v / (1.0f + __expf(-v)); }
        __syncthreads();
        for (int item = vcu; item < 2 * (ADA / 32); item += G) {
            const int l = item / (ADA / 32), n0 = (item % (ADA / 32)) * 32;
            const float* W = INP(I_WADA) + (size_t)l * DM * ADA + n0 + (lane & 31);
            float acc[5] = {0.f, 0.f, 0.f, 0.f, 0.f};
            const int kbase = wave * 256 + (lane >> 5);
#pragma unroll 16
            for (int kk = 0; kk < 128; ++kk) { const int k = kbase + 2 * kk; const float w = W[(size_t)k * ADA];
#pragma unroll
                for (int m = 0; m < 5; ++m) acc[m] += sS[m * DM + k] * w; }
#pragma unroll
            for (int m = 0; m < 5; ++m) { acc[m] += __shfl_xor(acc[m], 32); if (lane < 32) red[(wave * 5 + m) * 32 + lane] = acc[m]; }
            __syncthreads();
            if (tid < 160) { const int m = tid >> 5, c = tid & 31; float s = 0.f;
#pragma unroll
                for (int w = 0; w < 8; ++w) s += red[(w * 5 + m) * 32 + c];
                MOD[((size_t)l * 5 + m) * ADA + n0 + c] = s + INP(I_BADA)[(size_t)l * ADA + n0 + c]; }
            __syncthreads();
        }
        }
        for (int i = bx * 512 + tid; i < SEQ * 32; i += G * 512) { const int t = i >> 5, f = i & 31; const float pos = (f < 16) ? (float)(t >> 6) : (float)(t & 63);
            const float inv = powf(10000.0f, -(float)(f & 15) / 16.0f); const float ang = pos * inv; ROPE[2 * i] = cosf(ang); ROPE[2 * i + 1] = sinf(ang); }
        for (int l = 0; l < 2; ++l) { u32x4* z = (u32x4*)(ws + l * WL_STRIDE + W_INR + (size_t)2880 * DM * 2); const int n16 = 192 * DM * 2 / 16;
            for (int i = bx * 512 + tid; i < n16; i += G * 512) z[i] = (u32x4){0u, 0u, 0u, 0u}; }
        for (int i = bx * 512 + tid; i < 2 * HYW * 2 * 128; i += G * 512) {
            const int s = i & 127, cd = i >> 7, d = (cd & 1) * 4; bf16_t* f = FILT + (size_t)cd * FLEN;
            if (s < 64) { if (s <= d + 32) f[s] = 0; } else { const int ii = FLEN - 128 + s; if (ii >= d + 2 * SEQ + 32) f[ii] = 0; } }
        for (int i = bx * 512 + tid; i < HYW * 2 * 128; i += G * 512) {
            const int s = i & 127, cd = i >> 7, d = (cd & 1) * 4; bf16_t* f = FILTC + (size_t)cd * FLENC;
            if (s < 64) { if (s <= d + 32) f[s] = 0; } else { const int ii = FLENC - 128 + s; if (ii >= d + 2 * CTXL + 32) f[ii] = 0; } }
        __syncthreads();
        if (PH(15))
        {
            LAS float* hb = (LAS float*)(ldsl + wave * 16384);
            constexpr int ITEMS_LAT = (SEQ / 64) * 16, ITEMS_CTX = (CTXL / 64) * 16, NIT = 2 * ITEMS_LAT + ITEMS_CTX;
            for (int it = gw; it < NIT; it += NGW) {
                int set, r; if (it < ITEMS_LAT) { set = 0; r = it; } else if (it < 2 * ITEMS_LAT) { set = 1; r = it - ITEMS_LAT; } else { set = 2; r = it - 2 * ITEMS_LAT; }
                const int l = (set == 1) ? 1 : 0, n = (set == 2) ? CTXL : SEQ, pos = (r >> 4) * 64 + lane, c0 = (r & 15) * 64;
                const float* w1 = INP(I_FW1) + l * 33 * 64; const float* b1 = INP(I_FB1) + l * 64; const float* w2 = INP(I_FW2) + l * 64 * 64; const float* b2 = INP(I_FB2) + l * 64;
                const float* w3 = INP(I_FW3) + (size_t)l * 64 * 1024; const float* fr = INP(I_FFREQ) + l * 64;
                const float tt = (float)pos / (float)(n - 1);
                constexpr float INV2PI = 0.15915494309189535f;
                hb[lane] = tt;
#pragma unroll
                for (int i = 0; i < 16; ++i) { const float band = 1e-4f + (float)i * ((15.0f - 1e-4f) / 15.0f); const float rev = (float)pos * band / (float)n;
                    hb[(1 + i) * 64 + lane] = __builtin_amdgcn_cosf(rev); hb[(17 + i) * 64 + lane] = -__builtin_amdgcn_sinf(rev); }
                float h1[64];
#pragma unroll
                for (int j = 0; j < 64; ++j) h1[j] = b1[j];
                for (int i = 0; i < 33; ++i) { const float zi = hb[i * 64 + lane];
#pragma unroll
                    for (int j = 0; j < 64; ++j) h1[j] += zi * w1[i * 64 + j]; }
#pragma unroll
                for (int j = 0; j < 64; ++j) hb[j * 64 + lane] = __builtin_amdgcn_sinf(fr[j] * h1[j] * INV2PI);
#pragma unroll
                for (int j = 0; j < 64; ++j) h1[j] = b2[j];
                for (int i = 0; i < 64; ++i) { const float zi = hb[i * 64 + lane];
#pragma unroll
                    for (int j = 0; j < 64; ++j) h1[j] += zi * w2[i * 64 + j]; }
#pragma unroll
                for (int j = 0; j < 64; ++j) hb[j * 64 + lane] = __builtin_amdgcn_sinf(fr[j] * h1[j] * INV2PI);
#pragma unroll
                for (int j = 0; j < 64; ++j) h1[j] = 0.f;
                for (int i = 0; i < 64; ++i) { const float zi = hb[i * 64 + lane];
#pragma unroll
                    for (int j = 0; j < 64; ++j) h1[j] += zi * w3[i * 1024 + c0 + j]; }
                const bool bwd = c0 >= HYW; const int cb = bwd ? c0 - HYW : c0;
                bf16_t* F = (set == 2) ? FILTC : FILT + (size_t)l * HYW * 2 * FLEN; const int flen = (set == 2) ? FLENC : FLEN;
#pragma unroll
                for (int j = 0; j < 64; ++j) { const int c = cb + j;
                    const float delta = fabsf(-15.350567286626973f + (float)c * ((-3.0701134573253945f + 15.350567286626973f) / 511.0f));
                    const float kv = h1[j] * __expf(-tt * delta); const bf16_t kb = f2bf(kv);
                    bf16_t* f0 = F + (size_t)(c * 2) * flen;
                    if (!bwd) { f0[n + 32 - pos] = kb; f0[flen + 4 + n + 32 - pos] = kb; }
                    else if (pos >= 1) { f0[n + 32 + pos] = kb; f0[flen + 4 + n + 32 + pos] = kb; } }
            }
        }
        __syncthreads();
        if (PH(16))
        {
            LAS float* scr = (LAS float*)(ldsl + wave * 16384);
            constexpr int I_IN = 32 * (INC / 32), I_UQ = (QLORA / 64) * (1536 / 32), I_UKV = (KVLORA / 64) * (2048 / 32), I_OUT = 32 * 64, I_G = 32 * (FF / 32), I_D = (FF / 64) * 64;
            constexpr int PER_L = I_IN + I_UQ + I_UKV + I_OUT + 2 * I_G + I_D;
            for (int it = gw; it < 2 * PER_L; it += NGW) {
                const int l = it / PER_L; int r = it % PER_L; unsigned char* wl = ws + (size_t)l * WL_STRIDE;
                if (r < I_IN) { const int nb = r % (INC / 32); const float* W = INP(I_WIN) + (size_t)l * DM * INC;
                    if (nb < 48) transpose_item(W, DM, INC, (bf16_t*)(wl + W_INH), nullptr, scr, r, lane, MapInH()); else transpose_item(W, DM, INC, (bf16_t*)(wl + W_INR), nullptr, scr, r, lane, MapInR()); continue; } r -= I_IN;
                if (r < I_UQ) { transpose_item(INP(I_WUQ) + (size_t)l * QLORA * 1536, QLORA, 1536, (bf16_t*)(wl + W_UQ), INP(I_GQ) + l * QLORA, scr, r, lane, MapUQ()); continue; } r -= I_UQ;
                if (r < I_UKV) { transpose_item(INP(I_WUKV) + (size_t)l * KVLORA * 2048, KVLORA, 2048, (bf16_t*)(wl + W_UKV), INP(I_GKV) + l * KVLORA, scr, r, lane, MapIdent()); continue; } r -= I_UKV;
                if (r < I_OUT) { transpose_item(INP(I_WOUT) + (size_t)l * DM * DM, DM, DM, (bf16_t*)(wl + W_OUT), nullptr, scr, r, lane, MapIdent()); continue; } r -= I_OUT;
                if (r < I_G) { transpose_item(INP(I_WG) + (size_t)l * DM * FF, DM, FF, (bf16_t*)(wl + W_GU), nullptr, scr, r, lane, MapGate()); continue; } r -= I_G;
                if (r < I_G) { transpose_item(INP(I_WU) + (size_t)l * DM * FF, DM, FF, (bf16_t*)(wl + W_GU), nullptr, scr, r, lane, MapUp()); continue; } r -= I_G;
                transpose_item(INP(I_WD) + (size_t)l * FF * DM, FF, DM, (bf16_t*)(wl + W_DN), nullptr, scr, r, lane, MapIdent());
            }
        }
    }
    grid.sync();
    XcdBarrier xb = xcd_barrier_post((unsigned*)((unsigned char*)INP(30) + S_CTL), MISC);

    for (int l = 0; l < 2; ++l) {
        const int MR = (l == 0) ? TOK : NLAT;
        if (l == 0) {
            if (PH(1)) {
            DECL_PTRS(l)
            const float* gpre = INP(I_GAPRE);
            for (int row = gw; row < TOK; row += NGW) {
                const float* src = (row < NLAT) ? INP(I_X) + (size_t)row * DM : INP(I_CTX) + (size_t)(row - NLAT) * DM;
                const int bm = (row < NLAT) ? (row >> 11) : 4; const float* mrow = mod + (size_t)bm * ADA;
                f32x4 v[8]; float ss = 0.f;
#pragma unroll
                for (int j = 0; j < 8; ++j) { v[j] = *(const f32x4*)(src + 4 * lane + 256 * j); ss += pg8::dot4(v[j]); }
                const float rs = 1.0f / sqrtf(wave_sum(ss) * (1.0f / DM) + RMS_EPS);
#pragma unroll
                for (int j = 0; j < 8; ++j) { const int k = 4 * lane + 256 * j; const f32x4 gg = *(const f32x4*)(gpre + k), sh = *(const f32x4*)(mrow + k), sc = *(const f32x4*)(mrow + DM + k);
                    const f32x4 hh = v[j] * rs * gg * (sc + 1.0f) + sh; u32x2 w; w.x = cvt_pk_bf16(hh[0], hh[1]); w.y = cvt_pk_bf16(hh[2], hh[3]); *(u32x2*)(Hb + (size_t)row * DM + k) = w; }
            }
            }
            xcd_barrier(xb);
        }
        if (PH(2)) {
            DECL_PTRS(l)
            { pg8::Gemm g{Hb, (const bf16_t*)(wl + W_INR), TOK, PRW, DM, DM}; pg8::StaticOrder S; S.init(TOK, PRW, G, bx); pg8::EpiPR E{PR, SSQ, ROPE}; pg8::gemm_phase(ldsl, g, S, E); }
            { pg8::Gemm g{(const bf16_t*)(wl + W_INH), Hb, 1536, TOK, DM, DM}; pg8::StaticOrder S; S.init(1536, TOK, G, (bx + 176) % G); pg8::EpiBf16 E{PT, TOK}; pg8::gemm_phase(ldsl, g, S, E); }
        }
        xcd_barrier(xb);
        if (PH(3)) {
            DECL_PTRS(l)
            const int MQ = (l == 0) ? TOK : NLAT;
            { pg8::Gemm g{PR, (const bf16_t*)(wl + W_UQ), MQ, 1536, QLORA, PRW}; pg8::StaticOrder S; S.init(MQ, 1536, G, bx); pg8::EpiQ E{Qb, SSQ, ROPE}; pg8::gemm_phase(ldsl, g, S, E); }
            { pg8::Gemm g{PR + QLORA, (const bf16_t*)(wl + W_UKV), TOK, 2048, KVLORA, PRW}; pg8::StaticOrder S; S.init(TOK, 2048, G, (bx + 40) % G); pg8::EpiKV E{KVb, SSQ}; pg8::gemm_phase(ldsl, g, S, E); }
        }
        xcd_barrier(xb);
        {
            DECL_PTRS(l)
            char* al = (char*)lds;
            if (PH(10))
            for (int uidx = vcu; uidx < 256; uidx += G) {
                const int bh = uidx >> 3, qb = uidx & 7, b = bh >> 3, h = bh & 7; const int row0 = b * SEQ + qb * 256;
                att::Args a; a.Q = Qb + (size_t)row0 * 1536 + h * 192; a.ldq = 1536; a.Kn = KVb + h * 256; a.ldk = 2048; a.Kr = PR + PR_KR; a.ldkr = PRW; a.V = KVb + h * 256 + 128; a.ldv = 2048;
                a.O = YC + (size_t)row0 * DM + 512 + h * 128; a.ldo = DM; a.nt = 36; a.n1 = 32; a.base1 = b * SEQ; a.base2 = NLAT + b * CTXL; a.scale = MLA_SCALE; a.g = 0; a.rlo = 0; a.bias = nullptr;
                att::unit<192, false>(a, al);
            }
            const float* rpb = INP(I_RPB) + (size_t)l * 4 * 15 * 31;
            if (PH(11))
            for (int uidx = vcu; uidx < 128; uidx += G) {
                const int bh = uidx >> 3, gq = uidx & 7, b = bh >> 2, h = bh & 3; const int row0 = b * SEQ + gq * 256;
                const int rlo = min(max(4 * gq - 4, 0), 24), nr = (gq == 0 || gq == 7) ? 8 : 12;
                att::Args a; a.Q = PR + (size_t)row0 * PRW + PR_NAQ + h * 128; a.ldq = PRW; a.Kn = PR + PR_NAK + h * 128; a.ldk = PRW; a.Kr = nullptr; a.ldkr = 0; a.V = PR + PR_NAV + h * 128; a.ldv = PRW;
                a.O = YC + (size_t)row0 * DM + 1536 + h * 128; a.ldo = DM; a.nt = 4 + nr; a.n1 = 4; a.base1 = NLAT + b * CTXL; a.base2 = b * SEQ + rlo * 64; a.scale = NA_SCALE; a.g = gq; a.rlo = rlo; a.bias = rpb + h * 15 * 31;
                att::unit<128, true>(a, al);
            }
            if (l == 0 && PH(12)) {
                for (int uidx = vcu; uidx < 32; uidx += G) { const int b = uidx >> 3, h = uidx & 7; const int row0 = NLAT + b * CTXL;
                    att::Args a; a.Q = Qb + (size_t)row0 * 1536 + h * 192; a.ldq = 1536; a.Kn = KVb + h * 256; a.ldk = 2048; a.Kr = PR + PR_KR; a.ldkr = PRW; a.V = KVb + h * 256 + 128; a.ldv = 2048;
                    a.O = YC + (size_t)row0 * DM + 512 + h * 128; a.ldo = DM; a.nt = 4; a.n1 = 4; a.base1 = row0; a.base2 = row0; a.scale = MLA_SCALE; a.g = 0; a.rlo = 0; a.bias = nullptr;
                    att::unit<192, false>(a, al); }
                for (int uidx = vcu; uidx < 16; uidx += G) { const int b = uidx >> 2, h = uidx & 3; const int row0 = NLAT + b * CTXL;
                    att::Args a; a.Q = PR + (size_t)row0 * PRW + PR_NAQ + h * 128; a.ldq = PRW; a.Kn = PR + PR_NAK + h * 128; a.ldk = PRW; a.Kr = nullptr; a.ldkr = 0; a.V = PR + PR_NAV + h * 128; a.ldv = PRW;
                    a.O = YC + (size_t)row0 * DM + 1536 + h * 128; a.ldo = DM; a.nt = 4; a.n1 = 4; a.base1 = row0; a.base2 = row0; a.scale = NA_SCALE; a.g = 0; a.rlo = 0; a.bias = nullptr;
                    att::unit<128, false>(a, al); }
            }
            if (PH(13)) {
                const float* cw = INP(I_HCW) + (size_t)l * 3 * 1536; const float* cb = INP(I_HCB) + (size_t)l * 1536; const float* hbias = INP(I_HBIAS) + (size_t)l * HYW;
                const int nunits = (l == 0) ? 2 * HYW : HYW;
                for (int uidx = (vcu + 128) % G; uidx < nunits; uidx += G) {
                    const int set = uidx >= HYW ? 1 : 0, c = uidx - set * HYW, n = set ? CTXL : SEQ, col0 = set ? NLAT : 0, LZ = n + 40, flen = set ? FLENC : FLEN;
                    const bf16_t* filt = set ? FILTC + (size_t)c * 2 * FLENC : FILT + ((size_t)l * HYW + c) * 2 * FLEN;
                    bf16_t* ZS = (bf16_t*)lds;
                    bf16_t* RF = ZS + 16 * LZ;
                    bf16_t* X2S = RF + 2 * flen;
                    __syncthreads();
                    for (int i = tid; i < (16 * LZ) / 8; i += 512) ((u32x4*)ZS)[i] = (u32x4){0u, 0u, 0u, 0u};
                    for (int i = tid; i < (2 * flen) / 8; i += 512) ((u32x4*)RF)[i] = ((const u32x4*)filt)[i];
                    __syncthreads();
                    const float wv0 = cw[c], wv1 = cw[1536 + c], wv2 = cw[3072 + c], bv = cb[c];
                    const float wa0 = cw[HYW + c], wa1 = cw[1536 + HYW + c], wa2 = cw[3072 + HYW + c], ba = cb[HYW + c];
                    const float wx0 = cw[2 * HYW + c], wx1 = cw[1536 + 2 * HYW + c], wx2 = cw[3072 + 2 * HYW + c], bx2 = cb[2 * HYW + c];
                    const bf16_t* pv_ = PT + (size_t)c * TOK + col0; const bf16_t* pa_ = PT + (size_t)(HYW + c) * TOK + col0; const bf16_t* px_ = PT + (size_t)(2 * HYW + c) * TOK + col0;
                    for (int i = tid; i < n; i += 512) {
                        const int b = i / (n / 4), s0 = (i % (n / 4)) * 4; const size_t off = (size_t)b * n + s0;
                        float v[6], x1[6], x2[6];
                        { const u32x2 w = *(const u32x2*)(pv_ + off); v[1] = bf2f(w.x & 0xffff); v[2] = bf2f(w.x >> 16); v[3] = bf2f(w.y & 0xffff); v[4] = bf2f(w.y >> 16);
                          v[0] = s0 > 0 ? bf2f(pv_[off - 1]) : 0.f; v[5] = s0 + 4 < n ? bf2f(pv_[off + 4]) : 0.f; }
                        { const u32x2 w = *(const u32x2*)(pa_ + off); x1[1] = bf2f(w.x & 0xffff); x1[2] = bf2f(w.x >> 16); x1[3] = bf2f(w.y & 0xffff); x1[4] = bf2f(w.y >> 16);
                          x1[0] = s0 > 0 ? bf2f(pa_[off - 1]) : 0.f; x1[5] = s0 + 4 < n ? bf2f(pa_[off + 4]) : 0.f; }
                        { const u32x2 w = *(const u32x2*)(px_ + off); x2[1] = bf2f(w.x & 0xffff); x2[2] = bf2f(w.x >> 16); x2[3] = bf2f(w.y & 0xffff); x2[4] = bf2f(w.y >> 16);
                          x2[0] = s0 > 0 ? bf2f(px_[off - 1]) : 0.f; x2[5] = s0 + 4 < n ? bf2f(px_[off + 4]) : 0.f; }
#pragma unroll
                        for (int e = 0; e < 4; ++e) {
                            const float uv = wv0 * v[e] + wv1 * v[e + 1] + wv2 * v[e + 2] + bv, ua = wa0 * x1[e] + wa1 * x1[e + 1] + wa2 * x1[e + 2] + ba, ux = wx0 * x2[e] + wx1 * x2[e + 1] + wx2 * x2[e + 2] + bx2;
                            const bf16_t zb = f2bf(ua * uv); const int s = s0 + e;
#pragma unroll
                            for (int sg = 0; sg < 4; ++sg) ZS[(sg * 4 + b) * LZ + s + 32 - sg] = zb;
                            X2S[b * n + s] = f2bf(ux);
                        }
                    }
                    __syncthreads();
                    const int NT0 = n / 128, TPW = NT0 >= 8 ? NT0 / 8 : 1, nks = (n + 32) / 32;
                    if (wave * TPW < NT0) {
                        const int rho = lane & 15, gq4 = lane >> 4, colb = (lane & 15) >> 2, sg = lane & 3;
                        const bf16_t* zrow = ZS + (sg * 4 + colb) * LZ + 8 * gq4;
                        f32x4 acc[2][2] = {{{0.f, 0.f, 0.f, 0.f}, {0.f, 0.f, 0.f, 0.f}}, {{0.f, 0.f, 0.f, 0.f}, {0.f, 0.f, 0.f, 0.f}}};
                        const int T0a = 128 * (wave * TPW);
                        const bf16_t* ra = RF + (n - T0a - 8 * rho + 8 * gq4);
                        for (int ks = 0; ks < nks; ++ks) {
                            const bf16x8 bfr = *(const bf16x8*)(zrow + 32 * ks);
                            const bf16x8 a00 = *(const bf16x8*)(ra + 32 * ks), a01 = *(const bf16x8*)(ra + flen + 32 * ks);
                            acc[0][0] = __builtin_amdgcn_mfma_f32_16x16x32_bf16(a00, bfr, acc[0][0], 0, 0, 0);
                            acc[0][1] = __builtin_amdgcn_mfma_f32_16x16x32_bf16(a01, bfr, acc[0][1], 0, 0, 0);
                            if (TPW == 2) {
                                const bf16x8 a10 = *(const bf16x8*)(ra - 128 + 32 * ks), a11 = *(const bf16x8*)(ra - 128 + flen + 32 * ks);
                                acc[1][0] = __builtin_amdgcn_mfma_f32_16x16x32_bf16(a10, bfr, acc[1][0], 0, 0, 0);
                                acc[1][1] = __builtin_amdgcn_mfma_f32_16x16x32_bf16(a11, bfr, acc[1][1], 0, 0, 0);
                            }
                        }
                        const float hb_ = hbias[c];
#pragma unroll
                        for (int ti = 0; ti < 2; ++ti) { if (ti < TPW) {
#pragma unroll
                            for (int di = 0; di < 2; ++di)
#pragma unroll
                                for (int rg = 0; rg < 4; ++rg) { const int t = T0a + 128 * ti + 8 * (4 * gq4 + rg) + 4 * di + sg;
                                    const float zt = bf2f(ZS[colb * LZ + t + 32]), x2v = bf2f(X2S[colb * n + t]);
                                    YC[(size_t)(col0 + colb * n + t) * DM + c] = f2bf(x2v * (acc[ti][di][rg] + zt * hb_)); } } }
                    }
                }
            }
        }
        xcd_barrier(xb);
        if (PH(5)) { DECL_PTRS(l) pg8::Gemm g{YC, (const bf16_t*)(wl + W_OUT), MR, DM, DM, DM}; pg8::StaticOrder S; S.init(MR, DM, G, bx); pg8::EpiF32S E{YF, SSQY}; pg8::gemm_phase(ldsl, g, S, E); }
        xcd_barrier(xb);
        if (PH(6)) {
            DECL_PTRS(l)
            const float* gpost = INP(I_GAPOST) + l * DM; const float* gfpre = INP(I_GFPRE) + l * DM;
            for (int row = gw; row < MR; row += NGW) {
                const float* xs = (l == 0) ? ((row < NLAT) ? INP(I_X) + (size_t)row * DM : INP(I_CTX) + (size_t)(row - NLAT) * DM) : XR + (size_t)row * DM;
                const int bm = (row < NLAT) ? (row >> 11) : 4; const float* mrow = mod + (size_t)bm * ADA;
                float sy = (lane < 32) ? SSQY[(size_t)row * 32 + lane] : 0.f; sy = wave_sum(sy);
                const float rsy = 1.0f / sqrtf(sy * (1.0f / DM) + RMS_EPS);
                f32x4 v[8]; float ss = 0.f;
#pragma unroll
                for (int j = 0; j < 8; ++j) { const int k = 4 * lane + 256 * j; const f32x4 xv = *(const f32x4*)(xs + k), yv = *(const f32x4*)(YF + (size_t)row * DM + k), gg = *(const f32x4*)(gpost + k), gt = *(const f32x4*)(mrow + 2 * DM + k);
                    v[j] = xv + gt * (yv * rsy * gg); ss += pg8::dot4(v[j]); *(f32x4*)(XR + (size_t)row * DM + k) = v[j]; }
                const float rs = 1.0f / sqrtf(wave_sum(ss) * (1.0f / DM) + RMS_EPS);
#pragma unroll
                for (int j = 0; j < 8; ++j) { const int k = 4 * lane + 256 * j; const f32x4 gg = *(const f32x4*)(gfpre + k), sh = *(const f32x4*)(mrow + 3 * DM + k), sc = *(const f32x4*)(mrow + 4 * DM + k);
                    const f32x4 hh = v[j] * rs * gg * (sc + 1.0f) + sh; u32x2 w; w.x = cvt_pk_bf16(hh[0], hh[1]); w.y = cvt_pk_bf16(hh[2], hh[3]); *(u32x2*)(Hb + (size_t)row * DM + k) = w; }
            }
        }
        xcd_barrier(xb);
        if (PH(7)) { DECL_PTRS(l) pg8::Gemm g{Hb, (const bf16_t*)(wl + W_GU), MR, 2 * FF, DM, DM}; pg8::StaticOrder S; S.init(MR, 2 * FF, G, bx); pg8::EpiSwiGLU E{ACT}; pg8::gemm_phase(ldsl, g, S, E); }
        xcd_barrier(xb);
        if (PH(8)) { DECL_PTRS(l) pg8::Gemm g{ACT, (const bf16_t*)(wl + W_DN), MR, DM, FF, FF}; pg8::StaticOrder S; S.init(MR, DM, G, bx); pg8::EpiF32S E{YF, SSQY}; pg8::gemm_phase(ldsl, g, S, E); }
        xcd_barrier(xb);
        if (PH(9)) {
            DECL_PTRS(l)
            const float* gpost = INP(I_GFPOST) + l * DM; const float* gnext = INP(I_GAPRE) + DM; const float* modn = MOD + (size_t)5 * ADA;
            for (int row = gw; row < MR; row += NGW) {
                const int bm = (row < NLAT) ? (row >> 11) : 4; const float* mrow = mod + (size_t)bm * ADA; const float* mnext = modn + (size_t)bm * ADA;
                float sy = (lane < 32) ? SSQY[(size_t)row * 32 + lane] : 0.f; sy = wave_sum(sy);
                const float rsy = 1.0f / sqrtf(sy * (1.0f / DM) + RMS_EPS);
                f32x4 v[8]; float ss = 0.f;
                float* dst = (l == 0) ? XR + (size_t)row * DM : (float*)INP(29) + (size_t)row * DM;
#pragma unroll
                for (int j = 0; j < 8; ++j) { const int k = 4 * lane + 256 * j; const f32x4 xv = *(const f32x4*)(XR + (size_t)row * DM + k), yv = *(const f32x4*)(YF + (size_t)row * DM + k), gg = *(const f32x4*)(gpost + k), gt = *(const f32x4*)(mrow + 5 * DM + k);
                    v[j] = xv + gt * (yv * rsy * gg); ss += pg8::dot4(v[j]); *(f32x4*)(dst + k) = v[j]; }
                if (l == 0) {
                    const float rs = 1.0f / sqrtf(wave_sum(ss) * (1.0f / DM) + RMS_EPS);
#pragma unroll
                    for (int j = 0; j < 8; ++j) { const int k = 4 * lane + 256 * j; const f32x4 gg = *(const f32x4*)(gnext + k), sh = *(const f32x4*)(mnext + k), sc = *(const f32x4*)(mnext + DM + k);
                        const f32x4 hh = v[j] * rs * gg * (sc + 1.0f) + sh; u32x2 w; w.x = cvt_pk_bf16(hh[0], hh[1]); w.y = cvt_pk_bf16(hh[2], hh[3]); *(u32x2*)(Hb + (size_t)row * DM + k) = w; }
                }
            }
        }
        if (l == 0) xcd_barrier(xb);
    }
}

extern "C" void kernel_launch(void* const* d_in, const int* in_sizes, int n_in, void* d_out, int out_size, void* d_ws, size_t ws_size, hipStream_t stream) {
    static int grid = 0;
    if (grid == 0) {
        if (n_in != 29 || out_size != NLAT * DM || ws_size < WS_NEED) { fprintf(stderr, "kernel_launch: unexpected shapes: n_in %d out %d ws %zu\n", n_in, out_size, ws_size); grid = -1; return; }
        int dev = 0, cus = 0, per_cu = 0;
        (void)hipGetDevice(&dev); (void)hipDeviceGetAttribute(&cus, hipDeviceAttributeMultiprocessorCount, dev);
        (void)hipFuncSetAttribute((const void*)fwd_mega, hipFuncAttributeMaxDynamicSharedMemorySize, LDS_BYTES);
        (void)hipOccupancyMaxActiveBlocksPerMultiprocessor(&per_cu, (const void*)fwd_mega, 512, LDS_BYTES);
        if (per_cu < 1) { fprintf(stderr, "kernel_launch: occupancy query reports %d blocks per CU\n", per_cu); }
        grid = cus;
    }
    if (grid < 0) return;
    Params p{};
    for (int i = 0; i < 29; ++i) p.in[i] = (const float*)d_in[i];
    p.out = (float*)d_out; p.ws = (unsigned char*)d_ws;
    void* args[] = {&p};
    hipError_t e = hipLaunchCooperativeKernel((const void*)fwd_mega, dim3(grid), dim3(512), args, LDS_BYTES, stream);
    if (e != hipSuccess) fprintf(stderr, "cooperative launch failed: %s (grid %d)\n", hipGetErrorString(e), grid);
}
```

```cpp
#include <hip/hip_runtime.h>
#include <hip/hip_cooperative_groups.h>
#include <cstdio>
#include <cstdint>
namespace cg = cooperative_groups;

#define LAS __attribute__((address_space(3)))
typedef unsigned short bf16_t;
typedef short bf16x8 __attribute__((ext_vector_type(8)));
typedef short s16x4 __attribute__((ext_vector_type(4)));
typedef float f32x4 __attribute__((ext_vector_type(4)));
typedef float f32x2 __attribute__((ext_vector_type(2)));
typedef float f32x16 __attribute__((ext_vector_type(16)));
typedef unsigned u32x4 __attribute__((ext_vector_type(4)));
typedef unsigned u32x2 __attribute__((ext_vector_type(2)));

constexpr int DM = 2048, NBATCH = 4, SEQ = 2048, CTXL = 256, NLAT = NBATCH * SEQ, NCTX = NBATCH * CTXL, TOK = NLAT + NCTX;
constexpr int INC = 4416, HYW = 512, QLORA = 768, KVLORA = 512, FF = 5632, ADA = 6 * DM;
constexpr int PRW = 3072;
constexpr int PR_KR = 1280, PR_NAQ = 1344, PR_NAK = 1856, PR_NAV = 2368;
constexpr float RMS_EPS = 1e-6f;
constexpr float MLA_SCALE = 0.07216878364870322f;
constexpr float NA_SCALE = 0.08838834764831845f;

constexpr size_t MiB = 1u << 20;
constexpr size_t WL_STRIDE = 98 * MiB;
constexpr size_t W_INR = 0, W_INH = 12 * MiB, W_UQ = 18 * MiB, W_UKV = 21 * MiB, W_OUT = 23 * MiB, W_GU = 31 * MiB, W_DN = 75 * MiB;
constexpr size_t A_H = 196 * MiB, A_YC = 232 * MiB, A_YF = 268 * MiB, A_XR = 340 * MiB, A_PR = 412 * MiB, A_PT = 466 * MiB, A_Q = 493 * MiB, A_KV = 520 * MiB, A_ACT = 412 * MiB;
constexpr size_t S_MOD = 556 * MiB, S_ROPE = 557 * MiB, S_SSQ = 558 * MiB, S_SSQY = 559 * MiB, S_FILT = 561 * MiB, S_FILTC = 578 * MiB, S_CTL = 580 * MiB, S_H2T = 581 * MiB, A_YH = 583 * MiB, A_YP = 593 * MiB, A_XB = 626 * MiB, WS_NEED = 631 * MiB;
constexpr int FLEN = 2 * SEQ + 64, FLENC = 2 * CTXL + 64;

constexpr int LDS_BYTES = 147456;
#ifndef PHMASK
#define PHMASK 0xFFFFFFFFu
#endif
#define PH(n) ((PHMASK >> (n)) & 1u)
#ifndef PROBE_MULT
#define PROBE_MULT 0
#define PROBE_B0 0
#define PROBE_B1 1
#define PROBE_C0 0
#define PROBE_C1 1
#endif
#ifndef PROBE_UNIT
#define PROBE_UNIT 400
#endif
#ifndef PROBE_SUB
#define PROBE_SUB 0
#endif

__device__ __forceinline__ unsigned cvt_pk_bf16(float lo, float hi) { unsigned r; asm volatile("v_cvt_pk_bf16_f32 %0, %1, %2" : "=v"(r) : "v"(lo), "v"(hi)); return r; }
__device__ __forceinline__ bf16_t f2bf(float f) { return (bf16_t)(cvt_pk_bf16(f, 0.f) & 0xffffu); }
__device__ __forceinline__ float bf2f(bf16_t h) { return __uint_as_float(((unsigned)h) << 16); }
__device__ __forceinline__ f32x4 ldbf4(const bf16_t* p) { const u32x2 w = *(const u32x2*)p; return (f32x4){__uint_as_float(w.x << 16), __uint_as_float(w.x & 0xffff0000u), __uint_as_float(w.y << 16), __uint_as_float(w.y & 0xffff0000u)}; }
__device__ __forceinline__ void stbf4(bf16_t* p, f32x4 v) { u32x2 w; w.x = cvt_pk_bf16(v[0], v[1]); w.y = cvt_pk_bf16(v[2], v[3]); *(u32x2*)p = w; }
__device__ __forceinline__ float wave_sum(float v) {
#pragma unroll
    for (int o = 1; o < 64; o <<= 1) v += __shfl_xor(v, o);
    return v;
}

constexpr int CW_TMO = 4096, CW_XCH = 8192, CW_END = CW_XCH + 8 * 32 * 64;
#define RLX_AGENT __ATOMIC_RELAXED, __HIP_MEMORY_SCOPE_AGENT
__device__ __forceinline__ void st16f_wt(void* p, f32x4 v) { asm volatile("global_store_dwordx4 %0, %1, off sc1\n\ts_nop 1" :: "v"(p), "v"(v) : "memory"); }
__device__ __forceinline__ f32x4 ld16_sc1(const void* p) { f32x4 v; asm volatile("global_load_dwordx4 %0, %1, off sc1\n\ts_waitcnt vmcnt(0)" : "=&v"(v) : "v"(p) : "memory"); return v; }

namespace pg8 {
constexpr int BM = 256, BK = 64, HALF = 128, HTB = HALF * BK * 2, STAGE_BYTES = 8 * HTB, NXCD = 8, WGM = 8;
__host__ __device__ __forceinline__ int lds_byte(int r, int c) { const int st = (r >> 4) * 2 + (c >> 5), rr = r & 15, cc = c & 31, ob = rr * 64 + cc * 2; return st * 1024 + (ob ^ (((ob >> 9) & 1) << 5)); }
__host__ __device__ __forceinline__ void stage_rc(int b, int& R, int& C) { const int st = b / 1024, sb = b % 1024, swz = sb ^ (((sb >> 9) & 1) << 5); R = (st >> 1) * 16 + swz / 64; C = (st & 1) * 32 + (swz % 64) / 2; }
__host__ __device__ __forceinline__ int perm32(int rho) { const int n = rho >> 4, i = rho & 15; return 8 * (i >> 2) + 4 * n + (i & 3); }

struct Unit { int pm, pn, koff; };
struct Gemm { const bf16_t* A; const bf16_t* Bt; int M, N, K, lda, ldb; };

struct StaticOrder {
    int nM, nN, nwg, G, c;
    __host__ __device__ void init(int M, int N, int G_, int c_) { nM = M / BM; nN = N / BM; nwg = nM * nN; G = G_; c = c_; }
    __host__ __device__ bool next(int i, Unit& u) const {
        const long L = (long)i * G + c; if (L >= nwg) return false;
        int wgid = (int)L; { const int q = nwg / NXCD, r = nwg % NXCD, xcd = wgid % NXCD, off = wgid / NXCD; wgid = (xcd < r ? xcd * (q + 1) : r * (q + 1) + (xcd - r) * q) + off; }
        const int nig = WGM * nN, gid = wgid / nig, fm = gid * WGM, gsz = (nM - fm) < WGM ? (nM - fm) : WGM;
        u.pm = fm + ((wgid % nig) % gsz); u.pn = (wgid % nig) / gsz; u.koff = 0; return true;
    }
};

template <class Epi, class Sched>
__device__ __forceinline__ void gemm_phase(LAS unsigned char* lds, const Gemm g, const Sched& S, const Epi& E) {
    int tid = threadIdx.x; asm volatile("" : "+v"(tid));
    const int wid = __builtin_amdgcn_readfirstlane(tid >> 6), lane = tid & 63, wr = wid >> 2, wc = wid & 3, fr = lane & 15, fq = lane >> 4;
    const int K = g.K, nt = K / BK;
    unsigned voffA[2], voffB[2];
#pragma unroll
    for (int i = 0; i < 2; ++i) { int R, C; stage_rc(tid * 16 + i * 8192, R, C); const int Rb = Epi::PERM ? ((R & ~31) + perm32(R & 31)) : R;
        voffA[i] = (unsigned)(R * g.lda + C) * 2u; voffB[i] = (unsigned)(Rb * g.ldb + C) * 2u; }
    const size_t kstep = (size_t)(BK * 2);
    const size_t hstepA = (size_t)HALF * g.lda * 2, hstepB = (size_t)HALF * g.ldb * 2;
    const size_t tstepA = 2 * hstepA, tstepB = 2 * hstepB;
    const unsigned ldsw = (unsigned)wid * 1024u;
    const int aoff = lds_byte(wr * 64 + fr, fq * 8), boff = lds_byte(wc * 32 + fr, fq * 8);
#define PG8_SA(b, h) (((b) * 2 + (h)) * HTB)
#define PG8_SB(b, h) ((4 + (b) * 2 + (h)) * HTB)
#define PG8_STAGE(bufoff, gbase, voff) do { _Pragma("unroll") for (int _i = 0; _i < 2; ++_i) \
        __builtin_amdgcn_global_load_lds((const unsigned*)((const char*)(gbase) + (voff)[_i]), (LAS unsigned*)(lds + (bufoff) + ldsw + _i * 8192), 16, 0, 0); } while (0)
#define PG8_LDA(dst, b, h) do { _Pragma("unroll") for (int m = 0; m < 4; ++m) _Pragma("unroll") for (int k = 0; k < 2; ++k) dst[m][k] = *(const LAS bf16x8*)(lds + PG8_SA(b, h) + aoff + m * 2048 + k * 1024); } while (0)
#define PG8_LDB(dst, b, h) do { _Pragma("unroll") for (int n = 0; n < 2; ++n) _Pragma("unroll") for (int k = 0; k < 2; ++k) dst[n][k] = *(const LAS bf16x8*)(lds + PG8_SB(b, h) + boff + n * 2048 + k * 1024); } while (0)
#define PG8_MMA(ai, bj, At, Bt) do { __builtin_amdgcn_s_setprio(1); _Pragma("unroll") for (int m = 0; m < 4; ++m) _Pragma("unroll") for (int n = 0; n < 2; ++n) _Pragma("unroll") for (int k = 0; k < 2; ++k) \
        acc[ai][bj][m][n] = __builtin_amdgcn_mfma_f32_16x16x32_bf16(Bt[n][k], At[m][k], acc[ai][bj][m][n], 0, 0, 0); __builtin_amdgcn_s_setprio(0); } while (0)
#define PG8_WAIT_V(n) asm volatile("s_waitcnt vmcnt(" #n ")" ::: "memory")
#define PG8_WAIT_L(n) asm volatile("s_waitcnt lgkmcnt(" #n ")" ::: "memory")
#define PG8_BAR __builtin_amdgcn_s_barrier()
#define PG8_SCHED __builtin_amdgcn_sched_barrier(0)
    Unit cur, nxt; int ui = 0;
    if (!S.next(0, cur)) return;
    f32x4 acc[2][2][4][2];
#pragma unroll
    for (int a = 0; a < 2; ++a)
#pragma unroll
        for (int b = 0; b < 2; ++b)
#pragma unroll
            for (int m = 0; m < 4; ++m)
#pragma unroll
                for (int n = 0; n < 2; ++n) acc[a][b][m][n] = (f32x4){0.f, 0.f, 0.f, 0.f};
    bf16x8 At[4][2], B0[2][2], B1[2][2];
    const char* cA = (const char*)g.A + (size_t)cur.pm * tstepA + (size_t)cur.koff * 2; const char* cB = (const char*)g.Bt + (size_t)cur.pn * tstepB + (size_t)cur.koff * 2;
    PG8_STAGE(PG8_SB(0, 0), cB, voffB); PG8_STAGE(PG8_SB(0, 1), cB + hstepB, voffB); PG8_STAGE(PG8_SA(0, 0), cA, voffA); PG8_STAGE(PG8_SA(0, 1), cA + hstepA, voffA);
    if (wr == 1) PG8_BAR;
    PG8_WAIT_V(2); PG8_BAR;
    PG8_STAGE(PG8_SB(1, 0), cB + kstep, voffB); PG8_STAGE(PG8_SA(1, 0), cA + kstep, voffA); PG8_STAGE(PG8_SB(1, 1), cB + hstepB + kstep, voffB);
    PG8_WAIT_V(6); PG8_BAR;
    for (;;) {
        const bool has_next = S.next(ui + 1, nxt);
        const char* nA = has_next ? (const char*)g.A + (size_t)nxt.pm * tstepA + (size_t)nxt.koff * 2 : cA; const char* nB = has_next ? (const char*)g.Bt + (size_t)nxt.pn * tstepB + (size_t)nxt.koff * 2 : cB;
        for (int t = 0; t < nt; t += 2) {
            const bool last = (t == nt - 2);
            const char* a1 = cA + (size_t)(t + 1) * kstep;
            const char* a2 = last ? nA : cA + (size_t)(t + 2) * kstep; const char* b2 = last ? nB : cB + (size_t)(t + 2) * kstep;
            const char* a3 = a2 + kstep; const char* b3 = b2 + kstep;
            PG8_LDB(B0, 0, 0); PG8_LDB(B1, 0, 1); PG8_SCHED; PG8_LDA(At, 0, 0); PG8_STAGE(PG8_SA(1, 1), a1 + hstepA, voffA);
            PG8_WAIT_V(8); PG8_WAIT_L(0); PG8_BAR; PG8_MMA(0, 0, At, B0); PG8_MMA(0, 1, At, B1); PG8_BAR; PG8_SCHED;
            PG8_LDA(At, 0, 1); PG8_STAGE(PG8_SB(0, 0), b2, voffB); PG8_STAGE(PG8_SB(0, 1), b2 + hstepB, voffB); PG8_STAGE(PG8_SA(0, 0), a2, voffA);
            PG8_WAIT_V(8); PG8_WAIT_L(0); PG8_BAR; PG8_MMA(1, 0, At, B0); PG8_MMA(1, 1, At, B1); PG8_BAR; PG8_SCHED;
            PG8_LDB(B0, 1, 0); PG8_LDB(B1, 1, 1); PG8_SCHED; PG8_LDA(At, 1, 0); PG8_STAGE(PG8_SA(0, 1), a2 + hstepA, voffA);
            PG8_WAIT_V(8); PG8_WAIT_L(0); PG8_BAR; PG8_MMA(0, 0, At, B0); PG8_MMA(0, 1, At, B1); PG8_BAR; PG8_SCHED;
            PG8_LDA(At, 1, 1); PG8_STAGE(PG8_SB(1, 0), b3, voffB); PG8_STAGE(PG8_SB(1, 1), b3 + hstepB, voffB); PG8_STAGE(PG8_SA(1, 0), a3, voffA);
            PG8_WAIT_V(8); PG8_WAIT_L(0); PG8_BAR; PG8_MMA(1, 0, At, B0); PG8_MMA(1, 1, At, B1); PG8_BAR; PG8_SCHED;
        }
        if (wr == 0) PG8_BAR;
        if constexpr (!Epi::AFTER_DRAIN) E(acc, cur, wr, wc, fr, fq);
        if (!has_next) break;
#pragma unroll
        for (int a = 0; a < 2; ++a)
#pragma unroll
            for (int b = 0; b < 2; ++b)
#pragma unroll
                for (int m = 0; m < 4; ++m)
#pragma unroll
                    for (int n = 0; n < 2; ++n) acc[a][b][m][n] = (f32x4){0.f, 0.f, 0.f, 0.f};
        cur = nxt; cA = nA; cB = nB; ++ui;
        if (wr == 1) PG8_BAR;
    }
    PG8_WAIT_V(0);
    PG8_BAR;
    if constexpr (Epi::AFTER_DRAIN) E.fused(acc, cur, wr, wc, fr, fq, lds, wid, lane);
#undef PG8_SA
#undef PG8_SB
#undef PG8_STAGE
#undef PG8_LDA
#undef PG8_LDB
#undef PG8_MMA
#undef PG8_WAIT_V
#undef PG8_WAIT_L
#undef PG8_BAR
#undef PG8_SCHED
}

__device__ __forceinline__ float dot4(f32x4 v) { return (v[0] * v[0] + v[1] * v[1]) + (v[2] * v[2] + v[3] * v[3]); }
__device__ __forceinline__ void rope4(f32x4& v, const float* rope_row, int i0) {
    const f32x4 cs = *(const f32x4*)(rope_row + 2 * i0);
    const float a0 = v[0] * cs[0] - v[1] * cs[1], b0 = v[1] * cs[0] + v[0] * cs[1];
    const float a1 = v[2] * cs[2] - v[3] * cs[3], b1 = v[3] * cs[2] + v[2] * cs[3];
    v = (f32x4){a0, b0, a1, b1};
}
__device__ __forceinline__ u32x4 pack8(f32x4 v0, f32x4 v1) { u32x4 w; w.x = cvt_pk_bf16(v0[0], v0[1]); w.y = cvt_pk_bf16(v0[2], v0[3]); w.z = cvt_pk_bf16(v1[0], v1[1]); w.w = cvt_pk_bf16(v1[2], v1[3]); return w; }

struct EpiBf16 {
    static constexpr bool PERM = true, AFTER_DRAIN = false;
    bf16_t* O; int ldc;
    __device__ __forceinline__ void operator()(const f32x4 (&acc)[2][2][4][2], const Unit& u, int wr, int wc, int fr, int fq) const {
        const int row0 = u.pm * BM + wr * 64 + fr, col0 = u.pn * BM + wc * 32 + 8 * fq;
#pragma unroll
        for (int ai = 0; ai < 2; ++ai)
#pragma unroll
            for (int m = 0; m < 4; ++m) { bf16_t* rowp = O + (size_t)(row0 + ai * HALF + m * 16) * ldc + col0;
#pragma unroll
                for (int bj = 0; bj < 2; ++bj) *(u32x4*)(rowp + bj * HALF) = pack8(acc[ai][bj][m][0], acc[ai][bj][m][1]); }
    }
};
struct EpiPR {
    static constexpr bool PERM = true, AFTER_DRAIN = false;
    bf16_t* O; float* ssq; const float* rope;
    __device__ __forceinline__ void operator()(const f32x4 (&acc)[2][2][4][2], const Unit& u, int wr, int wc, int fr, int fq) const {
        const int row0 = u.pm * BM + wr * 64 + fr, col0 = u.pn * BM + wc * 32 + 8 * fq;
        const bool dorope = (u.pn == 5) && (wc < 2);
#pragma unroll
        for (int ai = 0; ai < 2; ++ai)
#pragma unroll
            for (int m = 0; m < 4; ++m) { const int row = row0 + ai * HALF + m * 16; bf16_t* rowp = O + (size_t)row * PRW + col0; float ss = 0.f;
#pragma unroll
                for (int bj = 0; bj < 2; ++bj) { f32x4 v0 = acc[ai][bj][m][0], v1 = acc[ai][bj][m][1];
                    if (bj == 0 && dorope && row < NLAT) { const float* rr = rope + (size_t)(row & (SEQ - 1)) * 64; const int i0 = 16 * wc + 4 * fq; rope4(v0, rr, i0); rope4(v1, rr, i0 + 2); }
                    ss += dot4(v0) + dot4(v1);
                    *(u32x4*)(rowp + bj * HALF) = pack8(v0, v1); }
                if (u.pn < 5) { ss += __shfl_xor(ss, 16); ss += __shfl_xor(ss, 32); if (fq == 0) ssq[(size_t)row * 20 + u.pn * 4 + wc] = ss; }
                asm volatile("" ::: "memory"); }
    }
};
struct EpiQ {
    static constexpr bool PERM = true, AFTER_DRAIN = false;
    bf16_t* O; const float* ssq; const float* rope;
    __device__ __forceinline__ void operator()(const f32x4 (&acc)[2][2][4][2], const Unit& u, int wr, int wc, int fr, int fq) const {
        const int row0 = u.pm * BM + wr * 64 + fr, col0 = u.pn * BM + wc * 32 + 8 * fq;
#pragma unroll
        for (int ai = 0; ai < 2; ++ai)
#pragma unroll
            for (int m = 0; m < 4; ++m) { const int row = row0 + ai * HALF + m * 16; bf16_t* rowp = O + (size_t)row * 1536 + col0;
                const f32x4* sp = (const f32x4*)(ssq + (size_t)row * 20); const f32x4 s0 = sp[0], s1 = sp[1], s2 = sp[2];
                const float tot = ((s0[0] + s0[1]) + (s0[2] + s0[3])) + ((s1[0] + s1[1]) + (s1[2] + s1[3])) + ((s2[0] + s2[1]) + (s2[2] + s2[3]));
                const float rs = 1.0f / sqrtf(tot * (1.0f / QLORA) + RMS_EPS);
#pragma unroll
                for (int bj = 0; bj < 2; ++bj) { f32x4 v0 = acc[ai][bj][m][0] * rs, v1 = acc[ai][bj][m][1] * rs;
                    const int j0 = (col0 + bj * HALF) % 192;
                    if (j0 >= 128 && row < NLAT) { const float* rr = rope + (size_t)(row & (SEQ - 1)) * 64; const int i0 = (j0 - 128) >> 1; rope4(v0, rr, i0); rope4(v1, rr, i0 + 2); }
                    *(u32x4*)(rowp + bj * HALF) = pack8(v0, v1); }
                asm volatile("" ::: "memory"); }
    }
};
struct EpiKV {
    static constexpr bool PERM = true, AFTER_DRAIN = false;
    bf16_t* O; const float* ssq;
    __device__ __forceinline__ void operator()(const f32x4 (&acc)[2][2][4][2], const Unit& u, int wr, int wc, int fr, int fq) const {
        const int row0 = u.pm * BM + wr * 64 + fr, col0 = u.pn * BM + wc * 32 + 8 * fq;
#pragma unroll
        for (int ai = 0; ai < 2; ++ai)
#pragma unroll
            for (int m = 0; m < 4; ++m) { const int row = row0 + ai * HALF + m * 16; bf16_t* rowp = O + (size_t)row * 2048 + col0;
                const f32x4* sp = (const f32x4*)(ssq + (size_t)row * 20 + 12); const f32x4 s0 = sp[0], s1 = sp[1];
                const float tot = ((s0[0] + s0[1]) + (s0[2] + s0[3])) + ((s1[0] + s1[1]) + (s1[2] + s1[3]));
                const float rs = 1.0f / sqrtf(tot * (1.0f / KVLORA) + RMS_EPS);
#pragma unroll
                for (int bj = 0; bj < 2; ++bj) *(u32x4*)(rowp + bj * HALF) = pack8(acc[ai][bj][m][0] * rs, acc[ai][bj][m][1] * rs);
                asm volatile("" ::: "memory"); }
    }
};
struct EpiF32S {
    static constexpr bool PERM = true, AFTER_DRAIN = false;
    bf16_t* C; float* ssq;
    __device__ __forceinline__ void operator()(const f32x4 (&acc)[2][2][4][2], const Unit& u, int wr, int wc, int fr, int fq) const {
        const int row0 = u.pm * BM + wr * 64 + fr, col0 = u.pn * BM + wc * 32 + 8 * fq;
#pragma unroll
        for (int ai = 0; ai < 2; ++ai)
#pragma unroll
            for (int m = 0; m < 4; ++m) { const int row = row0 + ai * HALF + m * 16; bf16_t* rowp = C + (size_t)row * DM + col0; float ss = 0.f;
#pragma unroll
                for (int bj = 0; bj < 2; ++bj) { const f32x4 v0 = acc[ai][bj][m][0], v1 = acc[ai][bj][m][1]; ss += dot4(v0) + dot4(v1); *(u32x4*)(rowp + bj * HALF) = pack8(v0, v1); }
                ss += __shfl_xor(ss, 16); ss += __shfl_xor(ss, 32); if (fq == 0) ssq[(size_t)row * 32 + u.pn * 4 + wc] = ss; }
    }
};
struct EpiSwiGLU {
    static constexpr bool PERM = true, AFTER_DRAIN = false;
    bf16_t* O;
    __device__ __forceinline__ void operator()(const f32x4 (&acc)[2][2][4][2], const Unit& u, int wr, int wc, int fr, int fq) const {
        const int row0 = u.pm * BM + wr * 64 + fr, col0 = u.pn * HALF + wc * 32 + 8 * fq;
#pragma unroll
        for (int ai = 0; ai < 2; ++ai)
#pragma unroll
            for (int m = 0; m < 4; ++m) { bf16_t* rowp = O + (size_t)(row0 + ai * HALF + m * 16) * FF + col0; f32x4 r[2];
#pragma unroll
                for (int n = 0; n < 2; ++n) { const f32x4 gt = acc[ai][0][m][n], up = acc[ai][1][m][n];
#pragma unroll
                    for (int e = 0; e < 4; ++e) { const float sg = __builtin_amdgcn_rcpf(1.0f + __builtin_amdgcn_exp2f(-1.4426950408889634f * gt[e])); r[n][e] = gt[e] * sg * up[e]; } }
                *(u32x4*)rowp = pack8(r[0], r[1]); }
    }
};
struct RowExchange { f32x4* slots; unsigned* cnt; unsigned* tmo; unsigned long long* dbg; };
template <bool XF32, bool SECOND>
struct EpiNormRes {
    static constexpr bool PERM = true, AFTER_DRAIN = true;
    const float* xf; const bf16_t* xb;
    const float* gpost; const float* gate;
    const float* g2; const float* shift2; const float* scale2;
    bf16_t* XRo; bf16_t* Ho; float* outf;
    RowExchange x1;
    __device__ __forceinline__ f32x4 ldx(unsigned o) const { if constexpr (XF32) return *(const f32x4*)(xf + o); else return ldbf4(xb + o); }
    __device__ __forceinline__ void fused(f32x4 (&acc)[2][2][4][2], const Unit& u, int wr, int wc, int fr, int fq, LAS unsigned char* lds, int wid, int lane) const {
        LAS f32x4* P = (LAS f32x4*)lds; LAS f32x2* S = (LAS f32x2*)(lds + 16384);
#define DBGS(i) do { if (x1.dbg && blockIdx.x == 0 && threadIdx.x == 0) x1.dbg[i] = __builtin_amdgcn_s_memrealtime(); } while (0)
        DBGS(0);
        const int b = u.pm >> 3, col0 = u.pn * BM + wc * 32 + 8 * fq;
        const float* gt = gate + (size_t)b * ADA;
        f32x4 G[2][2];
#pragma unroll
        for (int bj = 0; bj < 2; ++bj)
#pragma unroll
            for (int n = 0; n < 2; ++n) { const int cc = col0 + bj * HALF + n * 4; G[bj][n] = *(const f32x4*)(gpost + cc) * *(const f32x4*)(gt + cc); }
        f32x4 xl[2][2][2][2];
#define NR_LOAD(SET, AM) do { _Pragma("unroll") for (int mm = 0; mm < 2; ++mm) { const unsigned off_ = (unsigned)(u.pm * BM + ((AM) >> 1) * HALF + wr * 64 + (((AM) & 1) * 2 + mm) * 16 + fr) * DM + col0; \
            _Pragma("unroll") for (int bj = 0; bj < 2; ++bj) _Pragma("unroll") for (int n = 0; n < 2; ++n) xl[SET][mm][bj][n] = ldx(off_ + bj * HALF + n * 4); } } while (0)
        NR_LOAD(0, 0);
#pragma unroll
        for (int am = 0; am < 4; ++am) { const int ai = am >> 1, m0 = (am & 1) * 2;
            if (am + 1 < 4) NR_LOAD((am + 1) & 1, am + 1);
#pragma unroll
            for (int mm = 0; mm < 2; ++mm) { const int m = m0 + mm; f32x4 s = {0.f, 0.f, 0.f, 0.f};
#pragma unroll
                for (int bj = 0; bj < 2; ++bj)
#pragma unroll
                    for (int n = 0; n < 2; ++n) { const f32x4 y = acc[ai][bj][m][n], x = xl[am & 1][mm][bj][n], gy = G[bj][n] * y; acc[ai][bj][m][n] = gy;
                        s[0] += dot4(y); s[1] += dot4(x); s[2] += (x[0] * gy[0] + x[1] * gy[1]) + (x[2] * gy[2] + x[3] * gy[3]); s[3] += dot4(gy); }
#pragma unroll
                for (int e = 0; e < 4; ++e) { s[e] += __shfl_xor(s[e], 16); s[e] += __shfl_xor(s[e], 32); }
                if (fq == 0) P[(ai * HALF + wr * 64 + m * 16 + fr) * 4 + wc] = s; } }
#undef NR_LOAD
        asm volatile("s_waitcnt lgkmcnt(0)" ::: "memory"); __builtin_amdgcn_s_barrier(); asm volatile("" ::: "memory");
        DBGS(1);
        const int row = wid * 64 + lane;
        if (row < 256) { const f32x4 tot = (P[row * 4 + 0] + P[row * 4 + 1]) + (P[row * 4 + 2] + P[row * 4 + 3]); st16f_wt(x1.slots + ((size_t)u.pm * 256 + row) * 8 + u.pn, tot); }
        asm volatile("s_waitcnt vmcnt(0)" ::: "memory");
        if (lane == 0) __hip_atomic_fetch_add(x1.cnt + 64 * u.pm, 1u, RLX_AGENT);
        if (wid == 0) { unsigned polls = 0;
            while ((unsigned)__builtin_amdgcn_readfirstlane(__hip_atomic_load(x1.cnt + 64 * u.pm, RLX_AGENT)) < 64u) {
                if ((++polls & 255u) == 0u) { if (__builtin_amdgcn_readfirstlane(__hip_atomic_load(x1.tmo, RLX_AGENT)) != 0u) break; if (polls > (1u << 21)) { if (lane == 0) __hip_atomic_store(x1.tmo, 1u, RLX_AGENT); break; } }
                __builtin_amdgcn_s_sleep(1); } }
        asm volatile("s_waitcnt vmcnt(0) lgkmcnt(0)" ::: "memory"); __builtin_amdgcn_s_barrier(); asm volatile("" ::: "memory");
        DBGS(2);
        if (row < 256) { const f32x4* sl = x1.slots + ((size_t)u.pm * 256 + row) * 8; f32x4 t0, t1, t2, t3;
            asm volatile("global_load_dwordx4 %0, %4, off sc1\n\tglobal_load_dwordx4 %1, %4, off offset:16 sc1\n\tglobal_load_dwordx4 %2, %4, off offset:32 sc1\n\tglobal_load_dwordx4 %3, %4, off offset:48 sc1\n\ts_waitcnt vmcnt(0)"
                         : "=&v"(t0), "=&v"(t1), "=&v"(t2), "=&v"(t3) : "v"(sl) : "memory");
            f32x4 t = (t0 + t1) + (t2 + t3);
            asm volatile("global_load_dwordx4 %0, %4, off offset:64 sc1\n\tglobal_load_dwordx4 %1, %4, off offset:80 sc1\n\tglobal_load_dwordx4 %2, %4, off offset:96 sc1\n\tglobal_load_dwordx4 %3, %4, off offset:112 sc1\n\ts_waitcnt vmcnt(0)"
                         : "=&v"(t0), "=&v"(t1), "=&v"(t2), "=&v"(t3) : "v"(sl) : "memory");
            t = t + ((t0 + t1) + (t2 + t3));
            const float rsy = __builtin_amdgcn_rsqf(t[0] * (1.0f / DM) + RMS_EPS);
            const float sx2 = t[1] + (rsy + rsy) * t[2] + rsy * rsy * t[3];
            S[row] = (f32x2){rsy, __builtin_amdgcn_rsqf(fmaxf(sx2, 0.f) * (1.0f / DM) + RMS_EPS)}; }
        asm volatile("s_waitcnt lgkmcnt(0)" ::: "memory"); __builtin_amdgcn_s_barrier(); asm volatile("" ::: "memory");
        DBGS(3);
        int fr2 = fr, fq2 = fq; asm volatile("" : "+v"(fr2), "+v"(fq2)); const int col2 = u.pn * BM + wc * 32 + 8 * fq2;
        const float* sh = shift2 + (size_t)b * ADA; const float* sc = scale2 + (size_t)b * ADA;
        f32x4 gg[2][2], shv[2][2], scv[2][2];
        if constexpr (SECOND) {
#pragma unroll
            for (int bj = 0; bj < 2; ++bj)
#pragma unroll
                for (int n = 0; n < 2; ++n) { const int cc = col2 + bj * HALF + n * 4; gg[bj][n] = *(const f32x4*)(g2 + cc); shv[bj][n] = *(const f32x4*)(sh + cc); scv[bj][n] = *(const f32x4*)(sc + cc) + 1.0f; } }
#pragma unroll
        for (int am = 0; am < 4; ++am) { const int ai = am >> 1, m0 = (am & 1) * 2;
            f32x4 x2l[2][2][2];
#pragma unroll
            for (int mm = 0; mm < 2; ++mm) { const unsigned off = (unsigned)(u.pm * BM + ai * HALF + wr * 64 + (m0 + mm) * 16 + fr2) * DM + col2;
#pragma unroll
                for (int bj = 0; bj < 2; ++bj)
#pragma unroll
                    for (int n = 0; n < 2; ++n) x2l[mm][bj][n] = ldx(off + bj * HALF + n * 4); }
#pragma unroll
            for (int mm = 0; mm < 2; ++mm) { const int m = m0 + mm; const int r = ai * HALF + wr * 64 + m * 16 + fr2; const f32x2 st = S[r]; const unsigned off = (unsigned)(u.pm * BM + r) * DM + col2;
#pragma unroll
                for (int bj = 0; bj < 2; ++bj) { const unsigned o2 = off + bj * HALF;
                    const f32x4 xn0 = x2l[mm][bj][0] + acc[ai][bj][m][0] * st.x, xn1 = x2l[mm][bj][1] + acc[ai][bj][m][1] * st.x;
                    if constexpr (SECOND) { *(u32x4*)(XRo + o2) = pack8(xn0, xn1); *(u32x4*)(Ho + o2) = pack8(xn0 * st.y * gg[bj][0] * scv[bj][0] + shv[bj][0], xn1 * st.y * gg[bj][1] * scv[bj][1] + shv[bj][1]); }
                    else { *(f32x4*)(outf + o2) = xn0; *(f32x4*)(outf + o2 + 4) = xn1; } } }
            asm volatile("" ::: "memory"); }
        asm volatile("s_waitcnt lgkmcnt(0)" ::: "memory"); __builtin_amdgcn_s_barrier(); asm volatile("" ::: "memory");
        DBGS(4);
#undef DBGS
    }
};
struct CtxSplitOrder {
    int c, ksub;
    __device__ bool next(int i, Unit& u) const { if (i > 0 || c >= 128) return false; const int kp = c >> 5, r = c & 31; u.pm = 32 + (r >> 3); u.pn = r & 7; u.koff = kp * ksub; return true; }
};
struct EpiPart {
    static constexpr bool PERM = false, AFTER_DRAIN = false;
    float* P; int ksub;
    __device__ __forceinline__ void operator()(const f32x4 (&acc)[2][2][4][2], const Unit& u, int wr, int wc, int fr, int fq) const {
        const int row0 = u.pm * BM + wr * 64 + fr - NLAT, col0 = u.pn * BM + wc * 32 + 4 * fq; float* base = P + (size_t)(u.koff / ksub) * NCTX * DM;
#pragma unroll
        for (int ai = 0; ai < 2; ++ai)
#pragma unroll
            for (int m = 0; m < 4; ++m) { float* rowp = base + (size_t)(row0 + ai * HALF + m * 16) * DM + col0;
#pragma unroll
                for (int bj = 0; bj < 2; ++bj)
#pragma unroll
                    for (int n = 0; n < 2; ++n) *(f32x4*)(rowp + bj * HALF + n * 16) = acc[ai][bj][m][n]; }
    }
};
}

namespace att {
constexpr int NW = 8, QBLK = 32, KVBLK = 64;
#define SBAR() __builtin_amdgcn_sched_barrier(0)
__device__ __forceinline__ int crow(int r, int hi) { return (r & 3) + 8 * (r >> 2) + 4 * hi; }
__device__ __forceinline__ int v_st(int k, int c) { const int kk = (k & ~0xC) | ((k & 4) << 1) | ((k & 8) >> 1); return ((kk >> 3) * 4 + (c >> 5)) * 512 + ((kk & 7) * 32 + (c & 31)) * 2; }
__device__ __forceinline__ int v_rd_base(int lane) { return ((lane & 3) << 3) | (((lane >> 2) & 3) << 6) | (((lane >> 4) & 1) << 5) | (((lane >> 5) & 1) << 8); }
constexpr int v_rd_off(int d0, int ks, int half) { return d0 * 512 + ks * 4096 + half * 2048; }
template <int OFF> __device__ __forceinline__ s16x4 tr_read(int vb) { s16x4 r; asm volatile("ds_read_b64_tr_b16 %0, %1 offset:%2" : "=&v"(r) : "v"(vb), "i"(OFF) : "memory"); return r; }
template <int D0> __device__ __forceinline__ void pv_one(f32x16& od, int vb, bf16x8 pa0, bf16x8 pa1, bf16x8 pa2, bf16x8 pa3) {
    const s16x4 l0 = tr_read<v_rd_off(D0, 0, 0)>(vb), h0 = tr_read<v_rd_off(D0, 0, 1)>(vb), l1 = tr_read<v_rd_off(D0, 1, 0)>(vb), h1 = tr_read<v_rd_off(D0, 1, 1)>(vb);
    const s16x4 l2 = tr_read<v_rd_off(D0, 2, 0)>(vb), h2 = tr_read<v_rd_off(D0, 2, 1)>(vb), l3 = tr_read<v_rd_off(D0, 3, 0)>(vb), h3 = tr_read<v_rd_off(D0, 3, 1)>(vb);
    asm volatile("s_waitcnt lgkmcnt(0)" ::: "memory"); SBAR();
#define PKV(L, H) (bf16x8){L[0], L[1], L[2], L[3], H[0], H[1], H[2], H[3]}
    od = __builtin_amdgcn_mfma_f32_32x32x16_bf16(pa0, PKV(l0, h0), od, 0, 0, 0);
    od = __builtin_amdgcn_mfma_f32_32x32x16_bf16(pa1, PKV(l1, h1), od, 0, 0, 0);
    od = __builtin_amdgcn_mfma_f32_32x32x16_bf16(pa2, PKV(l2, h2), od, 0, 0, 0);
    od = __builtin_amdgcn_mfma_f32_32x32x16_bf16(pa3, PKV(l3, h3), od, 0, 0, 0);
#undef PKV
}
__device__ __forceinline__ void pv_d0(f32x16* o, int vb, bf16x8 pa0, bf16x8 pa1, bf16x8 pa2, bf16x8 pa3) {
    pv_one<0>(o[0], vb, pa0, pa1, pa2, pa3); pv_one<1>(o[1], vb, pa0, pa1, pa2, pa3); pv_one<2>(o[2], vb, pa0, pa1, pa2, pa3); pv_one<3>(o[3], vb, pa0, pa1, pa2, pa3);
}
__device__ __forceinline__ void partialSM(f32x16& p0, f32x16& p1, float& m_reg, float& alpha, float C, float thr) {
    float pmax = p0[0];
#pragma unroll
    for (int r = 1; r < 16; ++r) pmax = fmaxf(pmax, p0[r]);
#pragma unroll
    for (int r = 0; r < 16; ++r) pmax = fmaxf(pmax, p1[r]);
    { auto rr = __builtin_amdgcn_permlane32_swap(__float_as_uint(pmax), __float_as_uint(pmax), false, false); pmax = fmaxf(__uint_as_float(rr[0]), __uint_as_float(rr[1])); }
    float mn;
    if (__builtin_expect(__all(pmax - m_reg <= thr), 1)) { mn = m_reg; alpha = 1.f; }
    else { mn = fmaxf(m_reg, pmax); alpha = __builtin_amdgcn_exp2f((m_reg - mn) * C); m_reg = mn; }
    const float mnC = -mn * C;
#pragma unroll
    for (int r = 0; r < 16; ++r) p0[r] = fmaf(p0[r], C, mnC);
#pragma unroll
    for (int r = 0; r < 16; ++r) p1[r] = fmaf(p1[r], C, mnC);
#pragma unroll
    for (int r = 0; r < 16; ++r) p0[r] = __builtin_amdgcn_exp2f(p0[r]);
}
__device__ __forceinline__ void finishSM(f32x16& p0, f32x16& p1, float alpha, float& l_reg, bf16x8& pa0, bf16x8& pa1, bf16x8& pa2, bf16x8& pa3) {
#pragma unroll
    for (int r = 0; r < 16; ++r) p1[r] = __builtin_amdgcn_exp2f(p1[r]);
    float ps = 0;
#pragma unroll
    for (int r = 0; r < 16; ++r) ps += p0[r];
#pragma unroll
    for (int r = 0; r < 16; ++r) ps += p1[r];
    { auto rr = __builtin_amdgcn_permlane32_swap(__float_as_uint(ps), __float_as_uint(ps), false, false); ps = __uint_as_float(rr[0]) + __uint_as_float(rr[1]); }
    l_reg = l_reg * alpha + ps;
#define PK4(P, BASE, OUT) do { unsigned a0 = cvt_pk_bf16(P[BASE + 0], P[BASE + 1]), a1 = cvt_pk_bf16(P[BASE + 2], P[BASE + 3]);   \
    unsigned b0 = cvt_pk_bf16(P[BASE + 4], P[BASE + 5]), b1 = cvt_pk_bf16(P[BASE + 6], P[BASE + 7]);                              \
    auto r0 = __builtin_amdgcn_permlane32_swap(a0, b0, false, false); auto r1 = __builtin_amdgcn_permlane32_swap(a1, b1, false, false); \
    u32x4 w = {r0[0], r1[0], r0[1], r1[1]}; OUT = __builtin_bit_cast(bf16x8, w); } while (0)
    PK4(p0, 0, pa0); PK4(p0, 8, pa1); PK4(p1, 0, pa2); PK4(p1, 8, pa3);
#undef PK4
}

struct Args {
    const bf16_t* Q; int ldq;
    const bf16_t* Kn; int ldk;
    const bf16_t* Kr; int ldkr;
    const bf16_t* V; int ldv;
    bf16_t* O; int ldo;
    int nt, n1, base1, base2;
    float scale;
    int g, rlo; const float* bias;
};

template <int DQK, bool NA>
__device__ __forceinline__ void unit(const Args& a, char* lds) {
    constexpr int ND = DQK / 16, KROW = DQK * 2, SHM_V = KVBLK * 128 * 2, SHM_K = KVBLK * KROW;
#define KSWZ(row, colB) ((row) * KROW + ((colB) ^ (((row) & 7) << 4)))
    int tid = threadIdx.x; asm volatile("" : "+v"(tid));
    const int wid = tid >> 6, lane = tid & 63, r32 = lane & 31, hi = lane >> 5;
    char* V_lds = lds; char* K_lds = lds + 2 * SHM_V;
    float* ws = (float*)(lds + 2 * SHM_V + 2 * SHM_K) + wid * 64; float* li_l = ws; float* al_l = ws + 32;
    float* bt = (float*)(lds + 2 * SHM_V + 2 * SHM_K + NW * 256);
    const float C = a.scale * 1.4426950408889634f, thr = 8.0f / a.scale;
    __syncthreads();
    if (NA) { const float inv = 1.0f / a.scale; for (int i = tid; i < 15 * 128; i += 512) { const int c = (i & 127) - 48; bt[i] = (c >= 0 && c < 31) ? a.bias[(i >> 7) * 31 + c] * inv : 0.f; } }
    float m_reg = -1e30f, l_reg = 0; f32x16 o[4] = {}; bf16x8 qr[ND];
    { const bf16_t* Qw = a.Q + (size_t)(wid * QBLK + r32) * a.ldq + hi * 8;
#pragma unroll
      for (int d0 = 0; d0 < ND; ++d0) qr[d0] = *(const bf16x8*)(Qw + d0 * 16); }
    const int sr = tid >> 4, sc = (tid & 15) * 8, vst0 = v_st(sr, sc), vst1 = v_st(32 + sr, sc);
    const int krr = tid >> 3, krc = (tid & 7) * 8;
    const int vb0 = (int)(uintptr_t)V_lds + v_rd_base(lane);
    const int qidx = wid * 32 + r32, qr_row = 4 * a.g + (qidx >> 6), qc = qidx & 63;
    const int r0w = min(max(qr_row - 4, 0), 24), csw = min(max(qc - 8, 0), 48);
    unsigned cmask = 0u;
    if (NA) {
#pragma unroll
        for (int i = 0; i < 16; ++i) { const int kc_ = crow(i, hi); if (kc_ >= csw && kc_ < csw + 16) cmask |= 1u << i; if (kc_ + 32 >= csw && kc_ + 32 < csw + 16) cmask |= 1u << (16 + i); } }
    const float* btl = bt + (4 * hi - qc + 15 + 48);
    bf16x8 vs0, vs1, ks0, ks1, kr0;
#define TOKOF(j) ((j) < a.n1 ? a.base1 + 64 * (j) : a.base2 + 64 * ((j) - a.n1))
#define SLOAD(j) do { const int t0_ = TOKOF(j); \
    vs0 = *(const bf16x8*)(a.V + (size_t)(t0_ + sr) * a.ldv + sc); vs1 = *(const bf16x8*)(a.V + (size_t)(t0_ + 32 + sr) * a.ldv + sc); \
    ks0 = *(const bf16x8*)(a.Kn + (size_t)(t0_ + sr) * a.ldk + sc); ks1 = *(const bf16x8*)(a.Kn + (size_t)(t0_ + 32 + sr) * a.ldk + sc); \
    if (DQK == 192) kr0 = *(const bf16x8*)(a.Kr + (size_t)(t0_ + krr) * a.ldkr + krc); } while (0)
#define SWRITE(b) do { *(bf16x8*)(V_lds + (b) * SHM_V + vst0) = vs0; *(bf16x8*)(V_lds + (b) * SHM_V + vst1) = vs1; \
    *(bf16x8*)(K_lds + (b) * SHM_K + KSWZ(sr, sc * 2)) = ks0; *(bf16x8*)(K_lds + (b) * SHM_K + KSWZ(32 + sr, sc * 2)) = ks1; \
    if (DQK == 192) *(bf16x8*)(K_lds + (b) * SHM_K + KSWZ(krr, 256 + krc * 2)) = kr0; } while (0)
#define QKT(P0, P1, b) do { P0 = f32x16{}; P1 = f32x16{}; const char* Ks_ = K_lds + (b) * SHM_K; \
    _Pragma("unroll") for (int d0 = 0; d0 < ND; ++d0) { const int cb = (d0 * 16 + hi * 8) * 2; \
      const bf16x8 b0_ = *(const bf16x8*)(Ks_ + KSWZ(r32, cb)); const bf16x8 b1_ = *(const bf16x8*)(Ks_ + KSWZ(32 + r32, cb)); \
      P0 = __builtin_amdgcn_mfma_f32_32x32x16_bf16(b0_, qr[d0], P0, 0, 0, 0); P1 = __builtin_amdgcn_mfma_f32_32x32x16_bf16(b1_, qr[d0], P1, 0, 0, 0); } } while (0)
#define MASK(P0, P1, j) do { if (NA && (j) >= a.n1) { const int rr_ = a.rlo + (j) - a.n1; const float* bp_ = btl + 128 * (rr_ - qr_row + 7); \
      _Pragma("unroll") for (int i = 0; i < 16; ++i) { const int ko_ = (i & 3) + 8 * (i >> 2); \
        P0[i] = ((cmask >> i) & 1u) ? P0[i] + bp_[ko_] : -INFINITY; P1[i] = ((cmask >> (16 + i)) & 1u) ? P1[i] + bp_[ko_ + 32] : -INFINITY; } } } while (0)
#define RESC(al) do { if (__any((al) < 1.f)) { if (hi == 0) al_l[r32] = (al); asm volatile("s_waitcnt lgkmcnt(0)" ::: "memory"); \
    _Pragma("unroll") for (int d = 0; d < 4; ++d) _Pragma("unroll") for (int r = 0; r < 16; ++r) o[d][r] *= al_l[crow(r, hi)]; } } while (0)
    f32x16 p0, p1; float al; bf16x8 pa0, pa1, pa2, pa3; const int NT = a.nt;
    SLOAD(0); SWRITE(0); __syncthreads();
    for (int j = 0; j < NT; ++j) {
        const int cb_ = j & 1;
        if (j + 1 < NT) SLOAD(j + 1);
        bool live = true;
        if (NA && j >= a.n1) { const int rr_ = a.rlo + j - a.n1; const int r0u = __builtin_amdgcn_readfirstlane(r0w); live = (rr_ >= r0u) && (rr_ < r0u + 8); }
        if (live) {
        SBAR(); QKT(p0, p1, cb_); MASK(p0, p1, j);
        partialSM(p0, p1, m_reg, al, C, thr);
        RESC(al);
        finishSM(p0, p1, al, l_reg, pa0, pa1, pa2, pa3); SBAR();
        pv_d0(o, vb0 + cb_ * SHM_V, pa0, pa1, pa2, pa3);
        }
        if (j + 1 < NT) SWRITE(cb_ ^ 1);
        __syncthreads();
    }
    if (hi == 0) li_l[r32] = l_reg; asm volatile("s_waitcnt lgkmcnt(0)" ::: "memory");
    float rli[16];
#pragma unroll
    for (int r = 0; r < 16; ++r) rli[r] = __builtin_amdgcn_rcpf(li_l[crow(r, hi)]);
    bf16_t* Ow = a.O + (size_t)(wid * QBLK) * a.ldo;
#pragma unroll
    for (int r = 0; r < 16; ++r) { const int orow = crow(r, hi);
#pragma unroll
        for (int d0 = 0; d0 < 4; ++d0) Ow[(size_t)orow * a.ldo + d0 * 32 + r32] = f2bf(o[d0][r] * rli[r]); }
#undef KSWZ
#undef TOKOF
#undef SLOAD
#undef SWRITE
#undef QKT
#undef MASK
#undef RESC
}
#undef SBAR
}

template <int N, int NCH>
__device__ __forceinline__ void hyena_unit(int c0, int col0, const bf16_t* PT, const bf16_t* filt0, int fstride, bf16_t* YH, const float* cw, const float* cb, const float* hbias, unsigned char* lds) {
    constexpr int LZ = N + 40, FL = 2 * N + 64, CHB = (16 * LZ + 2 * FL + 4 * N) * 2;
    int tid = threadIdx.x; asm volatile("" : "+v"(tid));
    const int lane = tid & 63, wave = __builtin_amdgcn_readfirstlane(tid >> 6);
    __syncthreads();
    for (int i = tid; i < NCH * 16 * 40; i += 512) { const int ch = i / 640, r = (i % 640) / 40, e = i % 40, sg = r >> 2; bf16_t* zr = (bf16_t*)(lds + ch * CHB) + r * LZ;
        zr[e < 32 - sg ? e : N + 32 - sg + (e - (32 - sg))] = 0; }
    for (int i = tid; i < NCH * (2 * FL) / 8; i += 512) { const int ch = i / ((2 * FL) / 8), e = i % ((2 * FL) / 8);
        ((u32x4*)(lds + ch * CHB + 16 * LZ * 2))[e] = ((const u32x4*)(filt0 + (size_t)ch * fstride))[e]; }
    u32x2 wv[4], wa[4], wx[4]; unsigned short hv[4][2], ha[4][2], hx[4][2];
#pragma unroll
    for (int q = 0; q < 4; ++q) { const int i = tid + 512 * q, ch = i / N, ii = i % N, b = ii / (N / 4), s0 = (ii % (N / 4)) * 4, c = c0 + ch; const size_t off = (size_t)col0 + (size_t)b * N + s0;
        const bf16_t* pv_ = PT + (size_t)c * TOK + off; const bf16_t* pa_ = PT + (size_t)(HYW + c) * TOK + off; const bf16_t* px_ = PT + (size_t)(2 * HYW + c) * TOK + off;
        wv[q] = *(const u32x2*)pv_; wa[q] = *(const u32x2*)pa_; wx[q] = *(const u32x2*)px_;
        hv[q][0] = s0 > 0 ? pv_[-1] : 0; hv[q][1] = s0 + 4 < N ? pv_[4] : 0; ha[q][0] = s0 > 0 ? pa_[-1] : 0; ha[q][1] = s0 + 4 < N ? pa_[4] : 0; hx[q][0] = s0 > 0 ? px_[-1] : 0; hx[q][1] = s0 + 4 < N ? px_[4] : 0; }
#pragma unroll
    for (int q = 0; q < 4; ++q) { const int i = tid + 512 * q, ch = i / N, ii = i % N, b = ii / (N / 4), s0 = (ii % (N / 4)) * 4, c = c0 + ch;
        const float wv0 = cw[c], wv1 = cw[1536 + c], wv2 = cw[3072 + c], bv = cb[c];
        const float wa0 = cw[HYW + c], wa1 = cw[1536 + HYW + c], wa2 = cw[3072 + HYW + c], ba = cb[HYW + c];
        const float wx0 = cw[2 * HYW + c], wx1 = cw[1536 + 2 * HYW + c], wx2 = cw[3072 + 2 * HYW + c], bx2 = cb[2 * HYW + c];
        float v[6], x1[6], x2[6];
        v[0] = bf2f(hv[q][0]); v[1] = bf2f(wv[q].x & 0xffff); v[2] = bf2f(wv[q].x >> 16); v[3] = bf2f(wv[q].y & 0xffff); v[4] = bf2f(wv[q].y >> 16); v[5] = bf2f(hv[q][1]);
        x1[0] = bf2f(ha[q][0]); x1[1] = bf2f(wa[q].x & 0xffff); x1[2] = bf2f(wa[q].x >> 16); x1[3] = bf2f(wa[q].y & 0xffff); x1[4] = bf2f(wa[q].y >> 16); x1[5] = bf2f(ha[q][1]);
        x2[0] = bf2f(hx[q][0]); x2[1] = bf2f(wx[q].x & 0xffff); x2[2] = bf2f(wx[q].x >> 16); x2[3] = bf2f(wx[q].y & 0xffff); x2[4] = bf2f(wx[q].y >> 16); x2[5] = bf2f(hx[q][1]);
        float z[4], ux[4];
#pragma unroll
        for (int e = 0; e < 4; ++e) { const float uv = wv0 * v[e] + wv1 * v[e + 1] + wv2 * v[e + 2] + bv, ua = wa0 * x1[e] + wa1 * x1[e + 1] + wa2 * x1[e + 2] + ba; z[e] = ua * uv; ux[e] = wx0 * x2[e] + wx1 * x2[e + 1] + wx2 * x2[e + 2] + bx2; }
        const unsigned p01 = cvt_pk_bf16(z[0], z[1]), p23 = cvt_pk_bf16(z[2], z[3]), p12 = (p01 >> 16) | (p23 << 16);
        bf16_t* ZS = (bf16_t*)(lds + ch * CHB); bf16_t* X2S = ZS + 16 * LZ + 2 * FL;
        { u32x2 w; w.x = p01; w.y = p23; *(u32x2*)(ZS + (0 * 4 + b) * LZ + s0 + 32) = w; }
        { bf16_t* r = ZS + (2 * 4 + b) * LZ + s0 + 30; *(unsigned*)r = p01; *(unsigned*)(r + 2) = p23; }
        { bf16_t* r = ZS + (1 * 4 + b) * LZ + s0 + 31; r[0] = (bf16_t)(p01 & 0xffff); *(unsigned*)(r + 1) = p12; r[3] = (bf16_t)(p23 >> 16); }
        { bf16_t* r = ZS + (3 * 4 + b) * LZ + s0 + 29; r[0] = (bf16_t)(p01 & 0xffff); *(unsigned*)(r + 1) = p12; r[3] = (bf16_t)(p23 >> 16); }
        { u32x2 w; w.x = cvt_pk_bf16(ux[0], ux[1]); w.y = cvt_pk_bf16(ux[2], ux[3]); *(u32x2*)(X2S + b * N + s0) = w; }
    }
    __syncthreads();
    {
        const int ch = (NCH == 1) ? 0 : wave, T0a = (NCH == 1) ? 256 * wave : 0, c = c0 + ch;
        const bf16_t* ZS = (const bf16_t*)(lds + ch * CHB); const bf16_t* RF = ZS + 16 * LZ; const bf16_t* X2S = RF + 2 * FL;
        constexpr int nks = (N + 32) / 32;
        const int rho = lane & 15, gq4 = lane >> 4, colb = (lane & 15) >> 2, sg = lane & 3;
        const bf16_t* zrow = ZS + (sg * 4 + colb) * LZ + 8 * gq4;
        const bf16_t* ra = RF + (N - T0a - 8 * rho + 8 * gq4);
        f32x4 acc[2][2] = {{{0.f, 0.f, 0.f, 0.f}, {0.f, 0.f, 0.f, 0.f}}, {{0.f, 0.f, 0.f, 0.f}, {0.f, 0.f, 0.f, 0.f}}};
#define HY_LD(B, A0, A1, A2, A3, ks) do { B = *(const bf16x8*)(zrow + 32 * (ks)); A0 = *(const bf16x8*)(ra + 32 * (ks)); A1 = *(const bf16x8*)(ra + FL + 32 * (ks)); A2 = *(const bf16x8*)(ra - 128 + 32 * (ks)); A3 = *(const bf16x8*)(ra - 128 + FL + 32 * (ks)); } while (0)
#define HY_MM(B, A0, A1, A2, A3) do { acc[0][0] = __builtin_amdgcn_mfma_f32_16x16x32_bf16(A0, B, acc[0][0], 0, 0, 0); acc[0][1] = __builtin_amdgcn_mfma_f32_16x16x32_bf16(A1, B, acc[0][1], 0, 0, 0); \
            acc[1][0] = __builtin_amdgcn_mfma_f32_16x16x32_bf16(A2, B, acc[1][0], 0, 0, 0); acc[1][1] = __builtin_amdgcn_mfma_f32_16x16x32_bf16(A3, B, acc[1][1], 0, 0, 0); } while (0)
        bf16x8 b0, p0, p1, p2, p3, b1, q0, q1, q2, q3;
        HY_LD(b0, p0, p1, p2, p3, 0);
        static_assert(nks % 2 == 1, "odd step count");
        for (int ks = 0; ks + 2 < nks; ks += 2) {
            HY_LD(b1, q0, q1, q2, q3, ks + 1); __builtin_amdgcn_sched_barrier(0);
            HY_MM(b0, p0, p1, p2, p3); __builtin_amdgcn_sched_barrier(0);
            HY_LD(b0, p0, p1, p2, p3, ks + 2); __builtin_amdgcn_sched_barrier(0);
            HY_MM(b1, q0, q1, q2, q3); __builtin_amdgcn_sched_barrier(0);
        }
        HY_MM(b0, p0, p1, p2, p3);
#undef HY_LD
#undef HY_MM
        const float hb_ = hbias[c];
        bf16_t* OS = (bf16_t*)(lds + NCH * CHB) + ch * 4 * N;
#pragma unroll
        for (int ti = 0; ti < 2; ++ti)
#pragma unroll
            for (int di = 0; di < 2; ++di)
#pragma unroll
                for (int rg = 0; rg < 4; ++rg) { const int t = T0a + 128 * ti + 8 * (4 * gq4 + rg) + 4 * di + sg;
                    const float zt = bf2f(ZS[colb * LZ + t + 32]), x2v = bf2f(X2S[colb * N + t]);
                    OS[colb * N + t] = f2bf(x2v * (acc[ti][di][rg] + zt * hb_)); }
    }
    __syncthreads();
#pragma unroll
    for (int j = 0; j < (NCH * 4 * N) / (8 * 512); ++j) { const int e = (tid + 512 * j) * 8, ch = e / (4 * N), r = e % (4 * N);
        *(u32x4*)(YH + (size_t)(c0 + ch) * TOK + col0 + r) = *(const u32x4*)((const bf16_t*)(lds + NCH * CHB) + e); }
}

#define XB_TMO      128
#define XB_XCNT(j)  (256  + 64 * (j))
#define XB_XSUB(j)  (1280 + 64 * (j))
#define XB_XGEN(j)  (2304 + 64 * (j))
#define XB_TOP      3328
#define XB_TOPGEN   3392
#define XCD_BAR_WORDS 3456
#define XB_SPIN_CAP (1u << 18)
__device__ __forceinline__ unsigned xb_ld(unsigned* p)              { return __hip_atomic_load(p, __ATOMIC_RELAXED, __HIP_MEMORY_SCOPE_AGENT); }
__device__ __forceinline__ unsigned xb_add(unsigned* p, unsigned v) { return __hip_atomic_fetch_add(p, v, __ATOMIC_RELAXED, __HIP_MEMORY_SCOPE_AGENT); }
__device__ __forceinline__ unsigned xb_xcc_id() { return (unsigned)__builtin_amdgcn_s_getreg((3 << 11) | 20) & 0xFu; }
#define XB_SPIN(cond, bar) do { unsigned _sp = 0; while (cond) { __builtin_amdgcn_s_sleep(1); \
    if ((++_sp & 255u) == 0u) { if (xb_ld(&(bar)[XB_TMO])) break; if (_sp > XB_SPIN_CAP) { atomicAdd(&(bar)[XB_TMO], 1u); break; } } } } while (0)
struct XcdBarrier { unsigned* bar; volatile LAS unsigned* st; };
__device__ __forceinline__ XcdBarrier xcd_barrier_post(unsigned* bar, volatile LAS unsigned* st) {
    XcdBarrier b; b.bar = bar; b.st = st;
    if (threadIdx.x == 0) (void)xb_add(&bar[XB_XCNT(xb_xcc_id())], 1u);
    return b;
}
__device__ __forceinline__ void xcd_barrier_complete(unsigned* bar, unsigned x, unsigned& nloc, unsigned& nx) {
    const unsigned G = gridDim.x * gridDim.y * gridDim.z;
    unsigned sum, cnt, mine, sp = 0u;
    for (;;) {
        sum = 0u; cnt = 0u; mine = 0u;
#pragma unroll
        for (unsigned j = 0; j < 16; ++j) { const unsigned c = xb_ld(&bar[XB_XCNT(j)]); sum += c; cnt += (c > 0u) ? 1u : 0u; mine = (j == x) ? c : mine; }
        if (sum == G) break;
        __builtin_amdgcn_s_sleep(1);
        if ((++sp & 255u) == 0u) { if (xb_ld(&bar[XB_TMO])) break; if (sp > XB_SPIN_CAP) { atomicAdd(&bar[XB_TMO], 1u); break; } }
    }
    nloc = mine > 0u ? mine : 1u; nx = cnt > 0u ? cnt : 1u;
}
__device__ __forceinline__ void xcd_barrier(const XcdBarrier& b) {
    asm volatile("s_waitcnt vmcnt(0)" ::: "memory");
    __syncthreads();
    if (threadIdx.x == 0) {
        unsigned* bar = b.bar; asm volatile("" : "+s"(bar));
        __builtin_amdgcn_s_waitcnt(0);
        const unsigned bxid = xb_xcc_id();
        unsigned nloc = b.st[0], nx = b.st[1];
        if (nloc == 0u) { xcd_barrier_complete(bar, bxid, nloc, nx); b.st[0] = nloc; b.st[1] = nx; }
        const unsigned old = xb_add(&bar[XB_XSUB(bxid)], 1u);
        const unsigned gen = old / nloc;
        if (old + 1u == (gen + 1u) * nloc) {
            __builtin_amdgcn_fence(__ATOMIC_RELEASE, "agent");
            asm volatile("s_waitcnt vmcnt(0)" ::: "memory");
            const unsigned og = xb_add(&bar[XB_TOP], 1u);
            const unsigned tg = og / nx;
            if (og + 1u == (tg + 1u) * nx) xb_add(&bar[XB_TOPGEN], 1u);
            else XB_SPIN(xb_ld(&bar[XB_TOPGEN]) == tg, bar);
            __builtin_amdgcn_fence(__ATOMIC_ACQUIRE, "agent");
            xb_add(&bar[XB_XGEN(bxid)], 1u);
            asm volatile("s_waitcnt vmcnt(0)" ::: "memory");
        } else {
            XB_SPIN(xb_ld(&bar[XB_XGEN(bxid)]) == gen, bar);
            __builtin_amdgcn_fence(__ATOMIC_ACQUIRE, "agent");
            asm volatile("s_waitcnt vmcnt(0)" ::: "memory");
        }
    }
    __syncthreads();
}

struct Params { const float* in[29]; float* out; unsigned char* ws; };
enum { I_X = 0, I_C, I_CTX, I_CCTX, I_WADA, I_BADA, I_GAPRE, I_GAPOST, I_GFPRE, I_GFPOST, I_WIN, I_HCW, I_HCB, I_FW1, I_FB1, I_FW2, I_FB2, I_FW3, I_FFREQ, I_HBIAS,
       I_GQ, I_WUQ, I_GKV, I_WUKV, I_RPB, I_WOUT, I_WG, I_WU, I_WD };

__device__ __forceinline__ const float* INP(int i) { int j = i; asm volatile("" : "+s"(j)); return ((const float* const __attribute__((address_space(4)))*)__builtin_amdgcn_kernarg_segment_ptr())[j]; }
template <class Map>
__device__ __forceinline__ void transpose_item(const float* W, int K, int N, bf16_t* WT, const float* kscale, LAS float* scr, int item, int lane, const Map& map) {
    const int nblk = N / 32, kb = item / nblk, nb = item % nblk, k0 = 64 * kb, n0 = 32 * nb;
    f32x4 ld[8];
#pragma unroll
    for (int j = 0; j < 8; ++j) ld[j] = __builtin_nontemporal_load((const f32x4*)(W + (size_t)(k0 + 8 * j + (lane >> 3)) * N + n0 + 4 * (lane & 7)));
#pragma unroll
    for (int j = 0; j < 8; ++j) { const int kk = 8 * j + (lane >> 3); f32x4 v = ld[j]; if (kscale) v = v * kscale[k0 + kk];
#pragma unroll
        for (int e = 0; e < 4; ++e) scr[kk * 33 + 4 * (lane & 7) + e] = v[e]; }
    asm volatile("s_waitcnt lgkmcnt(0)" ::: "memory");
    const int c = lane & 7;
#pragma unroll
    for (int j = 0; j < 4; ++j) { const int n = (lane >> 3) + 8 * j; const LAS float* s = scr + (8 * c) * 33 + n;
        u32x4 o; o.x = cvt_pk_bf16(s[0 * 33], s[1 * 33]); o.y = cvt_pk_bf16(s[2 * 33], s[3 * 33]); o.z = cvt_pk_bf16(s[4 * 33], s[5 * 33]); o.w = cvt_pk_bf16(s[6 * 33], s[7 * 33]);
        const int drow = map(n0 + n);
        if (drow >= 0) *(u32x4*)(WT + (size_t)drow * K + k0 + 8 * c) = o; }
    asm volatile("s_waitcnt lgkmcnt(0)" ::: "memory");
}
struct MapIdent { __device__ int operator()(int n) const { return n; } };
struct MapInH   { __device__ int operator()(int n) const { return n < 1536 ? n : -1; } };
struct MapInR   { __device__ int operator()(int n) const { if (n < 1536) return -1; const int r = n - 1536; if (r >= PR_KR && r < PR_KR + 64) { const int i = r - PR_KR; return PR_KR + (i < 32 ? 2 * i : 2 * (i - 32) + 1); } return r; } };
struct MapUQ    { __device__ int operator()(int n) const { const int h = n / 192, j = n % 192; if (j < 128) return n; const int i = j - 128; return h * 192 + 128 + (i < 32 ? 2 * i : 2 * (i - 32) + 1); } };
struct MapGate  { __device__ int operator()(int n) const { return 256 * (n >> 7) + (n & 127); } };
struct MapUp    { __device__ int operator()(int n) const { return 256 * (n >> 7) + 128 + (n & 127); } };

__global__ void __launch_bounds__(512, 2) fwd_mega(Params p) {
    extern __shared__ __attribute__((aligned(16))) unsigned char lds[];
    cg::grid_group grid = cg::this_grid();
    LAS unsigned char* ldsl = (LAS unsigned char*)lds;
    const int wave = __builtin_amdgcn_readfirstlane(threadIdx.x >> 6);
    const int G = gridDim.x, NGW = G * 8;
#define bx0 ((int)blockIdx.x)
#define DECL_PTRS(L) unsigned char* ws = (unsigned char*)INP(30); asm volatile("" : "+s"(ws)); int tid = threadIdx.x; asm volatile("" : "+v"(tid)); const int lane = tid & 63; (void)lane; \
    int bx = blockIdx.x; asm volatile("" : "+s"(bx)); const int vcu = (G % 8 == 0) ? (bx % 8) * (G / 8) + bx / 8 : bx; const int gw = vcu * 8 + wave; (void)gw;   \
    float* MOD = (float*)(ws + S_MOD); float* ROPE = (float*)(ws + S_ROPE); float* SSQ = (float*)(ws + S_SSQ); float* SSQY = (float*)(ws + S_SSQY); \
    bf16_t* FILT = (bf16_t*)(ws + S_FILT); bf16_t* FILTC = (bf16_t*)(ws + S_FILTC); \
    bf16_t* Hb = (bf16_t*)(ws + A_H); bf16_t* YC = (bf16_t*)(ws + A_YC); bf16_t* YF = (bf16_t*)(ws + A_YF); bf16_t* XR = (bf16_t*)(ws + A_XR); \
    bf16_t* PR = (bf16_t*)(ws + A_PR); bf16_t* PT = (bf16_t*)(ws + A_PT); bf16_t* Qb = (bf16_t*)(ws + A_Q); bf16_t* KVb = (bf16_t*)(ws + A_KV); bf16_t* ACT = (bf16_t*)(ws + A_ACT); \
    unsigned char* wl = ws + (size_t)(L) * WL_STRIDE; const float* mod = MOD + (size_t)(L) * 5 * ADA; \
    (void)ROPE; (void)SSQ; (void)SSQY; (void)FILT; (void)FILTC; (void)Hb; (void)YC; (void)YF; (void)XR; (void)PR; (void)PT; (void)Qb; (void)KVb; (void)ACT; (void)wl; (void)mod;

#if PROBE_MULT
    unsigned long long* stamps = (unsigned long long*)((unsigned char*)INP(30) + S_CTL + 65536); int sidx = 0;
#define STAMP() do { if (bx0 == 0 && threadIdx.x == 0) stamps[sidx] = __builtin_amdgcn_s_memrealtime(); ++sidx; } while (0)
#else
#define STAMP() do {} while (0)
#endif
#if PROBE_MULT
#define DBGP(set) (stamps + 40 + 8 * (set))
#else
#define DBGP(set) nullptr
#endif
    STAMP();
    volatile LAS unsigned* MISC = (volatile LAS unsigned*)(ldsl + 131072);
    if (threadIdx.x == 0) { MISC[0] = 0u; MISC[1] = 0u; }
    {
        DECL_PTRS(0)
        { unsigned* bz = (unsigned*)(ws + S_CTL); for (int i = bx * 512 + tid; i < CW_END; i += G * 512) bz[i] = 0u; }
        for (int i = bx * 512 + tid; i < SEQ * 32; i += G * 512) { const int t = i >> 5, f = i & 31; const float pos = (f < 16) ? (float)(t >> 6) : (float)(t & 63);
            const float inv = powf(10000.0f, -(float)(f & 15) / 16.0f); const float ang = pos * inv; ROPE[2 * i] = cosf(ang); ROPE[2 * i + 1] = sinf(ang); }
        for (int l = 0; l < 2; ++l) { u32x4* z = (u32x4*)(ws + l * WL_STRIDE + W_INR + (size_t)2880 * DM * 2); const int n16 = 192 * DM * 2 / 16;
            for (int i = bx * 512 + tid; i < n16; i += G * 512) z[i] = (u32x4){0u, 0u, 0u, 0u}; }
        for (int i = bx * 512 + tid; i < 2 * HYW * 2 * 128; i += G * 512) {
            const int s = i & 127, cd = i >> 7, d = (cd & 1) * 4; bf16_t* f = FILT + (size_t)cd * FLEN;
            if (s < 64) { if (s <= d + 32) f[s] = 0; } else { const int ii = FLEN - 128 + s; if (ii >= d + 2 * SEQ + 32) f[ii] = 0; } }
        for (int i = bx * 512 + tid; i < HYW * 2 * 128; i += G * 512) {
            const int s = i & 127, cd = i >> 7, d = (cd & 1) * 4; bf16_t* f = FILTC + (size_t)cd * FLENC;
            if (s < 64) { if (s <= d + 32) f[s] = 0; } else { const int ii = FLENC - 128 + s; if (ii >= d + 2 * CTXL + 32) f[ii] = 0; } }
        if (vcu < 192) {
            if (PH(14)) {
            LAS float* sS = (LAS float*)ldsl;
            LAS float* red = (LAS float*)(ldsl + 5 * 2048 * 4);
            for (int i = tid; i < 5 * DM; i += 512) { const int m = i / DM, k = i % DM; const float v = (m < 4) ? INP(I_C)[m * DM + k] : INP(I_CCTX)[k]; sS[i] = v / (1.0f + __expf(-v)); }
            __syncthreads();
            {
                const int item = vcu, l = item / 96, n0 = (item % 96) * 128;
                const float* W = INP(I_WADA) + (size_t)l * DM * ADA + n0 + 4 * (lane & 31);
                f32x4 acc[5];
#pragma unroll
                for (int m = 0; m < 5; ++m) acc[m] = (f32x4){0.f, 0.f, 0.f, 0.f};
                const int kbase = wave * 256 + (lane >> 5);
#pragma unroll 16
                for (int kk = 0; kk < 128; ++kk) { const int k = kbase + 2 * kk; const f32x4 w = __builtin_nontemporal_load((const f32x4*)(W + (size_t)k * ADA));
#pragma unroll
                    for (int m = 0; m < 5; ++m) acc[m] += w * sS[m * DM + k]; }
#pragma unroll
                for (int m = 0; m < 5; ++m) {
#pragma unroll
                    for (int e = 0; e < 4; ++e) acc[m][e] += __shfl_xor(acc[m][e], 32);
                    if (lane < 32) *(LAS f32x4*)(red + (wave * 5 + m) * 128 + 4 * lane) = acc[m]; }
                __syncthreads();
                for (int i = tid; i < 640; i += 512) { const int m = i >> 7, c = i & 127; float s = 0.f;
#pragma unroll
                    for (int w = 0; w < 8; ++w) s += red[(w * 5 + m) * 128 + c];
                    MOD[((size_t)l * 5 + m) * ADA + n0 + c] = s + INP(I_BADA)[(size_t)l * ADA + n0 + c]; }
            }
            }
        } else if (PH(15)) {
            LAS float* tb = (LAS float*)(ldsl + wave * 16384);
            float* H2T = (float*)(ws + S_H2T);
            for (int it = (vcu - 192) * 8 + wave; it < 136; it += (G - 192) * 8) {
                const int set = it < 64 ? 0 : (it < 128 ? 1 : 2), r = it - 64 * set, l = (set == 1) ? 1 : 0, n = (set == 2) ? CTXL : SEQ, pos0 = r * 32, li = lane & 31, hh = lane >> 5;
                const float* w1 = INP(I_FW1) + l * 33 * 64; const float* b1 = INP(I_FB1) + l * 64; const float* w2 = INP(I_FW2) + l * 64 * 64; const float* b2 = INP(I_FB2) + l * 64; const float* fr = INP(I_FFREQ) + l * 64;
                constexpr float INV2PI = 0.15915494309189535f;
                const int pos = pos0 + li;
                f32x16 acc[2] = {f32x16{}, f32x16{}};
#pragma unroll
                for (int s = 0; s < 17; ++s) { const int k = 2 * s + hh; float a;
                    if (k == 0) a = (float)pos / (float)(n - 1);
                    else if (k == 33) a = 0.f;
                    else { const int bi = (k - 1) & 15; const float band = 1e-4f + (float)bi * ((15.0f - 1e-4f) / 15.0f); const float rev = (float)pos * band / (float)n;
                        a = (k <= 16) ? __builtin_amdgcn_cosf(rev) : -__builtin_amdgcn_sinf(rev); }
                    const int kc = k < 33 ? k : 32;
#pragma unroll
                    for (int cb = 0; cb < 2; ++cb) { const float b = (k < 33) ? w1[kc * 64 + 32 * cb + li] : 0.f; acc[cb] = __builtin_amdgcn_mfma_f32_32x32x2f32(a, b, acc[cb], 0, 0, 0); } }
#pragma unroll
                for (int cb = 0; cb < 2; ++cb) { const int j = 32 * cb + li; const float frj = fr[j] * INV2PI, bj = b1[j];
#pragma unroll
                    for (int rg = 0; rg < 16; ++rg) { const int prow = (rg & 3) + 8 * (rg >> 2) + 4 * hh; tb[prow * 65 + j] = __builtin_amdgcn_sinf(frj * (acc[cb][rg] + bj)); } }
                asm volatile("s_waitcnt lgkmcnt(0)" ::: "memory");
                acc[0] = f32x16{}; acc[1] = f32x16{};
#pragma unroll 8
                for (int s = 0; s < 32; ++s) { const int k = 2 * s + hh; const float a = tb[li * 65 + k];
#pragma unroll
                    for (int cb = 0; cb < 2; ++cb) acc[cb] = __builtin_amdgcn_mfma_f32_32x32x2f32(a, w2[k * 64 + 32 * cb + li], acc[cb], 0, 0, 0); }
                asm volatile("s_waitcnt lgkmcnt(0)" ::: "memory");
#pragma unroll
                for (int cb = 0; cb < 2; ++cb) { const int j = 32 * cb + li; const float frj = fr[j] * INV2PI, bj = b2[j]; float* o = H2T + (size_t)set * 64 * SEQ + (size_t)j * n + pos0;
#pragma unroll
                    for (int rg = 0; rg < 16; ++rg) { const int prow = (rg & 3) + 8 * (rg >> 2) + 4 * hh; o[prow] = __builtin_amdgcn_sinf(frj * (acc[cb][rg] + bj)); } }
            }
        }
    }
    grid.sync();
    STAMP();
    XcdBarrier xb = xcd_barrier_post((unsigned*)((unsigned char*)INP(30) + S_CTL), MISC);
    {
        DECL_PTRS(0)
        LAS float* scr = (LAS float*)(ldsl + wave * 16384);
        constexpr int I_IN = 32 * (INC / 32), I_UQ = (QLORA / 64) * (1536 / 32), I_UKV = (KVLORA / 64) * (2048 / 32), I_OUT = 32 * 64, I_G = 32 * (FF / 32), I_D = (FF / 64) * 64;
        constexpr int PER_L = I_IN + I_UQ + I_UKV + I_OUT + 2 * I_G + I_D;
        constexpr int N_F3 = 2 * (SEQ / 32) * 8 + (CTXL / 32) * 8, N_TR = 2 * PER_L, N_ALL = N_F3 + N_TR + TOK;
        for (int it0 = gw; it0 < N_ALL; it0 += NGW) {
            int it = it0;
            if (it < N_F3) {
                if (!PH(15)) continue;
                int set, r; if (it < 512) { set = 0; r = it; } else if (it < 1024) { set = 1; r = it - 512; } else { set = 2; r = it - 1024; }
                const int l = (set == 1) ? 1 : 0, n = (set == 2) ? CTXL : SEQ, pos0 = (r >> 3) * 32, c0 = (r & 7) * 128, li = lane & 31, hh = lane >> 5;
                const float* H2T = (const float*)(ws + S_H2T) + (size_t)set * 64 * SEQ + pos0 + li; const float* w3 = INP(I_FW3) + (size_t)l * 64 * 1024 + c0 + li;
                f32x16 acc[4];
#pragma unroll
                for (int cb = 0; cb < 4; ++cb) acc[cb] = f32x16{};
#pragma unroll 8
                for (int s = 0; s < 32; ++s) { const int k = 2 * s + hh; const float a = H2T[(size_t)k * n];
#pragma unroll
                    for (int cb = 0; cb < 4; ++cb) acc[cb] = __builtin_amdgcn_mfma_f32_32x32x2f32(a, w3[k * 1024 + 32 * cb], acc[cb], 0, 0, 0); }
                bf16_t* F = (set == 2) ? FILTC : FILT + (size_t)l * HYW * 2 * FLEN; const int flen = (set == 2) ? FLENC : FLEN;
                const float invn = 1.0f / (float)(n - 1);
#pragma unroll
                for (int cb = 0; cb < 4; ++cb) {
                    const int cabs = c0 + 32 * cb + li, ch = cabs & (HYW - 1);
                    const float delta = fabsf(-15.350567286626973f + (float)ch * ((-3.0701134573253945f + 15.350567286626973f) / 511.0f));
#pragma unroll
                    for (int rg = 0; rg < 16; ++rg) { const int prow = (rg & 3) + 8 * (rg >> 2) + 4 * hh; scr[li * 33 + prow] = acc[cb][rg] * __expf(-(float)(pos0 + prow) * invn * delta); }
                    asm volatile("s_waitcnt lgkmcnt(0)" ::: "memory");
                    const int pos = pos0 + li;
#pragma unroll 4
                    for (int i2 = 0; i2 < 16; ++i2) { const int col = 2 * i2 + hh, c2 = c0 + 32 * cb + col; const bool bwd = c2 >= HYW; const bf16_t kb = f2bf(scr[col * 33 + li]);
                        bf16_t* f0 = F + (size_t)((c2 & (HYW - 1)) * 2) * flen;
                        if (!bwd) { f0[n + 32 - pos] = kb; f0[flen + 4 + n + 32 - pos] = kb; }
                        else if (pos >= 1) { f0[n + 32 + pos] = kb; f0[flen + 4 + n + 32 + pos] = kb; } }
                    asm volatile("s_waitcnt lgkmcnt(0)" ::: "memory");
                }
                continue;
            }
            it -= N_F3;
            if (it < N_TR) {
                if (!PH(16)) continue;
                const int l = it / PER_L; int r = it % PER_L; unsigned char* wl2 = ws + (size_t)l * WL_STRIDE;
                if (r < I_IN) { const int nb = r % (INC / 32); const float* W = INP(I_WIN) + (size_t)l * DM * INC;
                    if (nb < 48) transpose_item(W, DM, INC, (bf16_t*)(wl2 + W_INH), nullptr, scr, r, lane, MapInH()); else transpose_item(W, DM, INC, (bf16_t*)(wl2 + W_INR), nullptr, scr, r, lane, MapInR()); continue; } r -= I_IN;
                if (r < I_UQ) { transpose_item(INP(I_WUQ) + (size_t)l * QLORA * 1536, QLORA, 1536, (bf16_t*)(wl2 + W_UQ), INP(I_GQ) + l * QLORA, scr, r, lane, MapUQ()); continue; } r -= I_UQ;
                if (r < I_UKV) { transpose_item(INP(I_WUKV) + (size_t)l * KVLORA * 2048, KVLORA, 2048, (bf16_t*)(wl2 + W_UKV), INP(I_GKV) + l * KVLORA, scr, r, lane, MapIdent()); continue; } r -= I_UKV;
                if (r < I_OUT) { transpose_item(INP(I_WOUT) + (size_t)l * DM * DM, DM, DM, (bf16_t*)(wl2 + W_OUT), nullptr, scr, r, lane, MapIdent()); continue; } r -= I_OUT;
                if (r < I_G) { transpose_item(INP(I_WG) + (size_t)l * DM * FF, DM, FF, (bf16_t*)(wl2 + W_GU), nullptr, scr, r, lane, MapGate()); continue; } r -= I_G;
                if (r < I_G) { transpose_item(INP(I_WU) + (size_t)l * DM * FF, DM, FF, (bf16_t*)(wl2 + W_GU), nullptr, scr, r, lane, MapUp()); continue; } r -= I_G;
                transpose_item(INP(I_WD) + (size_t)l * FF * DM, FF, DM, (bf16_t*)(wl2 + W_DN), nullptr, scr, r, lane, MapIdent());
                continue;
            }
            it -= N_TR;
            if (PH(1)) {
                const int row = it; const float* gpre = INP(I_GAPRE);
                const float* src = (row < NLAT) ? INP(I_X) + (size_t)row * DM : INP(I_CTX) + (size_t)(row - NLAT) * DM;
                const int bm = (row < NLAT) ? (row >> 11) : 4; const float* mrow = mod + (size_t)bm * ADA;
                f32x4 v[8]; float ss = 0.f;
#pragma unroll
                for (int j = 0; j < 8; ++j) { v[j] = *(const f32x4*)(src + 4 * lane + 256 * j); ss += pg8::dot4(v[j]); }
                const float rs = 1.0f / sqrtf(wave_sum(ss) * (1.0f / DM) + RMS_EPS);
#pragma unroll
                for (int j = 0; j < 8; ++j) { const int k = 4 * lane + 256 * j; const f32x4 gg = *(const f32x4*)(gpre + k), sh = *(const f32x4*)(mrow + k), sc = *(const f32x4*)(mrow + DM + k);
                    const f32x4 hh = v[j] * rs * gg * (sc + 1.0f) + sh; u32x2 w; w.x = cvt_pk_bf16(hh[0], hh[1]); w.y = cvt_pk_bf16(hh[2], hh[3]); *(u32x2*)(Hb + (size_t)row * DM + k) = w; }
            }
        }
    }
    xcd_barrier(xb); STAMP();

    for (int l = 0; l < 2; ++l) {
        const int MR = (l == 0) ? TOK : NLAT;
        if (PH(2)) {
            DECL_PTRS(l)
            { pg8::Gemm g{Hb, (const bf16_t*)(wl + W_INR), TOK, PRW, DM, DM, DM}; pg8::StaticOrder S; S.init(TOK, PRW, G, bx); pg8::EpiPR E{PR, SSQ, ROPE}; pg8::gemm_phase(ldsl, g, S, E); }
            { pg8::Gemm g{(const bf16_t*)(wl + W_INH), Hb, 1536, TOK, DM, DM, DM}; pg8::StaticOrder S; S.init(1536, TOK, G, (bx + 176) % G); pg8::EpiBf16 E{PT, TOK}; pg8::gemm_phase(ldsl, g, S, E); }
        }
        xcd_barrier(xb); STAMP();
        if (PH(3)) {
            DECL_PTRS(l)
            const int MQ = (l == 0) ? TOK : NLAT;
            { pg8::Gemm g{PR, (const bf16_t*)(wl + W_UQ), MQ, 1536, QLORA, PRW, QLORA}; pg8::StaticOrder S; S.init(MQ, 1536, G, bx); pg8::EpiQ E{Qb, SSQ, ROPE}; pg8::gemm_phase(ldsl, g, S, E); }
            { pg8::Gemm g{PR + QLORA, (const bf16_t*)(wl + W_UKV), TOK, 2048, KVLORA, PRW, KVLORA}; pg8::StaticOrder S; S.init(TOK, 2048, G, (bx + 40) % G); pg8::EpiKV E{KVb, SSQ}; pg8::gemm_phase(ldsl, g, S, E); }
        }
        xcd_barrier(xb); STAMP();
        {
            DECL_PTRS(l)
            char* al = (char*)lds;
            if (PH(10))
            for (int uidx = vcu; uidx < 256; uidx += G) {
                const int bh = uidx >> 3, qb = uidx & 7, b = bh >> 3, h = bh & 7; const int row0 = b * SEQ + qb * 256;
                att::Args a; a.Q = Qb + (size_t)row0 * 1536 + h * 192; a.ldq = 1536; a.Kn = KVb + h * 256; a.ldk = 2048; a.Kr = PR + PR_KR; a.ldkr = PRW; a.V = KVb + h * 256 + 128; a.ldv = 2048;
                a.O = YC + (size_t)row0 * DM + 512 + h * 128; a.ldo = DM; a.nt = 36; a.n1 = 32; a.base1 = b * SEQ; a.base2 = NLAT + b * CTXL; a.scale = MLA_SCALE; a.g = 0; a.rlo = 0; a.bias = nullptr;
                att::unit<192, false>(a, al);
            }
#if PROBE_MULT && PROBE_SUB
            xcd_barrier(xb); STAMP();
#endif
            const float* rpb = INP(I_RPB) + (size_t)l * 4 * 15 * 31;
            if (PH(11))
            for (int uidx = vcu; uidx < 128; uidx += G) {
                const int bh = uidx >> 3, gq = uidx & 7, b = bh >> 2, h = bh & 3; const int row0 = b * SEQ + gq * 256;
                const int rlo = min(max(4 * gq - 4, 0), 24), nr = (gq == 0 || gq == 7) ? 8 : 11;
                att::Args a; a.Q = PR + (size_t)row0 * PRW + PR_NAQ + h * 128; a.ldq = PRW; a.Kn = PR + PR_NAK + h * 128; a.ldk = PRW; a.Kr = nullptr; a.ldkr = 0; a.V = PR + PR_NAV + h * 128; a.ldv = PRW;
                a.O = YC + (size_t)row0 * DM + 1536 + h * 128; a.ldo = DM; a.nt = 4 + nr; a.n1 = 4; a.base1 = NLAT + b * CTXL; a.base2 = b * SEQ + rlo * 64; a.scale = NA_SCALE; a.g = gq; a.rlo = rlo; a.bias = rpb + h * 15 * 31;
                att::unit<128, true>(a, al);
            }
#if PROBE_MULT && PROBE_SUB
            xcd_barrier(xb); STAMP();
#endif
            if (l == 0 && PH(12)) {
                for (int uidx = vcu - 128; uidx >= 0 && uidx < 32; uidx += G) { const int b = uidx >> 3, h = uidx & 7; const int row0 = NLAT + b * CTXL;
                    att::Args a; a.Q = Qb + (size_t)row0 * 1536 + h * 192; a.ldq = 1536; a.Kn = KVb + h * 256; a.ldk = 2048; a.Kr = PR + PR_KR; a.ldkr = PRW; a.V = KVb + h * 256 + 128; a.ldv = 2048;
                    a.O = YC + (size_t)row0 * DM + 512 + h * 128; a.ldo = DM; a.nt = 4; a.n1 = 4; a.base1 = row0; a.base2 = row0; a.scale = MLA_SCALE; a.g = 0; a.rlo = 0; a.bias = nullptr;
                    att::unit<192, false>(a, al); }
                for (int uidx = vcu - 160; uidx >= 0 && uidx < 16; uidx += G) { const int b = uidx >> 2, h = uidx & 3; const int row0 = NLAT + b * CTXL;
                    att::Args a; a.Q = PR + (size_t)row0 * PRW + PR_NAQ + h * 128; a.ldq = PRW; a.Kn = PR + PR_NAK + h * 128; a.ldk = PRW; a.Kr = nullptr; a.ldkr = 0; a.V = PR + PR_NAV + h * 128; a.ldv = PRW;
                    a.O = YC + (size_t)row0 * DM + 1536 + h * 128; a.ldo = DM; a.nt = 4; a.n1 = 4; a.base1 = row0; a.base2 = row0; a.scale = NA_SCALE; a.g = 0; a.rlo = 0; a.bias = nullptr;
                    att::unit<128, false>(a, al); }
            }
#if PROBE_MULT && PROBE_SUB
            xcd_barrier(xb); STAMP();
#endif
            if (PH(13)) {
                const float* cw = INP(I_HCW) + (size_t)l * 3 * 1536; const float* cb = INP(I_HCB) + (size_t)l * 1536; const float* hbias = INP(I_HBIAS) + (size_t)l * HYW;
                { const int c0h = vcu < 128 ? vcu : 128 + 3 * (vcu - 128), nch = vcu < 128 ? 1 : 3;
                  for (int k4 = 0; k4 < nch; ++k4) { const int c = c0h + k4; hyena_unit<SEQ, 1>(c, 0, PT, FILT + ((size_t)l * HYW + c) * 2 * FLEN, 0, (bf16_t*)(ws + A_YH), cw, cb, hbias, lds); } }
                if (l == 0) for (int u = (vcu + 64) % G; u < HYW / 8; u += G) hyena_unit<CTXL, 8>(8 * u, NLAT, PT, FILTC + (size_t)(8 * u) * 2 * FLENC, 2 * FLENC, (bf16_t*)(ws + A_YH), cw, cb, hbias, lds);
            }
        }
        xcd_barrier(xb); STAMP();
        if (PH(13)) {
            DECL_PTRS(l)
            const bf16_t* YH = (const bf16_t*)(ws + A_YH); LAS unsigned short* tt = (LAS unsigned short*)(ldsl + wave * 16384);
            const int ntok = MR / 64;
            for (int it = gw; it < 8 * ntok; it += NGW) { const int cb8 = it / ntok, tb = it % ntok, ch0 = cb8 * 64, t0 = tb * 64;
#pragma unroll
                for (int j = 0; j < 8; ++j) { const int chl = 8 * j + (lane >> 3), tq = (lane & 7) * 8; const u32x4 w = *(const u32x4*)(YH + (size_t)(ch0 + chl) * TOK + t0 + tq);
                    LAS unsigned* d = (LAS unsigned*)(tt + chl * 66 + tq); d[0] = w.x; d[1] = w.y; d[2] = w.z; d[3] = w.w; }
                asm volatile("s_waitcnt lgkmcnt(0)" ::: "memory");
#pragma unroll
                for (int j = 0; j < 8; ++j) { const int tl = 8 * j + (lane >> 3), cq = (lane & 7) * 8; u32x4 o;
                    o.x = (unsigned)tt[(cq + 0) * 66 + tl] | ((unsigned)tt[(cq + 1) * 66 + tl] << 16); o.y = (unsigned)tt[(cq + 2) * 66 + tl] | ((unsigned)tt[(cq + 3) * 66 + tl] << 16);
                    o.z = (unsigned)tt[(cq + 4) * 66 + tl] | ((unsigned)tt[(cq + 5) * 66 + tl] << 16); o.w = (unsigned)tt[(cq + 6) * 66 + tl] | ((unsigned)tt[(cq + 7) * 66 + tl] << 16);
                    *(u32x4*)(YC + (size_t)(t0 + tl) * DM + ch0 + cq) = o; }
                asm volatile("s_waitcnt lgkmcnt(0)" ::: "memory");
            }
        }
        xcd_barrier(xb); STAMP();
        if (PH(5)) { DECL_PTRS(l) { pg8::Gemm g{YC, (const bf16_t*)(wl + W_OUT), NLAT, DM, DM, DM, DM}; pg8::StaticOrder S; S.init(NLAT, DM, G, bx);
              unsigned* ctl = (unsigned*)(ws + S_CTL); f32x4* xbs = (f32x4*)(ws + A_XB); const int set = l * 2 + 0;
              const pg8::RowExchange rx{xbs + (size_t)set * 65536, ctl + CW_XCH + set * 2048, ctl + CW_TMO, DBGP(set)};
              if (l == 0) { pg8::EpiNormRes<true, true> E{INP(I_X), XR, INP(I_GAPOST) + l * DM, mod + 2 * DM, INP(I_GFPRE) + l * DM, mod + 3 * DM, mod + 4 * DM, XR, Hb, nullptr, rx}; pg8::gemm_phase(ldsl, g, S, E); }
              else { pg8::EpiNormRes<false, true> E{nullptr, XR, INP(I_GAPOST) + l * DM, mod + 2 * DM, INP(I_GFPRE) + l * DM, mod + 3 * DM, mod + 4 * DM, XR, Hb, nullptr, rx}; pg8::gemm_phase(ldsl, g, S, E); } }
            if (l == 0) { pg8::Gemm g{YC, (const bf16_t*)(wl + W_OUT), TOK, DM, DM / 4, DM, DM}; pg8::CtxSplitOrder S{bx, DM / 4}; pg8::EpiPart E{(float*)(ws + A_YP), DM / 4}; pg8::gemm_phase(ldsl, g, S, E); } }
        xcd_barrier(xb); STAMP();
        if (l == 0) {
        if (PH(6)) {
            DECL_PTRS(l)
            const float* gpost = INP(I_GAPOST) + l * DM; const float* gfpre = INP(I_GFPRE) + l * DM;
            for (int row = NLAT + gw; row < TOK; row += NGW) {
                const float* xs = (row < NLAT) ? INP(I_X) + (size_t)row * DM : INP(I_CTX) + (size_t)(row - NLAT) * DM;
                const int bm = (row < NLAT) ? (row >> 11) : 4; const float* mrow = mod + (size_t)bm * ADA;
                f32x4 y[8]; float sy;
                if (row < NLAT) { sy = (lane < 32) ? SSQY[(size_t)row * 32 + lane] : 0.f;
#pragma unroll
                    for (int j = 0; j < 8; ++j) y[j] = ldbf4(YF + (size_t)row * DM + 4 * lane + 256 * j); }
                else { const float* yp = (const float*)(ws + A_YP) + (size_t)(row - NLAT) * DM + 4 * lane; sy = 0.f;
#pragma unroll
                    for (int j = 0; j < 8; ++j) { y[j] = (*(const f32x4*)(yp + 256 * j) + *(const f32x4*)(yp + (size_t)NCTX * DM + 256 * j)) + (*(const f32x4*)(yp + (size_t)2 * NCTX * DM + 256 * j) + *(const f32x4*)(yp + (size_t)3 * NCTX * DM + 256 * j)); sy += pg8::dot4(y[j]); } }
                sy = wave_sum(sy);
                const float rsy = 1.0f / sqrtf(sy * (1.0f / DM) + RMS_EPS);
                f32x4 v[8]; float ss = 0.f;
#pragma unroll
                for (int j = 0; j < 8; ++j) { const int k = 4 * lane + 256 * j; const f32x4 xv = (l == 0) ? *(const f32x4*)(xs + k) : ldbf4(XR + (size_t)row * DM + k), yv = y[j], gg = *(const f32x4*)(gpost + k), gt = *(const f32x4*)(mrow + 2 * DM + k);
                    v[j] = xv + gt * (yv * rsy * gg); ss += pg8::dot4(v[j]); stbf4(XR + (size_t)row * DM + k, v[j]); }
                const float rs = 1.0f / sqrtf(wave_sum(ss) * (1.0f / DM) + RMS_EPS);
#pragma unroll
                for (int j = 0; j < 8; ++j) { const int k = 4 * lane + 256 * j; const f32x4 gg = *(const f32x4*)(gfpre + k), sh = *(const f32x4*)(mrow + 3 * DM + k), sc = *(const f32x4*)(mrow + 4 * DM + k);
                    const f32x4 hh = v[j] * rs * gg * (sc + 1.0f) + sh; u32x2 w; w.x = cvt_pk_bf16(hh[0], hh[1]); w.y = cvt_pk_bf16(hh[2], hh[3]); *(u32x2*)(Hb + (size_t)row * DM + k) = w; }
            }
        }
        xcd_barrier(xb); STAMP();
        }
        if (PH(7)) { DECL_PTRS(l) pg8::Gemm g{Hb, (const bf16_t*)(wl + W_GU), MR, 2 * FF, DM, DM, DM}; pg8::StaticOrder S; S.init(MR, 2 * FF, G, bx); pg8::EpiSwiGLU E{ACT}; pg8::gemm_phase(ldsl, g, S, E); }
        xcd_barrier(xb); STAMP();
        if (PH(8)) { DECL_PTRS(l) { pg8::Gemm g{ACT, (const bf16_t*)(wl + W_DN), NLAT, DM, FF, FF, FF}; pg8::StaticOrder S; S.init(NLAT, DM, G, bx);
              unsigned* ctl = (unsigned*)(ws + S_CTL); f32x4* xbs = (f32x4*)(ws + A_XB); const int set = l * 2 + 1; const float* modn = MOD + (size_t)5 * ADA;
              const pg8::RowExchange rx{xbs + (size_t)set * 65536, ctl + CW_XCH + set * 2048, ctl + CW_TMO, DBGP(set)};
              if (l == 0) { pg8::EpiNormRes<false, true> E{nullptr, XR, INP(I_GFPOST) + l * DM, mod + 5 * DM, INP(I_GAPRE) + DM, modn, modn + DM, XR, Hb, nullptr, rx}; pg8::gemm_phase(ldsl, g, S, E); }
              else { pg8::EpiNormRes<false, false> E{nullptr, XR, INP(I_GFPOST) + l * DM, mod + 5 * DM, nullptr, modn, modn, XR, Hb, (float*)INP(29), rx}; pg8::gemm_phase(ldsl, g, S, E); } }
            if (l == 0) { pg8::Gemm g{ACT, (const bf16_t*)(wl + W_DN), TOK, DM, FF / 4, FF, FF}; pg8::CtxSplitOrder S{bx, FF / 4}; pg8::EpiPart E{(float*)(ws + A_YP), FF / 4}; pg8::gemm_phase(ldsl, g, S, E); } }
        xcd_barrier(xb); STAMP();
        if (l == 0 && PH(9)) {
            DECL_PTRS(l)
            const float* gpost = INP(I_GFPOST) + l * DM; const float* gnext = INP(I_GAPRE) + DM; const float* modn = MOD + (size_t)5 * ADA;
            for (int row = NLAT + gw; row < TOK; row += NGW) {
                const int bm = (row < NLAT) ? (row >> 11) : 4; const float* mrow = mod + (size_t)bm * ADA; const float* mnext = modn + (size_t)bm * ADA;
                f32x4 y[8]; float sy;
                if (row < NLAT) { sy = (lane < 32) ? SSQY[(size_t)row * 32 + lane] : 0.f;
#pragma unroll
                    for (int j = 0; j < 8; ++j) y[j] = ldbf4(YF + (size_t)row * DM + 4 * lane + 256 * j); }
                else { const float* yp = (const float*)(ws + A_YP) + (size_t)(row - NLAT) * DM + 4 * lane; sy = 0.f;
#pragma unroll
                    for (int j = 0; j < 8; ++j) { y[j] = (*(const f32x4*)(yp + 256 * j) + *(const f32x4*)(yp + (size_t)NCTX * DM + 256 * j)) + (*(const f32x4*)(yp + (size_t)2 * NCTX * DM + 256 * j) + *(const f32x4*)(yp + (size_t)3 * NCTX * DM + 256 * j)); sy += pg8::dot4(y[j]); } }
                sy = wave_sum(sy);
                const float rsy = 1.0f / sqrtf(sy * (1.0f / DM) + RMS_EPS);
                f32x4 v[8]; float ss = 0.f;
#pragma unroll
                for (int j = 0; j < 8; ++j) { const int k = 4 * lane + 256 * j; const f32x4 xv = ldbf4(XR + (size_t)row * DM + k), yv = y[j], gg = *(const f32x4*)(gpost + k), gt = *(const f32x4*)(mrow + 5 * DM + k);
                    v[j] = xv + gt * (yv * rsy * gg); ss += pg8::dot4(v[j]); if (l == 0) stbf4(XR + (size_t)row * DM + k, v[j]); else *(f32x4*)((float*)INP(29) + (size_t)row * DM + k) = v[j]; }
                if (l == 0) {
                    const float rs = 1.0f / sqrtf(wave_sum(ss) * (1.0f / DM) + RMS_EPS);
#pragma unroll
                    for (int j = 0; j < 8; ++j) { const int k = 4 * lane + 256 * j; const f32x4 gg = *(const f32x4*)(gnext + k), sh = *(const f32x4*)(mnext + k), sc = *(const f32x4*)(mnext + DM + k);
                        const f32x4 hh = v[j] * rs * gg * (sc + 1.0f) + sh; u32x2 w; w.x = cvt_pk_bf16(hh[0], hh[1]); w.y = cvt_pk_bf16(hh[2], hh[3]); *(u32x2*)(Hb + (size_t)row * DM + k) = w; }
                }
            }
        }
        if (l == 0) { xcd_barrier(xb); STAMP(); }
    }
#if PROBE_MULT
    STAMP();
    if (bx0 == 0 && threadIdx.x == 0) { const unsigned long long q1 = (stamps[PROBE_B1] - stamps[PROBE_B0] + PROBE_UNIT / 2) / PROBE_UNIT, q2 = (stamps[PROBE_C1] - stamps[PROBE_C0] + PROBE_UNIT / 2) / PROBE_UNIT; const unsigned long long d = (q1 > 99 ? 99 : q1) * 400000ull + (q2 > 99 ? 99 : q2) * 4000ull, t0 = __builtin_amdgcn_s_memrealtime(); while (__builtin_amdgcn_s_memrealtime() - t0 < d) __builtin_amdgcn_s_sleep(8); }
#endif
}

extern "C" void kernel_launch(void* const* d_in, const int* in_sizes, int n_in, void* d_out, int out_size, void* d_ws, size_t ws_size, hipStream_t stream) {
    static int grid = 0;
    if (grid == 0) {
        if (n_in != 29 || out_size != NLAT * DM || ws_size < WS_NEED) { fprintf(stderr, "kernel_launch: unexpected shapes: n_in %d out %d ws %zu\n", n_in, out_size, ws_size); grid = -1; return; }
        int dev = 0, cus = 0, per_cu = 0;
        (void)hipGetDevice(&dev); (void)hipDeviceGetAttribute(&cus, hipDeviceAttributeMultiprocessorCount, dev);
        (void)hipFuncSetAttribute((const void*)fwd_mega, hipFuncAttributeMaxDynamicSharedMemorySize, LDS_BYTES);
        (void)hipOccupancyMaxActiveBlocksPerMultiprocessor(&per_cu, (const void*)fwd_mega, 512, LDS_BYTES);
        if (per_cu < 1) { fprintf(stderr, "kernel_launch: occupancy query reports %d blocks per CU\n", per_cu); }
        grid = cus;
    }
    if (grid < 0) return;
    Params p{};
    for (int i = 0; i < 29; ++i) p.in[i] = (const float*)d_in[i];
    p.out = (float*)d_out; p.ws = (unsigned char*)d_ws;
    void* args[] = {&p};
    hipError_t e = hipLaunchCooperativeKernel((const void*)fwd_mega, dim3(grid), dim3(512), args, LDS_BYTES, stream);
    if (e != hipSuccess) fprintf(stderr, "cooperative launch failed: %s (grid %d)\n", hipGetErrorString(e), grid);
}
```

```cpp
#include <hip/hip_runtime.h>
#include <hip/hip_cooperative_groups.h>
#include <cstdio>
#include <cstdint>
namespace cg = cooperative_groups;

#define LAS __attribute__((address_space(3)))
typedef unsigned short bf16_t;
typedef short bf16x8 __attribute__((ext_vector_type(8)));
typedef short s16x4 __attribute__((ext_vector_type(4)));
typedef float f32x4 __attribute__((ext_vector_type(4)));
typedef float f32x2 __attribute__((ext_vector_type(2)));
typedef float f32x16 __attribute__((ext_vector_type(16)));
typedef unsigned u32x4 __attribute__((ext_vector_type(4)));
typedef unsigned u32x2 __attribute__((ext_vector_type(2)));

constexpr int DM = 2048, NBATCH = 4, SEQ = 2048, CTXL = 256, NLAT = NBATCH * SEQ, NCTX = NBATCH * CTXL, TOK = NLAT + NCTX;
constexpr int INC = 4416, HYW = 512, QLORA = 768, KVLORA = 512, FF = 5632, ADA = 6 * DM;
constexpr int PRW = 3072;
constexpr int PR_KR = 1280, PR_NAQ = 1344, PR_NAK = 1856, PR_NAV = 2368;
constexpr float RMS_EPS = 1e-6f;
constexpr float MLA_SCALE = 0.07216878364870322f;
constexpr float NA_SCALE = 0.08838834764831845f;

constexpr size_t MiB = 1u << 20;
constexpr size_t WL_STRIDE = 98 * MiB;
constexpr size_t W_INR = 0, W_INH = 12 * MiB, W_UQ = 18 * MiB, W_UKV = 21 * MiB, W_OUT = 23 * MiB, W_GU = 31 * MiB, W_DN = 75 * MiB;
constexpr size_t A_H = 196 * MiB, A_YC = 232 * MiB, A_YF = 268 * MiB, A_XR = 340 * MiB, A_PR = 412 * MiB, A_PT = 466 * MiB, A_Q = 493 * MiB, A_KV = 520 * MiB, A_ACT = 412 * MiB;
constexpr size_t S_MOD = 556 * MiB, S_ROPE = 557 * MiB, S_SSQ = 558 * MiB, S_SSQY = 559 * MiB, S_FILT = 561 * MiB, S_FILTC = 578 * MiB, S_CTL = 580 * MiB, S_H2T = 581 * MiB, A_YH = 583 * MiB, A_YP = 593 * MiB, A_XB = 626 * MiB, WS_NEED = 631 * MiB;
constexpr int FLEN = 2 * SEQ + 64, FLENC = 2 * CTXL + 64;

constexpr int LDS_BYTES = 147456;
#ifndef PHMASK
#define PHMASK 0xFFFFFFFFu
#endif
#define PH(n) ((PHMASK >> (n)) & 1u)
#ifndef PROBE_MULT
#define PROBE_MULT 0
#define PROBE_B0 0
#define PROBE_B1 1
#define PROBE_C0 0
#define PROBE_C1 1
#endif
#ifndef PROBE_UNIT
#define PROBE_UNIT 400
#endif
#ifndef PROBE_SUB
#define PROBE_SUB 0
#endif

__device__ __forceinline__ unsigned cvt_pk_bf16(float lo, float hi) { unsigned r; asm volatile("v_cvt_pk_bf16_f32 %0, %1, %2" : "=v"(r) : "v"(lo), "v"(hi)); return r; }
__device__ __forceinline__ bf16_t f2bf(float f) { return (bf16_t)(cvt_pk_bf16(f, 0.f) & 0xffffu); }
__device__ __forceinline__ float bf2f(bf16_t h) { return __uint_as_float(((unsigned)h) << 16); }
__device__ __forceinline__ f32x4 ldbf4(const bf16_t* p) { const u32x2 w = *(const u32x2*)p; return (f32x4){__uint_as_float(w.x << 16), __uint_as_float(w.x & 0xffff0000u), __uint_as_float(w.y << 16), __uint_as_float(w.y & 0xffff0000u)}; }
__device__ __forceinline__ void stbf4(bf16_t* p, f32x4 v) { u32x2 w; w.x = cvt_pk_bf16(v[0], v[1]); w.y = cvt_pk_bf16(v[2], v[3]); *(u32x2*)p = w; }
__device__ __forceinline__ float wave_sum(float v) {
#pragma unroll
    for (int o = 1; o < 64; o <<= 1) v += __shfl_xor(v, o);
    return v;
}

constexpr int CW_TMO = 4096, CW_XCH = 8192, CW_END = CW_XCH + 8 * 32 * 64;
#define RLX_AGENT __ATOMIC_RELAXED, __HIP_MEMORY_SCOPE_AGENT
__device__ __forceinline__ void st16f_wt(void* p, f32x4 v) { asm volatile("global_store_dwordx4 %0, %1, off sc1\n\ts_nop 1" :: "v"(p), "v"(v) : "memory"); }
__device__ __forceinline__ f32x4 ld16_sc1(const void* p) { f32x4 v; asm volatile("global_load_dwordx4 %0, %1, off sc1\n\ts_waitcnt vmcnt(0)" : "=&v"(v) : "v"(p) : "memory"); return v; }

namespace pg8 {
constexpr int BM = 256, BK = 64, HALF = 128, HTB = HALF * BK * 2, STAGE_BYTES = 8 * HTB, NXCD = 8, WGM = 8;
__host__ __device__ __forceinline__ int lds_byte(int r, int c) { const int st = (r >> 4) * 2 + (c >> 5), rr = r & 15, cc = c & 31, ob = rr * 64 + cc * 2; return st * 1024 + (ob ^ (((ob >> 9) & 1) << 5)); }
__host__ __device__ __forceinline__ void stage_rc(int b, int& R, int& C) { const int st = b / 1024, sb = b % 1024, swz = sb ^ (((sb >> 9) & 1) << 5); R = (st >> 1) * 16 + swz / 64; C = (st & 1) * 32 + (swz % 64) / 2; }
__host__ __device__ __forceinline__ int perm32(int rho) { const int n = rho >> 4, i = rho & 15; return 8 * (i >> 2) + 4 * n + (i & 3); }

struct Unit { int pm, pn, koff; };
struct Gemm { const bf16_t* A; const bf16_t* Bt; int M, N, K, lda, ldb; };

struct StaticOrder {
    int nM, nN, nwg, G, c;
    __host__ __device__ void init(int M, int N, int G_, int c_) { nM = M / BM; nN = N / BM; nwg = nM * nN; G = G_; c = c_; }
    __host__ __device__ bool next(int i, Unit& u) const {
        const long L = (long)i * G + c; if (L >= nwg) return false;
        int wgid = (int)L; { const int q = nwg / NXCD, r = nwg % NXCD, xcd = wgid % NXCD, off = wgid / NXCD; wgid = (xcd < r ? xcd * (q + 1) : r * (q + 1) + (xcd - r) * q) + off; }
        const int nig = WGM * nN, gid = wgid / nig, fm = gid * WGM, gsz = (nM - fm) < WGM ? (nM - fm) : WGM;
        u.pm = fm + ((wgid % nig) % gsz); u.pn = (wgid % nig) / gsz; u.koff = 0; return true;
    }
};

template <class Epi, class Sched>
__device__ __forceinline__ void gemm_phase(LAS unsigned char* lds, const Gemm g, const Sched& S, const Epi& E) {
    int tid = threadIdx.x; asm volatile("" : "+v"(tid));
    const int wid = __builtin_amdgcn_readfirstlane(tid >> 6), lane = tid & 63, wr = wid >> 2, wc = wid & 3, fr = lane & 15, fq = lane >> 4;
    const int K = g.K, nt = K / BK;
    unsigned voffA[2], voffB[2];
#pragma unroll
    for (int i = 0; i < 2; ++i) { int R, C; stage_rc(tid * 16 + i * 8192, R, C); const int Rb = Epi::PERM ? ((R & ~31) + perm32(R & 31)) : R;
        voffA[i] = (unsigned)(R * g.lda + C) * 2u; voffB[i] = (unsigned)(Rb * g.ldb + C) * 2u; }
    const size_t kstep = (size_t)(BK * 2);
    const size_t hstepA = (size_t)HALF * g.lda * 2, hstepB = (size_t)HALF * g.ldb * 2;
    const size_t tstepA = 2 * hstepA, tstepB = 2 * hstepB;
    const unsigned ldsw = (unsigned)wid * 1024u;
    const int aoff = lds_byte(wr * 64 + fr, fq * 8), boff = lds_byte(wc * 32 + fr, fq * 8);
#define PG8_SA(b, h) (((b) * 2 + (h)) * HTB)
#define PG8_SB(b, h) ((4 + (b) * 2 + (h)) * HTB)
#define PG8_STAGE(bufoff, gbase, voff) do { _Pragma("unroll") for (int _i = 0; _i < 2; ++_i) \
        __builtin_amdgcn_global_load_lds((const unsigned*)((const char*)(gbase) + (voff)[_i]), (LAS unsigned*)(lds + (bufoff) + ldsw + _i * 8192), 16, 0, 0); } while (0)
#define PG8_LDA(dst, b, h) do { _Pragma("unroll") for (int m = 0; m < 4; ++m) _Pragma("unroll") for (int k = 0; k < 2; ++k) dst[m][k] = *(const LAS bf16x8*)(lds + PG8_SA(b, h) + aoff + m * 2048 + k * 1024); } while (0)
#define PG8_LDB(dst, b, h) do { _Pragma("unroll") for (int n = 0; n < 2; ++n) _Pragma("unroll") for (int k = 0; k < 2; ++k) dst[n][k] = *(const LAS bf16x8*)(lds + PG8_SB(b, h) + boff + n * 2048 + k * 1024); } while (0)
#define PG8_MMA(ai, bj, At, Bt) do { __builtin_amdgcn_s_setprio(1); _Pragma("unroll") for (int m = 0; m < 4; ++m) _Pragma("unroll") for (int n = 0; n < 2; ++n) _Pragma("unroll") for (int k = 0; k < 2; ++k) \
        acc[ai][bj][m][n] = __builtin_amdgcn_mfma_f32_16x16x32_bf16(Bt[n][k], At[m][k], acc[ai][bj][m][n], 0, 0, 0); __builtin_amdgcn_s_setprio(0); } while (0)
#define PG8_WAIT_V(n) asm volatile("s_waitcnt vmcnt(" #n ")" ::: "memory")
#define PG8_WAIT_L(n) asm volatile("s_waitcnt lgkmcnt(" #n ")" ::: "memory")
#define PG8_BAR __builtin_amdgcn_s_barrier()
#define PG8_SCHED __builtin_amdgcn_sched_barrier(0)
    Unit cur, nxt; int ui = 0;
    if (!S.next(0, cur)) return;
    f32x4 acc[2][2][4][2];
#pragma unroll
    for (int a = 0; a < 2; ++a)
#pragma unroll
        for (int b = 0; b < 2; ++b)
#pragma unroll
            for (int m = 0; m < 4; ++m)
#pragma unroll
                for (int n = 0; n < 2; ++n) acc[a][b][m][n] = (f32x4){0.f, 0.f, 0.f, 0.f};
    bf16x8 At[4][2], B0[2][2], B1[2][2];
    const char* cA = (const char*)g.A + (size_t)cur.pm * tstepA + (size_t)cur.koff * 2; const char* cB = (const char*)g.Bt + (size_t)cur.pn * tstepB + (size_t)cur.koff * 2;
    PG8_STAGE(PG8_SB(0, 0), cB, voffB); PG8_STAGE(PG8_SB(0, 1), cB + hstepB, voffB); PG8_STAGE(PG8_SA(0, 0), cA, voffA); PG8_STAGE(PG8_SA(0, 1), cA + hstepA, voffA);
    if (wr == 1) PG8_BAR;
    PG8_WAIT_V(2); PG8_BAR;
    PG8_STAGE(PG8_SB(1, 0), cB + kstep, voffB); PG8_STAGE(PG8_SA(1, 0), cA + kstep, voffA); PG8_STAGE(PG8_SB(1, 1), cB + hstepB + kstep, voffB);
    PG8_WAIT_V(6); PG8_BAR;
    for (;;) {
        const bool has_next = S.next(ui + 1, nxt);
        const char* nA = has_next ? (const char*)g.A + (size_t)nxt.pm * tstepA + (size_t)nxt.koff * 2 : cA; const char* nB = has_next ? (const char*)g.Bt + (size_t)nxt.pn * tstepB + (size_t)nxt.koff * 2 : cB;
        for (int t = 0; t < nt; t += 2) {
            const bool last = (t == nt - 2);
            const char* a1 = cA + (size_t)(t + 1) * kstep;
            const char* a2 = last ? nA : cA + (size_t)(t + 2) * kstep; const char* b2 = last ? nB : cB + (size_t)(t + 2) * kstep;
            const char* a3 = a2 + kstep; const char* b3 = b2 + kstep;
            PG8_LDB(B0, 0, 0); PG8_LDB(B1, 0, 1); PG8_SCHED; PG8_LDA(At, 0, 0); PG8_STAGE(PG8_SA(1, 1), a1 + hstepA, voffA);
            PG8_WAIT_V(8); PG8_WAIT_L(0); PG8_BAR; PG8_MMA(0, 0, At, B0); PG8_MMA(0, 1, At, B1); PG8_BAR; PG8_SCHED;
            PG8_LDA(At, 0, 1); PG8_STAGE(PG8_SB(0, 0), b2, voffB); PG8_STAGE(PG8_SB(0, 1), b2 + hstepB, voffB); PG8_STAGE(PG8_SA(0, 0), a2, voffA);
            PG8_WAIT_V(8); PG8_WAIT_L(0); PG8_BAR; PG8_MMA(1, 0, At, B0); PG8_MMA(1, 1, At, B1); PG8_BAR; PG8_SCHED;
            PG8_LDB(B0, 1, 0); PG8_LDB(B1, 1, 1); PG8_SCHED; PG8_LDA(At, 1, 0); PG8_STAGE(PG8_SA(0, 1), a2 + hstepA, voffA);
            PG8_WAIT_V(8); PG8_WAIT_L(0); PG8_BAR; PG8_MMA(0, 0, At, B0); PG8_MMA(0, 1, At, B1); PG8_BAR; PG8_SCHED;
            PG8_LDA(At, 1, 1); PG8_STAGE(PG8_SB(1, 0), b3, voffB); PG8_STAGE(PG8_SB(1, 1), b3 + hstepB, voffB); PG8_STAGE(PG8_SA(1, 0), a3, voffA);
            PG8_WAIT_V(8); PG8_WAIT_L(0); PG8_BAR; PG8_MMA(1, 0, At, B0); PG8_MMA(1, 1, At, B1); PG8_BAR; PG8_SCHED;
        }
        if (wr == 0) PG8_BAR;
        if constexpr (!Epi::AFTER_DRAIN) E(acc, cur, wr, wc, fr, fq);
        if (!has_next) break;
#pragma unroll
        for (int a = 0; a < 2; ++a)
#pragma unroll
            for (int b = 0; b < 2; ++b)
#pragma unroll
                for (int m = 0; m < 4; ++m)
#pragma unroll
                    for (int n = 0; n < 2; ++n) acc[a][b][m][n] = (f32x4){0.f, 0.f, 0.f, 0.f};
        cur = nxt; cA = nA; cB = nB; ++ui;
        if (wr == 1) PG8_BAR;
    }
    PG8_WAIT_V(0);
    PG8_BAR;
    if constexpr (Epi::AFTER_DRAIN) E.fused(acc, cur, wr, wc, fr, fq, lds, wid, lane);
#undef PG8_SA
#undef PG8_SB
#undef PG8_STAGE
#undef PG8_LDA
#undef PG8_LDB
#undef PG8_MMA
#undef PG8_WAIT_V
#undef PG8_WAIT_L
#undef PG8_BAR
#undef PG8_SCHED
}

__device__ __forceinline__ float dot4(f32x4 v) { return (v[0] * v[0] + v[1] * v[1]) + (v[2] * v[2] + v[3] * v[3]); }
__device__ __forceinline__ void rope4(f32x4& v, const float* rope_row, int i0) {
    const f32x4 cs = *(const f32x4*)(rope_row + 2 * i0);
    const float a0 = v[0] * cs[0] - v[1] * cs[1], b0 = v[1] * cs[0] + v[0] * cs[1];
    const float a1 = v[2] * cs[2] - v[3] * cs[3], b1 = v[3] * cs[2] + v[2] * cs[3];
    v = (f32x4){a0, b0, a1, b1};
}
__device__ __forceinline__ u32x4 pack8(f32x4 v0, f32x4 v1) { u32x4 w; w.x = cvt_pk_bf16(v0[0], v0[1]); w.y = cvt_pk_bf16(v0[2], v0[3]); w.z = cvt_pk_bf16(v1[0], v1[1]); w.w = cvt_pk_bf16(v1[2], v1[3]); return w; }

struct EpiBf16 {
    static constexpr bool PERM = true, AFTER_DRAIN = false;
    bf16_t* O; int ldc;
    __device__ __forceinline__ void operator()(const f32x4 (&acc)[2][2][4][2], const Unit& u, int wr, int wc, int fr, int fq) const {
        const int row0 = u.pm * BM + wr * 64 + fr, col0 = u.pn * BM + wc * 32 + 8 * fq;
#pragma unroll
        for (int ai = 0; ai < 2; ++ai)
#pragma unroll
            for (int m = 0; m < 4; ++m) { bf16_t* rowp = O + (size_t)(row0 + ai * HALF + m * 16) * ldc + col0;
#pragma unroll
                for (int bj = 0; bj < 2; ++bj) *(u32x4*)(rowp + bj * HALF) = pack8(acc[ai][bj][m][0], acc[ai][bj][m][1]); }
    }
};
struct EpiPR {
    static constexpr bool PERM = true, AFTER_DRAIN = false;
    bf16_t* O; float* ssq; const float* rope;
    __device__ __forceinline__ void operator()(const f32x4 (&acc)[2][2][4][2], const Unit& u, int wr, int wc, int fr, int fq) const {
        const int row0 = u.pm * BM + wr * 64 + fr, col0 = u.pn * BM + wc * 32 + 8 * fq;
        const bool dorope = (u.pn == 5) && (wc < 2);
#pragma unroll
        for (int ai = 0; ai < 2; ++ai)
#pragma unroll
            for (int m = 0; m < 4; ++m) { const int row = row0 + ai * HALF + m * 16; bf16_t* rowp = O + (size_t)row * PRW + col0; float ss = 0.f;
#pragma unroll
                for (int bj = 0; bj < 2; ++bj) { f32x4 v0 = acc[ai][bj][m][0], v1 = acc[ai][bj][m][1];
                    if (bj == 0 && dorope && row < NLAT) { const float* rr = rope + (size_t)(row & (SEQ - 1)) * 64; const int i0 = 16 * wc + 4 * fq; rope4(v0, rr, i0); rope4(v1, rr, i0 + 2); }
                    ss += dot4(v0) + dot4(v1);
                    *(u32x4*)(rowp + bj * HALF) = pack8(v0, v1); }
                if (u.pn < 5) { ss += __shfl_xor(ss, 16); ss += __shfl_xor(ss, 32); if (fq == 0) ssq[(size_t)row * 20 + u.pn * 4 + wc] = ss; }
                asm volatile("" ::: "memory"); }
    }
};
struct EpiQ {
    static constexpr bool PERM = true, AFTER_DRAIN = false;
    bf16_t* O; const float* ssq; const float* rope;
    __device__ __forceinline__ void operator()(const f32x4 (&acc)[2][2][4][2], const Unit& u, int wr, int wc, int fr, int fq) const {
        const int row0 = u.pm * BM + wr * 64 + fr, col0 = u.pn * BM + wc * 32 + 8 * fq;
#pragma unroll
        for (int ai = 0; ai < 2; ++ai)
#pragma unroll
            for (int m = 0; m < 4; ++m) { const int row = row0 + ai * HALF + m * 16; bf16_t* rowp = O + (size_t)row * 1536 + col0;
                const f32x4* sp = (const f32x4*)(ssq + (size_t)row * 20); const f32x4 s0 = sp[0], s1 = sp[1], s2 = sp[2];
                const float tot = ((s0[0] + s0[1]) + (s0[2] + s0[3])) + ((s1[0] + s1[1]) + (s1[2] + s1[3])) + ((s2[0] + s2[1]) + (s2[2] + s2[3]));
                const float rs = 1.0f / sqrtf(tot * (1.0f / QLORA) + RMS_EPS);
#pragma unroll
                for (int bj = 0; bj < 2; ++bj) { f32x4 v0 = acc[ai][bj][m][0] * rs, v1 = acc[ai][bj][m][1] * rs;
                    const int j0 = (col0 + bj * HALF) % 192;
                    if (j0 >= 128 && row < NLAT) { const float* rr = rope + (size_t)(row & (SEQ - 1)) * 64; const int i0 = (j0 - 128) >> 1; rope4(v0, rr, i0); rope4(v1, rr, i0 + 2); }
                    *(u32x4*)(rowp + bj * HALF) = pack8(v0, v1); }
                asm volatile("" ::: "memory"); }
    }
};
struct EpiKV {
    static constexpr bool PERM = true, AFTER_DRAIN = false;
    bf16_t* O; const float* ssq;
    __device__ __forceinline__ void operator()(const f32x4 (&acc)[2][2][4][2], const Unit& u, int wr, int wc, int fr, int fq) const {
        const int row0 = u.pm * BM + wr * 64 + fr, col0 = u.pn * BM + wc * 32 + 8 * fq;
#pragma unroll
        for (int ai = 0; ai < 2; ++ai)
#pragma unroll
            for (int m = 0; m < 4; ++m) { const int row = row0 + ai * HALF + m * 16; bf16_t* rowp = O + (size_t)row * 2048 + col0;
                const f32x4* sp = (const f32x4*)(ssq + (size_t)row * 20 + 12); const f32x4 s0 = sp[0], s1 = sp[1];
                const float tot = ((s0[0] + s0[1]) + (s0[2] + s0[3])) + ((s1[0] + s1[1]) + (s1[2] + s1[3]));
                const float rs = 1.0f / sqrtf(tot * (1.0f / KVLORA) + RMS_EPS);
#pragma unroll
                for (int bj = 0; bj < 2; ++bj) *(u32x4*)(rowp + bj * HALF) = pack8(acc[ai][bj][m][0] * rs, acc[ai][bj][m][1] * rs);
                asm volatile("" ::: "memory"); }
    }
};
struct EpiF32S {
    static constexpr bool PERM = true, AFTER_DRAIN = false;
    bf16_t* C; float* ssq;
    __device__ __forceinline__ void operator()(const f32x4 (&acc)[2][2][4][2], const Unit& u, int wr, int wc, int fr, int fq) const {
        const int row0 = u.pm * BM + wr * 64 + fr, col0 = u.pn * BM + wc * 32 + 8 * fq;
#pragma unroll
        for (int ai = 0; ai < 2; ++ai)
#pragma unroll
            for (int m = 0; m < 4; ++m) { const int row = row0 + ai * HALF + m * 16; bf16_t* rowp = C + (size_t)row * DM + col0; float ss = 0.f;
#pragma unroll
                for (int bj = 0; bj < 2; ++bj) { const f32x4 v0 = acc[ai][bj][m][0], v1 = acc[ai][bj][m][1]; ss += dot4(v0) + dot4(v1); *(u32x4*)(rowp + bj * HALF) = pack8(v0, v1); }
                ss += __shfl_xor(ss, 16); ss += __shfl_xor(ss, 32); if (fq == 0) ssq[(size_t)row * 32 + u.pn * 4 + wc] = ss; }
    }
};
struct EpiSwiGLU {
    static constexpr bool PERM = true, AFTER_DRAIN = false;
    bf16_t* O;
    __device__ __forceinline__ void operator()(const f32x4 (&acc)[2][2][4][2], const Unit& u, int wr, int wc, int fr, int fq) const {
        const int row0 = u.pm * BM + wr * 64 + fr, col0 = u.pn * HALF + wc * 32 + 8 * fq;
#pragma unroll
        for (int ai = 0; ai < 2; ++ai)
#pragma unroll
            for (int m = 0; m < 4; ++m) { bf16_t* rowp = O + (size_t)(row0 + ai * HALF + m * 16) * FF + col0; f32x4 r[2];
#pragma unroll
                for (int n = 0; n < 2; ++n) { const f32x4 gt = acc[ai][0][m][n], up = acc[ai][1][m][n];
#pragma unroll
                    for (int e = 0; e < 4; ++e) { const float sg = __builtin_amdgcn_rcpf(1.0f + __builtin_amdgcn_exp2f(-1.4426950408889634f * gt[e])); r[n][e] = gt[e] * sg * up[e]; } }
                *(u32x4*)rowp = pack8(r[0], r[1]); }
    }
};
struct RowExchange { f32x4* slots; unsigned* cnt; unsigned* tmo; unsigned long long* dbg; };
template <bool XF32, bool SECOND>
struct EpiNormRes {
    static constexpr bool PERM = true, AFTER_DRAIN = true;
    const float* xf; const bf16_t* xb;
    const float* gpost; const float* gate;
    const float* g2; const float* shift2; const float* scale2;
    bf16_t* XRo; bf16_t* Ho; float* outf;
    RowExchange x1;
    __device__ __forceinline__ f32x4 ldx(unsigned o) const { if constexpr (XF32) return *(const f32x4*)(xf + o); else return ldbf4(xb + o); }
    __device__ __forceinline__ void fused(f32x4 (&acc)[2][2][4][2], const Unit& u, int wr, int wc, int fr, int fq, LAS unsigned char* lds, int wid, int lane) const {
        LAS f32x4* P = (LAS f32x4*)lds; LAS f32x2* S = (LAS f32x2*)(lds + 16384);
#define DBGS(i) do { if (x1.dbg && blockIdx.x == 0 && threadIdx.x == 0) x1.dbg[i] = __builtin_amdgcn_s_memrealtime(); } while (0)
        DBGS(0);
        const int b = u.pm >> 3, col0 = u.pn * BM + wc * 32 + 8 * fq;
        const float* gt = gate + (size_t)b * ADA;
        f32x4 G[2][2];
#pragma unroll
        for (int bj = 0; bj < 2; ++bj)
#pragma unroll
            for (int n = 0; n < 2; ++n) { const int cc = col0 + bj * HALF + n * 4; G[bj][n] = *(const f32x4*)(gpost + cc) * *(const f32x4*)(gt + cc); }
        f32x4 xl[2][2][2][2];
#define NR_LOAD(SET, AM) do { _Pragma("unroll") for (int mm = 0; mm < 2; ++mm) { const unsigned off_ = (unsigned)(u.pm * BM + ((AM) >> 1) * HALF + wr * 64 + (((AM) & 1) * 2 + mm) * 16 + fr) * DM + col0; \
            _Pragma("unroll") for (int bj = 0; bj < 2; ++bj) _Pragma("unroll") for (int n = 0; n < 2; ++n) xl[SET][mm][bj][n] = ldx(off_ + bj * HALF + n * 4); } } while (0)
        NR_LOAD(0, 0);
#pragma unroll
        for (int am = 0; am < 4; ++am) { const int ai = am >> 1, m0 = (am & 1) * 2;
            if (am + 1 < 4) NR_LOAD((am + 1) & 1, am + 1);
#pragma unroll
            for (int mm = 0; mm < 2; ++mm) { const int m = m0 + mm; f32x4 s = {0.f, 0.f, 0.f, 0.f};
#pragma unroll
                for (int bj = 0; bj < 2; ++bj)
#pragma unroll
                    for (int n = 0; n < 2; ++n) { const f32x4 y = acc[ai][bj][m][n], x = xl[am & 1][mm][bj][n], gy = G[bj][n] * y; acc[ai][bj][m][n] = gy;
                        s[0] += dot4(y); s[1] += dot4(x); s[2] += (x[0] * gy[0] + x[1] * gy[1]) + (x[2] * gy[2] + x[3] * gy[3]); s[3] += dot4(gy); }
#pragma unroll
                for (int e = 0; e < 4; ++e) { s[e] += __shfl_xor(s[e], 16); s[e] += __shfl_xor(s[e], 32); }
                if (fq == 0) P[(ai * HALF + wr * 64 + m * 16 + fr) * 4 + wc] = s; } }
#undef NR_LOAD
        asm volatile("s_waitcnt lgkmcnt(0)" ::: "memory"); __builtin_amdgcn_s_barrier(); asm volatile("" ::: "memory");
        DBGS(1);
        const int row = wid * 64 + lane;
        if (row < 256) { const f32x4 tot = (P[row * 4 + 0] + P[row * 4 + 1]) + (P[row * 4 + 2] + P[row * 4 + 3]); st16f_wt(x1.slots + ((size_t)u.pm * 256 + row) * 8 + u.pn, tot); }
        asm volatile("s_waitcnt vmcnt(0)" ::: "memory");
        if (lane == 0) __hip_atomic_fetch_add(x1.cnt + 64 * u.pm, 1u, RLX_AGENT);
        if (wid == 0) { unsigned polls = 0;
            while ((unsigned)__builtin_amdgcn_readfirstlane(__hip_atomic_load(x1.cnt + 64 * u.pm, RLX_AGENT)) < 64u) {
                if ((++polls & 255u) == 0u) { if (__builtin_amdgcn_readfirstlane(__hip_atomic_load(x1.tmo, RLX_AGENT)) != 0u) break; if (polls > (1u << 21)) { if (lane == 0) __hip_atomic_store(x1.tmo, 1u, RLX_AGENT); break; } }
                __builtin_amdgcn_s_sleep(1); } }
        asm volatile("s_waitcnt vmcnt(0) lgkmcnt(0)" ::: "memory"); __builtin_amdgcn_s_barrier(); asm volatile("" ::: "memory");
        DBGS(2);
        if (row < 256) { const f32x4* sl = x1.slots + ((size_t)u.pm * 256 + row) * 8; f32x4 t0, t1, t2, t3;
            asm volatile("global_load_dwordx4 %0, %4, off sc1\n\tglobal_load_dwordx4 %1, %4, off offset:16 sc1\n\tglobal_load_dwordx4 %2, %4, off offset:32 sc1\n\tglobal_load_dwordx4 %3, %4, off offset:48 sc1\n\ts_waitcnt vmcnt(0)"
                         : "=&v"(t0), "=&v"(t1), "=&v"(t2), "=&v"(t3) : "v"(sl) : "memory");
            f32x4 t = (t0 + t1) + (t2 + t3);
            asm volatile("global_load_dwordx4 %0, %4, off offset:64 sc1\n\tglobal_load_dwordx4 %1, %4, off offset:80 sc1\n\tglobal_load_dwordx4 %2, %4, off offset:96 sc1\n\tglobal_load_dwordx4 %3, %4, off offset:112 sc1\n\ts_waitcnt vmcnt(0)"
                         : "=&v"(t0), "=&v"(t1), "=&v"(t2), "=&v"(t3) : "v"(sl) : "memory");
            t = t + ((t0 + t1) + (t2 + t3));
            const float rsy = __builtin_amdgcn_rsqf(t[0] * (1.0f / DM) + RMS_EPS);
            const float sx2 = t[1] + (rsy + rsy) * t[2] + rsy * rsy * t[3];
            S[row] = (f32x2){rsy, __builtin_amdgcn_rsqf(fmaxf(sx2, 0.f) * (1.0f / DM) + RMS_EPS)}; }
        asm volatile("s_waitcnt lgkmcnt(0)" ::: "memory"); __builtin_amdgcn_s_barrier(); asm volatile("" ::: "memory");
        DBGS(3);
        int fr2 = fr, fq2 = fq; asm volatile("" : "+v"(fr2), "+v"(fq2)); const int col2 = u.pn * BM + wc * 32 + 8 * fq2;
        const float* sh = shift2 + (size_t)b * ADA; const float* sc = scale2 + (size_t)b * ADA;
        f32x4 gg[2][2], shv[2][2], scv[2][2];
        if constexpr (SECOND) {
#pragma unroll
            for (int bj = 0; bj < 2; ++bj)
#pragma unroll
                for (int n = 0; n < 2; ++n) { const int cc = col2 + bj * HALF + n * 4; gg[bj][n] = *(const f32x4*)(g2 + cc); shv[bj][n] = *(const f32x4*)(sh + cc); scv[bj][n] = *(const f32x4*)(sc + cc) + 1.0f; } }
#pragma unroll
        for (int am = 0; am < 4; ++am) { const int ai = am >> 1, m0 = (am & 1) * 2;
            f32x4 x2l[2][2][2];
#pragma unroll
            for (int mm = 0; mm < 2; ++mm) { const unsigned off = (unsigned)(u.pm * BM + ai * HALF + wr * 64 + (m0 + mm) * 16 + fr2) * DM + col2;
#pragma unroll
                for (int bj = 0; bj < 2; ++bj)
#pragma unroll
                    for (int n = 0; n < 2; ++n) x2l[mm][bj][n] = ldx(off + bj * HALF + n * 4); }
#pragma unroll
            for (int mm = 0; mm < 2; ++mm) { const int m = m0 + mm; const int r = ai * HALF + wr * 64 + m * 16 + fr2; const f32x2 st = S[r]; const unsigned off = (unsigned)(u.pm * BM + r) * DM + col2;
#pragma unroll
                for (int bj = 0; bj < 2; ++bj) { const unsigned o2 = off + bj * HALF;
                    const f32x4 xn0 = x2l[mm][bj][0] + acc[ai][bj][m][0] * st.x, xn1 = x2l[mm][bj][1] + acc[ai][bj][m][1] * st.x;
                    if constexpr (SECOND) { *(u32x4*)(XRo + o2) = pack8(xn0, xn1); *(u32x4*)(Ho + o2) = pack8(xn0 * st.y * gg[bj][0] * scv[bj][0] + shv[bj][0], xn1 * st.y * gg[bj][1] * scv[bj][1] + shv[bj][1]); }
                    else { *(f32x4*)(outf + o2) = xn0; *(f32x4*)(outf + o2 + 4) = xn1; } } }
            asm volatile("" ::: "memory"); }
        asm volatile("s_waitcnt lgkmcnt(0)" ::: "memory"); __builtin_amdgcn_s_barrier(); asm volatile("" ::: "memory");
        DBGS(4);
#undef DBGS
    }
};
struct CtxSplitOrder {
    int c, ksub;
    __device__ bool next(int i, Unit& u) const { if (i > 0 || c >= 128) return false; const int kp = c >> 5, r = c & 31; u.pm = 32 + (r >> 3); u.pn = r & 7; u.koff = kp * ksub; return true; }
};
struct EpiPart {
    static constexpr bool PERM = false, AFTER_DRAIN = false;
    float* P; int ksub;
    __device__ __forceinline__ void operator()(const f32x4 (&acc)[2][2][4][2], const Unit& u, int wr, int wc, int fr, int fq) const {
        const int row0 = u.pm * BM + wr * 64 + fr - NLAT, col0 = u.pn * BM + wc * 32 + 4 * fq; float* base = P + (size_t)(u.koff / ksub) * NCTX * DM;
#pragma unroll
        for (int ai = 0; ai < 2; ++ai)
#pragma unroll
            for (int m = 0; m < 4; ++m) { float* rowp = base + (size_t)(row0 + ai * HALF + m * 16) * DM + col0;
#pragma unroll
                for (int bj = 0; bj < 2; ++bj)
#pragma unroll
                    for (int n = 0; n < 2; ++n) *(f32x4*)(rowp + bj * HALF + n * 16) = acc[ai][bj][m][n]; }
    }
};
}

namespace att {
constexpr int NW = 8, QBLK = 32, KVBLK = 64;
#define SBAR() __builtin_amdgcn_sched_barrier(0)
__device__ __forceinline__ int crow(int r, int hi) { return (r & 3) + 8 * (r >> 2) + 4 * hi; }
__device__ __forceinline__ int v_st(int k, int c) { const int kk = (k & ~0xC) | ((k & 4) << 1) | ((k & 8) >> 1); return ((kk >> 3) * 4 + (c >> 5)) * 512 + ((kk & 7) * 32 + (c & 31)) * 2; }
__device__ __forceinline__ int v_rd_base(int lane) { return ((lane & 3) << 3) | (((lane >> 2) & 3) << 6) | (((lane >> 4) & 1) << 5) | (((lane >> 5) & 1) << 8); }
constexpr int v_rd_off(int d0, int ks, int half) { return d0 * 512 + ks * 4096 + half * 2048; }
template <int OFF> __device__ __forceinline__ s16x4 tr_read(int vb) { s16x4 r; asm volatile("ds_read_b64_tr_b16 %0, %1 offset:%2" : "=&v"(r) : "v"(vb), "i"(OFF) : "memory"); return r; }
template <int D0> __device__ __forceinline__ void pv_one(f32x16& od, int vb, bf16x8 pa0, bf16x8 pa1, bf16x8 pa2, bf16x8 pa3) {
    const s16x4 l0 = tr_read<v_rd_off(D0, 0, 0)>(vb), h0 = tr_read<v_rd_off(D0, 0, 1)>(vb), l1 = tr_read<v_rd_off(D0, 1, 0)>(vb), h1 = tr_read<v_rd_off(D0, 1, 1)>(vb);
    const s16x4 l2 = tr_read<v_rd_off(D0, 2, 0)>(vb), h2 = tr_read<v_rd_off(D0, 2, 1)>(vb), l3 = tr_read<v_rd_off(D0, 3, 0)>(vb), h3 = tr_read<v_rd_off(D0, 3, 1)>(vb);
    asm volatile("s_waitcnt lgkmcnt(0)" ::: "memory"); SBAR();
#define PKV(L, H) (bf16x8){L[0], L[1], L[2], L[3], H[0], H[1], H[2], H[3]}
    od = __builtin_amdgcn_mfma_f32_32x32x16_bf16(pa0, PKV(l0, h0), od, 0, 0, 0);
    od = __builtin_amdgcn_mfma_f32_32x32x16_bf16(pa1, PKV(l1, h1), od, 0, 0, 0);
    od = __builtin_amdgcn_mfma_f32_32x32x16_bf16(pa2, PKV(l2, h2), od, 0, 0, 0);
    od = __builtin_amdgcn_mfma_f32_32x32x16_bf16(pa3, PKV(l3, h3), od, 0, 0, 0);
#undef PKV
}
__device__ __forceinline__ void pv_d0(f32x16* o, int vb, bf16x8 pa0, bf16x8 pa1, bf16x8 pa2, bf16x8 pa3) {
    pv_one<0>(o[0], vb, pa0, pa1, pa2, pa3); pv_one<1>(o[1], vb, pa0, pa1, pa2, pa3); pv_one<2>(o[2], vb, pa0, pa1, pa2, pa3); pv_one<3>(o[3], vb, pa0, pa1, pa2, pa3);
}
__device__ __forceinline__ void partialSM(f32x16& p0, f32x16& p1, float& m_reg, float& alpha, float C, float thr) {
    float pmax = p0[0];
#pragma unroll
    for (int r = 1; r < 16; ++r) pmax = fmaxf(pmax, p0[r]);
#pragma unroll
    for (int r = 0; r < 16; ++r) pmax = fmaxf(pmax, p1[r]);
    { auto rr = __builtin_amdgcn_permlane32_swap(__float_as_uint(pmax), __float_as_uint(pmax), false, false); pmax = fmaxf(__uint_as_float(rr[0]), __uint_as_float(rr[1])); }
    float mn;
    if (__builtin_expect(__all(pmax - m_reg <= thr), 1)) { mn = m_reg; alpha = 1.f; }
    else { mn = fmaxf(m_reg, pmax); alpha = __builtin_amdgcn_exp2f((m_reg - mn) * C); m_reg = mn; }
    const float mnC = -mn * C;
#pragma unroll
    for (int r = 0; r < 16; ++r) p0[r] = fmaf(p0[r], C, mnC);
#pragma unroll
    for (int r = 0; r < 16; ++r) p1[r] = fmaf(p1[r], C, mnC);
#pragma unroll
    for (int r = 0; r < 16; ++r) p0[r] = __builtin_amdgcn_exp2f(p0[r]);
}
__device__ __forceinline__ void finishSM(f32x16& p0, f32x16& p1, float alpha, float& l_reg, bf16x8& pa0, bf16x8& pa1, bf16x8& pa2, bf16x8& pa3) {
#pragma unroll
    for (int r = 0; r < 16; ++r) p1[r] = __builtin_amdgcn_exp2f(p1[r]);
    float ps = 0;
#pragma unroll
    for (int r = 0; r < 16; ++r) ps += p0[r];
#pragma unroll
    for (int r = 0; r < 16; ++r) ps += p1[r];
    { auto rr = __builtin_amdgcn_permlane32_swap(__float_as_uint(ps), __float_as_uint(ps), false, false); ps = __uint_as_float(rr[0]) + __uint_as_float(rr[1]); }
    l_reg = l_reg * alpha + ps;
#define PK4(P, BASE, OUT) do { unsigned a0 = cvt_pk_bf16(P[BASE + 0], P[BASE + 1]), a1 = cvt_pk_bf16(P[BASE + 2], P[BASE + 3]);   \
    unsigned b0 = cvt_pk_bf16(P[BASE + 4], P[BASE + 5]), b1 = cvt_pk_bf16(P[BASE + 6], P[BASE + 7]);                              \
    auto r0 = __builtin_amdgcn_permlane32_swap(a0, b0, false, false); auto r1 = __builtin_amdgcn_permlane32_swap(a1, b1, false, false); \
    u32x4 w = {r0[0], r1[0], r0[1], r1[1]}; OUT = __builtin_bit_cast(bf16x8, w); } while (0)
    PK4(p0, 0, pa0); PK4(p0, 8, pa1); PK4(p1, 0, pa2); PK4(p1, 8, pa3);
#undef PK4
}

struct Args {
    const bf16_t* Q; int ldq;
    const bf16_t* Kn; int ldk;
    const bf16_t* Kr; int ldkr;
    const bf16_t* V; int ldv;
    bf16_t* O; int ldo;
    int nt, n1, base1, base2;
    float scale;
    int g, rlo; const float* bias;
};

template <int DQK, bool NA>
__device__ __forceinline__ void unit(const Args& a, char* lds) {
    constexpr int ND = DQK / 16, KROW = DQK * 2, SHM_V = KVBLK * 128 * 2, SHM_K = KVBLK * KROW;
#define KSWZ(row, colB) ((row) * KROW + ((colB) ^ (((row) & 7) << 4)))
    int tid = threadIdx.x; asm volatile("" : "+v"(tid));
    const int wid = tid >> 6, lane = tid & 63, r32 = lane & 31, hi = lane >> 5;
    char* V_lds = lds; char* K_lds = lds + 2 * SHM_V;
    float* ws = (float*)(lds + 2 * SHM_V + 2 * SHM_K) + wid * 64; float* li_l = ws; float* al_l = ws + 32;
    float* bt = (float*)(lds + 2 * SHM_V + 2 * SHM_K + NW * 256);
    const float C = a.scale * 1.4426950408889634f, thr = 8.0f / a.scale;
    __syncthreads();
    if (NA) { const float inv = 1.0f / a.scale; for (int i = tid; i < 15 * 128; i += 512) { const int c = (i & 127) - 48; bt[i] = (c >= 0 && c < 31) ? a.bias[(i >> 7) * 31 + c] * inv : 0.f; } }
    float m_reg = -1e30f, l_reg = 0; f32x16 o[4] = {}; bf16x8 qr[ND];
    { const bf16_t* Qw = a.Q + (size_t)(wid * QBLK + r32) * a.ldq + hi * 8;
#pragma unroll
      for (int d0 = 0; d0 < ND; ++d0) qr[d0] = *(const bf16x8*)(Qw + d0 * 16); }
    const int sr = tid >> 4, sc = (tid & 15) * 8, vst0 = v_st(sr, sc), vst1 = v_st(32 + sr, sc);
    const int krr = tid >> 3, krc = (tid & 7) * 8;
    const int vb0 = (int)(uintptr_t)V_lds + v_rd_base(lane);
    const int qidx = wid * 32 + r32, qr_row = 4 * a.g + (qidx >> 6), qc = qidx & 63;
    const int r0w = min(max(qr_row - 4, 0), 24), csw = min(max(qc - 8, 0), 48);
    unsigned cmask = 0u;
    if (NA) {
#pragma unroll
        for (int i = 0; i < 16; ++i) { const int kc_ = crow(i, hi); if (kc_ >= csw && kc_ < csw + 16) cmask |= 1u << i; if (kc_ + 32 >= csw && kc_ + 32 < csw + 16) cmask |= 1u << (16 + i); } }
    const float* btl = bt + (4 * hi - qc + 15 + 48);
    bf16x8 vs0, vs1, ks0, ks1, kr0;
#define TOKOF(j) ((j) < a.n1 ? a.base1 + 64 * (j) : a.base2 + 64 * ((j) - a.n1))
#define SLOAD(j) do { const int t0_ = TOKOF(j); \
    vs0 = *(const bf16x8*)(a.V + (size_t)(t0_ + sr) * a.ldv + sc); vs1 = *(const bf16x8*)(a.V + (size_t)(t0_ + 32 + sr) * a.ldv + sc); \
    ks0 = *(const bf16x8*)(a.Kn + (size_t)(t0_ + sr) * a.ldk + sc); ks1 = *(const bf16x8*)(a.Kn + (size_t)(t0_ + 32 + sr) * a.ldk + sc); \
    if (DQK == 192) kr0 = *(const bf16x8*)(a.Kr + (size_t)(t0_ + krr) * a.ldkr + krc); } while (0)
#define SWRITE(b) do { *(bf16x8*)(V_lds + (b) * SHM_V + vst0) = vs0; *(bf16x8*)(V_lds + (b) * SHM_V + vst1) = vs1; \
    *(bf16x8*)(K_lds + (b) * SHM_K + KSWZ(sr, sc * 2)) = ks0; *(bf16x8*)(K_lds + (b) * SHM_K + KSWZ(32 + sr, sc * 2)) = ks1; \
    if (DQK == 192) *(bf16x8*)(K_lds + (b) * SHM_K + KSWZ(krr, 256 + krc * 2)) = kr0; } while (0)
#define QKT(P0, P1, b) do { P0 = f32x16{}; P1 = f32x16{}; const char* Ks_ = K_lds + (b) * SHM_K; \
    _Pragma("unroll") for (int d0 = 0; d0 < ND; ++d0) { const int cb = (d0 * 16 + hi * 8) * 2; \
      const bf16x8 b0_ = *(const bf16x8*)(Ks_ + KSWZ(r32, cb)); const bf16x8 b1_ = *(const bf16x8*)(Ks_ + KSWZ(32 + r32, cb)); \
      P0 = __builtin_amdgcn_mfma_f32_32x32x16_bf16(b0_, qr[d0], P0, 0, 0, 0); P1 = __builtin_amdgcn_mfma_f32_32x32x16_bf16(b1_, qr[d0], P1, 0, 0, 0); } } while (0)
#define MASK(P0, P1, j) do { if (NA && (j) >= a.n1) { const int rr_ = a.rlo + (j) - a.n1; const float* bp_ = btl + 128 * (rr_ - qr_row + 7); \
      _Pragma("unroll") for (int i = 0; i < 16; ++i) { const int ko_ = (i & 3) + 8 * (i >> 2); \
        P0[i] = ((cmask >> i) & 1u) ? P0[i] + bp_[ko_] : -INFINITY; P1[i] = ((cmask >> (16 + i)) & 1u) ? P1[i] + bp_[ko_ + 32] : -INFINITY; } } } while (0)
#define RESC(al) do { if (__any((al) < 1.f)) { if (hi == 0) al_l[r32] = (al); asm volatile("s_waitcnt lgkmcnt(0)" ::: "memory"); \
    _Pragma("unroll") for (int d = 0; d < 4; ++d) _Pragma("unroll") for (int r = 0; r < 16; ++r) o[d][r] *= al_l[crow(r, hi)]; } } while (0)
    f32x16 p0, p1; float al; bf16x8 pa0, pa1, pa2, pa3; const int NT = a.nt;
    SLOAD(0); SWRITE(0); __syncthreads();
    for (int j = 0; j < NT; ++j) {
        const int cb_ = j & 1;
        if (j + 1 < NT) SLOAD(j + 1);
        bool live = true;
        if (NA && j >= a.n1) { const int rr_ = a.rlo + j - a.n1; const int r0u = __builtin_amdgcn_readfirstlane(r0w); live = (rr_ >= r0u) && (rr_ < r0u + 8); }
        if (live) {
        SBAR(); QKT(p0, p1, cb_); MASK(p0, p1, j);
        partialSM(p0, p1, m_reg, al, C, thr);
        RESC(al);
        finishSM(p0, p1, al, l_reg, pa0, pa1, pa2, pa3); SBAR();
        pv_d0(o, vb0 + cb_ * SHM_V, pa0, pa1, pa2, pa3);
        }
        if (j + 1 < NT) SWRITE(cb_ ^ 1);
        __syncthreads();
    }
    if (hi == 0) li_l[r32] = l_reg; asm volatile("s_waitcnt lgkmcnt(0)" ::: "memory");
    float rli[16];
#pragma unroll
    for (int r = 0; r < 16; ++r) rli[r] = __builtin_amdgcn_rcpf(li_l[crow(r, hi)]);
    bf16_t* Ow = a.O + (size_t)(wid * QBLK) * a.ldo;
#pragma unroll
    for (int r = 0; r < 16; ++r) { const int orow = crow(r, hi);
#pragma unroll
        for (int d0 = 0; d0 < 4; ++d0) Ow[(size_t)orow * a.ldo + d0 * 32 + r32] = f2bf(o[d0][r] * rli[r]); }
#undef KSWZ
#undef TOKOF
#undef SLOAD
#undef SWRITE
#undef QKT
#undef MASK
#undef RESC
}
#undef SBAR
}

template <int N, int NCH>
__device__ __forceinline__ void hyena_unit(int c0, int col0, const bf16_t* PT, const bf16_t* filt0, int fstride, bf16_t* YH, const float* cw, const float* cb, const float* hbias, unsigned char* lds) {
    constexpr int LZ = N + 40, FL = 2 * N + 64, CHB = (16 * LZ + 2 * FL + 4 * N) * 2;
    int tid = threadIdx.x; asm volatile("" : "+v"(tid));
    const int lane = tid & 63, wave = __builtin_amdgcn_readfirstlane(tid >> 6);
    __syncthreads();
    for (int i = tid; i < NCH * 16 * 40; i += 512) { const int ch = i / 640, r = (i % 640) / 40, e = i % 40, sg = r >> 2; bf16_t* zr = (bf16_t*)(lds + ch * CHB) + r * LZ;
        zr[e < 32 - sg ? e : N + 32 - sg + (e - (32 - sg))] = 0; }
    for (int i = tid; i < NCH * (2 * FL) / 8; i += 512) { const int ch = i / ((2 * FL) / 8), e = i % ((2 * FL) / 8);
        ((u32x4*)(lds + ch * CHB + 16 * LZ * 2))[e] = ((const u32x4*)(filt0 + (size_t)ch * fstride))[e]; }
    u32x2 wv[4], wa[4], wx[4]; unsigned short hv[4][2], ha[4][2], hx[4][2];
#pragma unroll
    for (int q = 0; q < 4; ++q) { const int i = tid + 512 * q, ch = i / N, ii = i % N, b = ii / (N / 4), s0 = (ii % (N / 4)) * 4, c = c0 + ch; const size_t off = (size_t)col0 + (size_t)b * N + s0;
        const bf16_t* pv_ = PT + (size_t)c * TOK + off; const bf16_t* pa_ = PT + (size_t)(HYW + c) * TOK + off; const bf16_t* px_ = PT + (size_t)(2 * HYW + c) * TOK + off;
        wv[q] = *(const u32x2*)pv_; wa[q] = *(const u32x2*)pa_; wx[q] = *(const u32x2*)px_;
        hv[q][0] = s0 > 0 ? pv_[-1] : 0; hv[q][1] = s0 + 4 < N ? pv_[4] : 0; ha[q][0] = s0 > 0 ? pa_[-1] : 0; ha[q][1] = s0 + 4 < N ? pa_[4] : 0; hx[q][0] = s0 > 0 ? px_[-1] : 0; hx[q][1] = s0 + 4 < N ? px_[4] : 0; }
#pragma unroll
    for (int q = 0; q < 4; ++q) { const int i = tid + 512 * q, ch = i / N, ii = i % N, b = ii / (N / 4), s0 = (ii % (N / 4)) * 4, c = c0 + ch;
        const float wv0 = cw[c], wv1 = cw[1536 + c], wv2 = cw[3072 + c], bv = cb[c];
        const float wa0 = cw[HYW + c], wa1 = cw[1536 + HYW + c], wa2 = cw[3072 + HYW + c], ba = cb[HYW + c];
        const float wx0 = cw[2 * HYW + c], wx1 = cw[1536 + 2 * HYW + c], wx2 = cw[3072 + 2 * HYW + c], bx2 = cb[2 * HYW + c];
        float v[6], x1[6], x2[6];
        v[0] = bf2f(hv[q][0]); v[1] = bf2f(wv[q].x & 0xffff); v[2] = bf2f(wv[q].x >> 16); v[3] = bf2f(wv[q].y & 0xffff); v[4] = bf2f(wv[q].y >> 16); v[5] = bf2f(hv[q][1]);
        x1[0] = bf2f(ha[q][0]); x1[1] = bf2f(wa[q].x & 0xffff); x1[2] = bf2f(wa[q].x >> 16); x1[3] = bf2f(wa[q].y & 0xffff); x1[4] = bf2f(wa[q].y >> 16); x1[5] = bf2f(ha[q][1]);
        x2[0] = bf2f(hx[q][0]); x2[1] = bf2f(wx[q].x & 0xffff); x2[2] = bf2f(wx[q].x >> 16); x2[3] = bf2f(wx[q].y & 0xffff); x2[4] = bf2f(wx[q].y >> 16); x2[5] = bf2f(hx[q][1]);
        float z[4], ux[4];
#pragma unroll
        for (int e = 0; e < 4; ++e) { const float uv = wv0 * v[e] + wv1 * v[e + 1] + wv2 * v[e + 2] + bv, ua = wa0 * x1[e] + wa1 * x1[e + 1] + wa2 * x1[e + 2] + ba; z[e] = ua * uv; ux[e] = wx0 * x2[e] + wx1 * x2[e + 1] + wx2 * x2[e + 2] + bx2; }
        const unsigned p01 = cvt_pk_bf16(z[0], z[1]), p23 = cvt_pk_bf16(z[2], z[3]), p12 = (p01 >> 16) | (p23 << 16);
        bf16_t* ZS = (bf16_t*)(lds + ch * CHB); bf16_t* X2S = ZS + 16 * LZ + 2 * FL;
        { u32x2 w; w.x = p01; w.y = p23; *(u32x2*)(ZS + (0 * 4 + b) * LZ + s0 + 32) = w; }
        { bf16_t* r = ZS + (2 * 4 + b) * LZ + s0 + 30; *(unsigned*)r = p01; *(unsigned*)(r + 2) = p23; }
        { bf16_t* r = ZS + (1 * 4 + b) * LZ + s0 + 31; r[0] = (bf16_t)(p01 & 0xffff); *(unsigned*)(r + 1) = p12; r[3] = (bf16_t)(p23 >> 16); }
        { bf16_t* r = ZS + (3 * 4 + b) * LZ + s0 + 29; r[0] = (bf16_t)(p01 & 0xffff); *(unsigned*)(r + 1) = p12; r[3] = (bf16_t)(p23 >> 16); }
        { u32x2 w; w.x = cvt_pk_bf16(ux[0], ux[1]); w.y = cvt_pk_bf16(ux[2], ux[3]); *(u32x2*)(X2S + b * N + s0) = w; }
    }
    __syncthreads();
    {
        const int ch = (NCH == 1) ? 0 : wave, T0a = (NCH == 1) ? 256 * wave : 0, c = c0 + ch;
        const bf16_t* ZS = (const bf16_t*)(lds + ch * CHB); const bf16_t* RF = ZS + 16 * LZ; const bf16_t* X2S = RF + 2 * FL;
        constexpr int nks = (N + 32) / 32;
        const int rho = lane & 15, gq4 = lane >> 4, colb = (lane & 15) >> 2, sg = lane & 3;
        const bf16_t* zrow = ZS + (sg * 4 + colb) * LZ + 8 * gq4;
        const bf16_t* ra = RF + (N - T0a - 8 * rho + 8 * gq4);
        f32x4 acc[2][2] = {{{0.f, 0.f, 0.f, 0.f}, {0.f, 0.f, 0.f, 0.f}}, {{0.f, 0.f, 0.f, 0.f}, {0.f, 0.f, 0.f, 0.f}}};
#define HY_LD(B, A0, A1, A2, A3, ks) do { B = *(const bf16x8*)(zrow + 32 * (ks)); A0 = *(const bf16x8*)(ra + 32 * (ks)); A1 = *(const bf16x8*)(ra + FL + 32 * (ks)); A2 = *(const bf16x8*)(ra - 128 + 32 * (ks)); A3 = *(const bf16x8*)(ra - 128 + FL + 32 * (ks)); } while (0)
#define HY_MM(B, A0, A1, A2, A3) do { acc[0][0] = __builtin_amdgcn_mfma_f32_16x16x32_bf16(A0, B, acc[0][0], 0, 0, 0); acc[0][1] = __builtin_amdgcn_mfma_f32_16x16x32_bf16(A1, B, acc[0][1], 0, 0, 0); \
            acc[1][0] = __builtin_amdgcn_mfma_f32_16x16x32_bf16(A2, B, acc[1][0], 0, 0, 0); acc[1][1] = __builtin_amdgcn_mfma_f32_16x16x32_bf16(A3, B, acc[1][1], 0, 0, 0); } while (0)
        bf16x8 b0, p0, p1, p2, p3, b1, q0, q1, q2, q3;
        HY_LD(b0, p0, p1, p2, p3, 0);
        static_assert(nks % 2 == 1, "odd step count");
        for (int ks = 0; ks + 2 < nks; ks += 2) {
            HY_LD(b1, q0, q1, q2, q3, ks + 1); __builtin_amdgcn_sched_barrier(0);
            HY_MM(b0, p0, p1, p2, p3); __builtin_amdgcn_sched_barrier(0);
            HY_LD(b0, p0, p1, p2, p3, ks + 2); __builtin_amdgcn_sched_barrier(0);
            HY_MM(b1, q0, q1, q2, q3); __builtin_amdgcn_sched_barrier(0);
        }
        HY_MM(b0, p0, p1, p2, p3);
#undef HY_LD
#undef HY_MM
        const float hb_ = hbias[c];
        bf16_t* OS = (bf16_t*)(lds + NCH * CHB) + ch * 4 * N;
#pragma unroll
        for (int ti = 0; ti < 2; ++ti)
#pragma unroll
            for (int di = 0; di < 2; ++di)
#pragma unroll
                for (int rg = 0; rg < 4; ++rg) { const int t = T0a + 128 * ti + 8 * (4 * gq4 + rg) + 4 * di + sg;
                    const float zt = bf2f(ZS[colb * LZ + t + 32]), x2v = bf2f(X2S[colb * N + t]);
                    OS[colb * N + t] = f2bf(x2v * (acc[ti][di][rg] + zt * hb_)); }
    }
    __syncthreads();
#pragma unroll
    for (int j = 0; j < (NCH * 4 * N) / (8 * 512); ++j) { const int e = (tid + 512 * j) * 8, ch = e / (4 * N), r = e % (4 * N);
        *(u32x4*)(YH + (size_t)(c0 + ch) * TOK + col0 + r) = *(const u32x4*)((const bf16_t*)(lds + NCH * CHB) + e); }
}

#define XB_TMO      128
#define XB_XCNT(j)  (256  + 64 * (j))
#define XB_XSUB(j)  (1280 + 64 * (j))
#define XB_XGEN(j)  (2304 + 64 * (j))
#define XB_TOP      3328
#define XB_TOPGEN   3392
#define XCD_BAR_WORDS 3456
#define XB_SPIN_CAP (1u << 18)
__device__ __forceinline__ unsigned xb_ld(unsigned* p)              { return __hip_atomic_load(p, __ATOMIC_RELAXED, __HIP_MEMORY_SCOPE_AGENT); }
__device__ __forceinline__ unsigned xb_add(unsigned* p, unsigned v) { return __hip_atomic_fetch_add(p, v, __ATOMIC_RELAXED, __HIP_MEMORY_SCOPE_AGENT); }
__device__ __forceinline__ unsigned xb_xcc_id() { return (unsigned)__builtin_amdgcn_s_getreg((3 << 11) | 20) & 0xFu; }
#define XB_SPIN(cond, bar) do { unsigned _sp = 0; while (cond) { __builtin_amdgcn_s_sleep(1); \
    if ((++_sp & 255u) == 0u) { if (xb_ld(&(bar)[XB_TMO])) break; if (_sp > XB_SPIN_CAP) { atomicAdd(&(bar)[XB_TMO], 1u); break; } } } } while (0)
struct XcdBarrier { unsigned* bar; volatile LAS unsigned* st; };
__device__ __forceinline__ XcdBarrier xcd_barrier_post(unsigned* bar, volatile LAS unsigned* st) {
    XcdBarrier b; b.bar = bar; b.st = st;
    if (threadIdx.x == 0) (void)xb_add(&bar[XB_XCNT(xb_xcc_id())], 1u);
    return b;
}
__device__ __forceinline__ void xcd_barrier_complete(unsigned* bar, unsigned x, unsigned& nloc, unsigned& nx) {
    const unsigned G = gridDim.x * gridDim.y * gridDim.z;
    unsigned sum, cnt, mine, sp = 0u;
    for (;;) {
        sum = 0u; cnt = 0u; mine = 0u;
#pragma unroll
        for (unsigned j = 0; j < 16; ++j) { const unsigned c = xb_ld(&bar[XB_XCNT(j)]); sum += c; cnt += (c > 0u) ? 1u : 0u; mine = (j == x) ? c : mine; }
        if (sum == G) break;
        __builtin_amdgcn_s_sleep(1);
        if ((++sp & 255u) == 0u) { if (xb_ld(&bar[XB_TMO])) break; if (sp > XB_SPIN_CAP) { atomicAdd(&bar[XB_TMO], 1u); break; } }
    }
    nloc = mine > 0u ? mine : 1u; nx = cnt > 0u ? cnt : 1u;
}
__device__ __forceinline__ void xcd_barrier(const XcdBarrier& b) {
    asm volatile("s_waitcnt vmcnt(0)" ::: "memory");
    __syncthreads();
    if (threadIdx.x == 0) {
        unsigned* bar = b.bar; asm volatile("" : "+s"(bar));
        __builtin_amdgcn_s_waitcnt(0);
        const unsigned bxid = xb_xcc_id();
        unsigned nloc = b.st[0], nx = b.st[1];
        if (nloc == 0u) { xcd_barrier_complete(bar, bxid, nloc, nx); b.st[0] = nloc; b.st[1] = nx; }
        const unsigned old = xb_add(&bar[XB_XSUB(bxid)], 1u);
        const unsigned gen = old / nloc;
        if (old + 1u == (gen + 1u) * nloc) {
            __builtin_amdgcn_fence(__ATOMIC_RELEASE, "agent");
            asm volatile("s_waitcnt vmcnt(0)" ::: "memory");
            const unsigned og = xb_add(&bar[XB_TOP], 1u);
            const unsigned tg = og / nx;
            if (og + 1u == (tg + 1u) * nx) xb_add(&bar[XB_TOPGEN], 1u);
            else XB_SPIN(xb_ld(&bar[XB_TOPGEN]) == tg, bar);
            __builtin_amdgcn_fence(__ATOMIC_ACQUIRE, "agent");
            xb_add(&bar[XB_XGEN(bxid)], 1u);
            asm volatile("s_waitcnt vmcnt(0)" ::: "memory");
        } else {
            XB_SPIN(xb_ld(&bar[XB_XGEN(bxid)]) == gen, bar);
            __builtin_amdgcn_fence(__ATOMIC_ACQUIRE, "agent");
            asm volatile("s_waitcnt vmcnt(0)" ::: "memory");
        }
    }
    __syncthreads();
}

struct Params { const float* in[29]; float* out; unsigned char* ws; };
enum { I_X = 0, I_C, I_CTX, I_CCTX, I_WADA, I_BADA, I_GAPRE, I_GAPOST, I_GFPRE, I_GFPOST, I_WIN, I_HCW, I_HCB, I_FW1, I_FB1, I_FW2, I_FB2, I_FW3, I_FFREQ, I_HBIAS,
       I_GQ, I_WUQ, I_GKV, I_WUKV, I_RPB, I_WOUT, I_WG, I_WU, I_WD };

__device__ __forceinline__ const float* INP(int i) { int j = i; asm volatile("" : "+s"(j)); return ((const float* const __attribute__((address_space(4)))*)__builtin_amdgcn_kernarg_segment_ptr())[j]; }
template <class Map>
__device__ __forceinline__ void transpose_item(const float* W, int K, int N, bf16_t* WT, const float* kscale, LAS float* scr, int item, int lane, const Map& map) {
    const int nblk = N / 32, kb = item / nblk, nb = item % nblk, k0 = 64 * kb, n0 = 32 * nb;
    f32x4 ld[8];
#pragma unroll
    for (int j = 0; j < 8; ++j) ld[j] = __builtin_nontemporal_load((const f32x4*)(W + (size_t)(k0 + 8 * j + (lane >> 3)) * N + n0 + 4 * (lane & 7)));
#pragma unroll
    for (int j = 0; j < 8; ++j) { const int kk = 8 * j + (lane >> 3); f32x4 v = ld[j]; if (kscale) v = v * kscale[k0 + kk];
#pragma unroll
        for (int e = 0; e < 4; ++e) scr[kk * 33 + 4 * (lane & 7) + e] = v[e]; }
    asm volatile("s_waitcnt lgkmcnt(0)" ::: "memory");
    const int c = lane & 7;
#pragma unroll
    for (int j = 0; j < 4; ++j) { const int n = (lane >> 3) + 8 * j; const LAS float* s = scr + (8 * c) * 33 + n;
        u32x4 o; o.x = cvt_pk_bf16(s[0 * 33], s[1 * 33]); o.y = cvt_pk_bf16(s[2 * 33], s[3 * 33]); o.z = cvt_pk_bf16(s[4 * 33], s[5 * 33]); o.w = cvt_pk_bf16(s[6 * 33], s[7 * 33]);
        const int drow = map(n0 + n);
        if (drow >= 0) __builtin_nontemporal_store(o, (u32x4*)(WT + (size_t)drow * K + k0 + 8 * c)); }
    asm volatile("s_waitcnt lgkmcnt(0)" ::: "memory");
}
struct MapIdent { __device__ int operator()(int n) const { return n; } };
struct MapInH   { __device__ int operator()(int n) const { return n < 1536 ? n : -1; } };
struct MapInR   { __device__ int operator()(int n) const { if (n < 1536) return -1; const int r = n - 1536; if (r >= PR_KR && r < PR_KR + 64) { const int i = r - PR_KR; return PR_KR + (i < 32 ? 2 * i : 2 * (i - 32) + 1); } return r; } };
struct MapUQ    { __device__ int operator()(int n) const { const int h = n / 192, j = n % 192; if (j < 128) return n; const int i = j - 128; return h * 192 + 128 + (i < 32 ? 2 * i : 2 * (i - 32) + 1); } };
struct MapGate  { __device__ int operator()(int n) const { return 256 * (n >> 7) + (n & 127); } };
struct MapUp    { __device__ int operator()(int n) const { return 256 * (n >> 7) + 128 + (n & 127); } };

constexpr int WI_IN = 32 * (INC / 32), WI_UQ = (QLORA / 64) * (1536 / 32), WI_UKV = (KVLORA / 64) * (2048 / 32), WI_OUT = 32 * 64, WI_G = 32 * (FF / 32), WI_D = (FF / 64) * 64;
constexpr int WPER_L = WI_IN + WI_UQ + WI_UKV + WI_OUT + 2 * WI_G + WI_D;
constexpr int W_EARLY = 2560;
__device__ __forceinline__ void weight_item(int l, int r, LAS float* scr, int lane, unsigned char* ws) {
    unsigned char* wl2 = ws + (size_t)l * WL_STRIDE;
    if (r < WI_IN) { const int nb = r % (INC / 32); const float* W = INP(I_WIN) + (size_t)l * DM * INC;
        if (nb < 48) transpose_item(W, DM, INC, (bf16_t*)(wl2 + W_INH), nullptr, scr, r, lane, MapInH()); else transpose_item(W, DM, INC, (bf16_t*)(wl2 + W_INR), nullptr, scr, r, lane, MapInR()); return; } r -= WI_IN;
    if (r < WI_UQ) { transpose_item(INP(I_WUQ) + (size_t)l * QLORA * 1536, QLORA, 1536, (bf16_t*)(wl2 + W_UQ), INP(I_GQ) + l * QLORA, scr, r, lane, MapUQ()); return; } r -= WI_UQ;
    if (r < WI_UKV) { transpose_item(INP(I_WUKV) + (size_t)l * KVLORA * 2048, KVLORA, 2048, (bf16_t*)(wl2 + W_UKV), INP(I_GKV) + l * KVLORA, scr, r, lane, MapIdent()); return; } r -= WI_UKV;
    if (r < WI_OUT) { transpose_item(INP(I_WOUT) + (size_t)l * DM * DM, DM, DM, (bf16_t*)(wl2 + W_OUT), nullptr, scr, r, lane, MapIdent()); return; } r -= WI_OUT;
    if (r < WI_G) { transpose_item(INP(I_WG) + (size_t)l * DM * FF, DM, FF, (bf16_t*)(wl2 + W_GU), nullptr, scr, r, lane, MapGate()); return; } r -= WI_G;
    if (r < WI_G) { transpose_item(INP(I_WU) + (size_t)l * DM * FF, DM, FF, (bf16_t*)(wl2 + W_GU), nullptr, scr, r, lane, MapUp()); return; } r -= WI_G;
    transpose_item(INP(I_WD) + (size_t)l * FF * DM, FF, DM, (bf16_t*)(wl2 + W_DN), nullptr, scr, r, lane, MapIdent());
}

__global__ void __launch_bounds__(512, 2) fwd_mega(Params p) {
    extern __shared__ __attribute__((aligned(16))) unsigned char lds[];
    cg::grid_group grid = cg::this_grid();
    LAS unsigned char* ldsl = (LAS unsigned char*)lds;
    const int wave = __builtin_amdgcn_readfirstlane(threadIdx.x >> 6);
    const int G = gridDim.x, NGW = G * 8;
#define bx0 ((int)blockIdx.x)
#define DECL_PTRS(L) unsigned char* ws = (unsigned char*)INP(30); asm volatile("" : "+s"(ws)); int tid = threadIdx.x; asm volatile("" : "+v"(tid)); const int lane = tid & 63; (void)lane; \
    int bx = blockIdx.x; asm volatile("" : "+s"(bx)); const int vcu = (G % 8 == 0) ? (bx % 8) * (G / 8) + bx / 8 : bx; const int gw = vcu * 8 + wave; (void)gw;   \
    float* MOD = (float*)(ws + S_MOD); float* ROPE = (float*)(ws + S_ROPE); float* SSQ = (float*)(ws + S_SSQ); float* SSQY = (float*)(ws + S_SSQY); \
    bf16_t* FILT = (bf16_t*)(ws + S_FILT); bf16_t* FILTC = (bf16_t*)(ws + S_FILTC); \
    bf16_t* Hb = (bf16_t*)(ws + A_H); bf16_t* YC = (bf16_t*)(ws + A_YC); bf16_t* YF = (bf16_t*)(ws + A_YF); bf16_t* XR = (bf16_t*)(ws + A_XR); \
    bf16_t* PR = (bf16_t*)(ws + A_PR); bf16_t* PT = (bf16_t*)(ws + A_PT); bf16_t* Qb = (bf16_t*)(ws + A_Q); bf16_t* KVb = (bf16_t*)(ws + A_KV); bf16_t* ACT = (bf16_t*)(ws + A_ACT); \
    unsigned char* wl = ws + (size_t)(L) * WL_STRIDE; const float* mod = MOD + (size_t)(L) * 5 * ADA; \
    (void)ROPE; (void)SSQ; (void)SSQY; (void)FILT; (void)FILTC; (void)Hb; (void)YC; (void)YF; (void)XR; (void)PR; (void)PT; (void)Qb; (void)KVb; (void)ACT; (void)wl; (void)mod;

#if PROBE_MULT
    unsigned long long* stamps = (unsigned long long*)((unsigned char*)INP(30) + S_CTL + 524288); int sidx = 0;
#define STAMP() do { if (bx0 == 0 && threadIdx.x == 0) stamps[sidx] = __builtin_amdgcn_s_memrealtime(); ++sidx; } while (0)
#else
#define STAMP() do {} while (0)
#endif
#if PROBE_MULT
#define DBGP(set) (stamps + 40 + 8 * (set))
#else
#define DBGP(set) nullptr
#endif
    STAMP();
    volatile LAS unsigned* MISC = (volatile LAS unsigned*)(ldsl + 131072);
    if (threadIdx.x == 0) { MISC[0] = 0u; MISC[1] = 0u; }
    {
        DECL_PTRS(0)
        { unsigned* bz = (unsigned*)(ws + S_CTL); for (int i = bx * 512 + tid; i < CW_END; i += G * 512) bz[i] = 0u; }
        for (int i = bx * 512 + tid; i < SEQ * 32; i += G * 512) { const int t = i >> 5, f = i & 31; const float pos = (f < 16) ? (float)(t >> 6) : (float)(t & 63);
            const float inv = powf(10000.0f, -(float)(f & 15) / 16.0f); const float ang = pos * inv; ROPE[2 * i] = cosf(ang); ROPE[2 * i + 1] = sinf(ang); }
        for (int l = 0; l < 2; ++l) { u32x4* z = (u32x4*)(ws + l * WL_STRIDE + W_INR + (size_t)2880 * DM * 2); const int n16 = 192 * DM * 2 / 16;
            for (int i = bx * 512 + tid; i < n16; i += G * 512) z[i] = (u32x4){0u, 0u, 0u, 0u}; }
        for (int i = bx * 512 + tid; i < 2 * HYW * 2 * 128; i += G * 512) {
            const int s = i & 127, cd = i >> 7, d = (cd & 1) * 4; bf16_t* f = FILT + (size_t)cd * FLEN;
            if (s < 64) { if (s <= d + 32) f[s] = 0; } else { const int ii = FLEN - 128 + s; if (ii >= d + 2 * SEQ + 32) f[ii] = 0; } }
        for (int i = bx * 512 + tid; i < HYW * 2 * 128; i += G * 512) {
            const int s = i & 127, cd = i >> 7, d = (cd & 1) * 4; bf16_t* f = FILTC + (size_t)cd * FLENC;
            if (s < 64) { if (s <= d + 32) f[s] = 0; } else { const int ii = FLENC - 128 + s; if (ii >= d + 2 * CTXL + 32) f[ii] = 0; } }
        if (vcu < 192) {
            if (PH(14)) {
            LAS float* sS = (LAS float*)ldsl;
            LAS float* red = (LAS float*)(ldsl + 5 * 2048 * 4);
            for (int i = tid; i < 5 * DM; i += 512) { const int m = i / DM, k = i % DM; const float v = (m < 4) ? INP(I_C)[m * DM + k] : INP(I_CCTX)[k]; sS[i] = v / (1.0f + __expf(-v)); }
            __syncthreads();
            {
                const int item = vcu, l = item / 96, n0 = (item % 96) * 128;
                const float* W = INP(I_WADA) + (size_t)l * DM * ADA + n0 + 4 * (lane & 31);
                f32x4 acc[5];
#pragma unroll
                for (int m = 0; m < 5; ++m) acc[m] = (f32x4){0.f, 0.f, 0.f, 0.f};
                const int kbase = wave * 256 + (lane >> 5);
#pragma unroll 16
                for (int kk = 0; kk < 128; ++kk) { const int k = kbase + 2 * kk; const f32x4 w = __builtin_nontemporal_load((const f32x4*)(W + (size_t)k * ADA));
#pragma unroll
                    for (int m = 0; m < 5; ++m) acc[m] += w * sS[m * DM + k]; }
#pragma unroll
                for (int m = 0; m < 5; ++m) {
#pragma unroll
                    for (int e = 0; e < 4; ++e) acc[m][e] += __shfl_xor(acc[m][e], 32);
                    if (lane < 32) *(LAS f32x4*)(red + (wave * 5 + m) * 128 + 4 * lane) = acc[m]; }
                __syncthreads();
                for (int i = tid; i < 640; i += 512) { const int m = i >> 7, c = i & 127; float s = 0.f;
#pragma unroll
                    for (int w = 0; w < 8; ++w) s += red[(w * 5 + m) * 128 + c];
                    MOD[((size_t)l * 5 + m) * ADA + n0 + c] = s + INP(I_BADA)[(size_t)l * ADA + n0 + c]; }
            }
            }
        } else if (PH(15)) {
            LAS float* tb = (LAS float*)(ldsl + wave * 16384);
            float* H2T = (float*)(ws + S_H2T);
            for (int it = (vcu - 192) * 8 + wave; it < 136; it += (G - 192) * 8) {
                const int set = it < 64 ? 0 : (it < 128 ? 1 : 2), r = it - 64 * set, l = (set == 1) ? 1 : 0, n = (set == 2) ? CTXL : SEQ, pos0 = r * 32, li = lane & 31, hh = lane >> 5;
                const float* w1 = INP(I_FW1) + l * 33 * 64; const float* b1 = INP(I_FB1) + l * 64; const float* w2 = INP(I_FW2) + l * 64 * 64; const float* b2 = INP(I_FB2) + l * 64; const float* fr = INP(I_FFREQ) + l * 64;
                constexpr float INV2PI = 0.15915494309189535f;
                const int pos = pos0 + li;
                f32x16 acc[2] = {f32x16{}, f32x16{}};
#pragma unroll
                for (int s = 0; s < 17; ++s) { const int k = 2 * s + hh; float a;
                    if (k == 0) a = (float)pos / (float)(n - 1);
                    else if (k == 33) a = 0.f;
                    else { const int bi = (k - 1) & 15; const float band = 1e-4f + (float)bi * ((15.0f - 1e-4f) / 15.0f); const float rev = (float)pos * band / (float)n;
                        a = (k <= 16) ? __builtin_amdgcn_cosf(rev) : -__builtin_amdgcn_sinf(rev); }
                    const int kc = k < 33 ? k : 32;
#pragma unroll
                    for (int cb = 0; cb < 2; ++cb) { const float b = (k < 33) ? w1[kc * 64 + 32 * cb + li] : 0.f; acc[cb] = __builtin_amdgcn_mfma_f32_32x32x2f32(a, b, acc[cb], 0, 0, 0); } }
#pragma unroll
                for (int cb = 0; cb < 2; ++cb) { const int j = 32 * cb + li; const float frj = fr[j] * INV2PI, bj = b1[j];
#pragma unroll
                    for (int rg = 0; rg < 16; ++rg) { const int prow = (rg & 3) + 8 * (rg >> 2) + 4 * hh; tb[prow * 65 + j] = __builtin_amdgcn_sinf(frj * (acc[cb][rg] + bj)); } }
                asm volatile("s_waitcnt lgkmcnt(0)" ::: "memory");
                acc[0] = f32x16{}; acc[1] = f32x16{};
#pragma unroll 8
                for (int s = 0; s < 32; ++s) { const int k = 2 * s + hh; const float a = tb[li * 65 + k];
#pragma unroll
                    for (int cb = 0; cb < 2; ++cb) acc[cb] = __builtin_amdgcn_mfma_f32_32x32x2f32(a, w2[k * 64 + 32 * cb + li], acc[cb], 0, 0, 0); }
                asm volatile("s_waitcnt lgkmcnt(0)" ::: "memory");
#pragma unroll
                for (int cb = 0; cb < 2; ++cb) { const int j = 32 * cb + li; const float frj = fr[j] * INV2PI, bj = b2[j]; float* o = H2T + (size_t)set * 64 * SEQ + (size_t)j * n + pos0;
#pragma unroll
                    for (int rg = 0; rg < 16; ++rg) { const int prow = (rg & 3) + 8 * (rg >> 2) + 4 * hh; o[prow] = __builtin_amdgcn_sinf(frj * (acc[cb][rg] + bj)); } }
            }
            if (PH(16)) { asm volatile("s_waitcnt lgkmcnt(0)" ::: "memory"); for (int it = (vcu - 192) * 8 + wave; it < W_EARLY; it += (G - 192) * 8) weight_item(0, it, tb, lane, ws); }
        }
    }
    grid.sync();
    STAMP();
    XcdBarrier xb = xcd_barrier_post((unsigned*)((unsigned char*)INP(30) + S_CTL), MISC);
    {
        DECL_PTRS(0)
        LAS float* scr = (LAS float*)(ldsl + wave * 16384);
        constexpr int I_IN = 32 * (INC / 32), I_UQ = (QLORA / 64) * (1536 / 32), I_UKV = (KVLORA / 64) * (2048 / 32), I_OUT = 32 * 64, I_G = 32 * (FF / 32), I_D = (FF / 64) * 64;
        constexpr int PER_L = I_IN + I_UQ + I_UKV + I_OUT + 2 * I_G + I_D;
        constexpr int N_F3 = 2 * (SEQ / 32) * 8 + (CTXL / 32) * 8, N_TR = 2 * PER_L - W_EARLY, N_ALL = N_F3 + N_TR + TOK;
        for (int it0 = gw; it0 < N_ALL; it0 += NGW) {
            int it = it0;
            if (it < N_F3) {
                if (!PH(15)) continue;
                int set, r; if (it < 512) { set = 0; r = it; } else if (it < 1024) { set = 1; r = it - 512; } else { set = 2; r = it - 1024; }
                const int l = (set == 1) ? 1 : 0, n = (set == 2) ? CTXL : SEQ, pos0 = (r >> 3) * 32, c0 = (r & 7) * 128, li = lane & 31, hh = lane >> 5;
                const float* H2T = (const float*)(ws + S_H2T) + (size_t)set * 64 * SEQ + pos0 + li; const float* w3 = INP(I_FW3) + (size_t)l * 64 * 1024 + c0 + li;
                f32x16 acc[4];
#pragma unroll
                for (int cb = 0; cb < 4; ++cb) acc[cb] = f32x16{};
#pragma unroll 8
                for (int s = 0; s < 32; ++s) { const int k = 2 * s + hh; const float a = H2T[(size_t)k * n];
#pragma unroll
                    for (int cb = 0; cb < 4; ++cb) acc[cb] = __builtin_amdgcn_mfma_f32_32x32x2f32(a, w3[k * 1024 + 32 * cb], acc[cb], 0, 0, 0); }
                bf16_t* F = (set == 2) ? FILTC : FILT + (size_t)l * HYW * 2 * FLEN; const int flen = (set == 2) ? FLENC : FLEN;
                const float invn = 1.0f / (float)(n - 1);
#pragma unroll
                for (int cb = 0; cb < 4; ++cb) {
                    const int cabs = c0 + 32 * cb + li, ch = cabs & (HYW - 1);
                    const float delta = fabsf(-15.350567286626973f + (float)ch * ((-3.0701134573253945f + 15.350567286626973f) / 511.0f));
#pragma unroll
                    for (int rg = 0; rg < 16; ++rg) { const int prow = (rg & 3) + 8 * (rg >> 2) + 4 * hh; scr[li * 33 + prow] = acc[cb][rg] * __expf(-(float)(pos0 + prow) * invn * delta); }
                    asm volatile("s_waitcnt lgkmcnt(0)" ::: "memory");
                    const int pos = pos0 + li;
#pragma unroll 4
                    for (int i2 = 0; i2 < 16; ++i2) { const int col = 2 * i2 + hh, c2 = c0 + 32 * cb + col; const bool bwd = c2 >= HYW; const bf16_t kb = f2bf(scr[col * 33 + li]);
                        bf16_t* f0 = F + (size_t)((c2 & (HYW - 1)) * 2) * flen;
                        if (!bwd) { f0[n + 32 - pos] = kb; f0[flen + 4 + n + 32 - pos] = kb; }
                        else if (pos >= 1) { f0[n + 32 + pos] = kb; f0[flen + 4 + n + 32 + pos] = kb; } }
                    asm volatile("s_waitcnt lgkmcnt(0)" ::: "memory");
                }
                continue;
            }
            it -= N_F3;
            if (it < N_TR) {
                if (!PH(16)) continue;
                { const int gi = it + W_EARLY; weight_item(gi / WPER_L, gi % WPER_L, scr, lane, ws); }
                continue;
            }
            it -= N_TR;
            if (PH(1)) {
                const int row = it; const float* gpre = INP(I_GAPRE);
                const float* src = (row < NLAT) ? INP(I_X) + (size_t)row * DM : INP(I_CTX) + (size_t)(row - NLAT) * DM;
                const int bm = (row < NLAT) ? (row >> 11) : 4; const float* mrow = mod + (size_t)bm * ADA;
                f32x4 v[8]; float ss = 0.f;
#pragma unroll
                for (int j = 0; j < 8; ++j) { v[j] = *(const f32x4*)(src + 4 * lane + 256 * j); ss += pg8::dot4(v[j]); }
                const float rs = 1.0f / sqrtf(wave_sum(ss) * (1.0f / DM) + RMS_EPS);
#pragma unroll
                for (int j = 0; j < 8; ++j) { const int k = 4 * lane + 256 * j; const f32x4 gg = *(const f32x4*)(gpre + k), sh = *(const f32x4*)(mrow + k), sc = *(const f32x4*)(mrow + DM + k);
                    const f32x4 hh = v[j] * rs * gg * (sc + 1.0f) + sh; u32x2 w; w.x = cvt_pk_bf16(hh[0], hh[1]); w.y = cvt_pk_bf16(hh[2], hh[3]); *(u32x2*)(Hb + (size_t)row * DM + k) = w; }
            }
        }
    }
    xcd_barrier(xb); STAMP();

    for (int l = 0; l < 2; ++l) {
        const int MR = (l == 0) ? TOK : NLAT;
        if (PH(2)) {
            DECL_PTRS(l)
            { pg8::Gemm g{Hb, (const bf16_t*)(wl + W_INR), TOK, PRW, DM, DM, DM}; pg8::StaticOrder S; S.init(TOK, PRW, G, bx); pg8::EpiPR E{PR, SSQ, ROPE}; pg8::gemm_phase(ldsl, g, S, E); }
            { pg8::Gemm g{(const bf16_t*)(wl + W_INH), Hb, 1536, TOK, DM, DM, DM}; pg8::StaticOrder S; S.init(1536, TOK, G, (bx + 176) % G); pg8::EpiBf16 E{PT, TOK}; pg8::gemm_phase(ldsl, g, S, E); }
        }
        xcd_barrier(xb); STAMP();
        if (PH(3)) {
            DECL_PTRS(l)
            const int MQ = (l == 0) ? TOK : NLAT;
            { pg8::Gemm g{PR, (const bf16_t*)(wl + W_UQ), MQ, 1536, QLORA, PRW, QLORA}; pg8::StaticOrder S; S.init(MQ, 1536, G, bx); pg8::EpiQ E{Qb, SSQ, ROPE}; pg8::gemm_phase(ldsl, g, S, E); }
            { pg8::Gemm g{PR + QLORA, (const bf16_t*)(wl + W_UKV), TOK, 2048, KVLORA, PRW, KVLORA}; pg8::StaticOrder S; S.init(TOK, 2048, G, (bx + 40) % G); pg8::EpiKV E{KVb, SSQ}; pg8::gemm_phase(ldsl, g, S, E); }
        }
        xcd_barrier(xb); STAMP();
        {
            DECL_PTRS(l)
            char* al = (char*)lds;
            if (PH(10))
            for (int uidx = vcu; uidx < 256; uidx += G) {
                const int bh = uidx >> 3, qb = uidx & 7, b = bh >> 3, h = bh & 7; const int row0 = b * SEQ + qb * 256;
                att::Args a; a.Q = Qb + (size_t)row0 * 1536 + h * 192; a.ldq = 1536; a.Kn = KVb + h * 256; a.ldk = 2048; a.Kr = PR + PR_KR; a.ldkr = PRW; a.V = KVb + h * 256 + 128; a.ldv = 2048;
                a.O = YC + (size_t)row0 * DM + 512 + h * 128; a.ldo = DM; a.nt = 36; a.n1 = 32; a.base1 = b * SEQ; a.base2 = NLAT + b * CTXL; a.scale = MLA_SCALE; a.g = 0; a.rlo = 0; a.bias = nullptr;
                att::unit<192, false>(a, al);
            }
#if PROBE_MULT && PROBE_SUB
            xcd_barrier(xb); STAMP();
#endif
            const float* rpb = INP(I_RPB) + (size_t)l * 4 * 15 * 31;
            if (PH(11))
            for (int uidx = vcu; uidx < 128; uidx += G) {
                const int bh = uidx >> 3, gq = uidx & 7, b = bh >> 2, h = bh & 3; const int row0 = b * SEQ + gq * 256;
                const int rlo = min(max(4 * gq - 4, 0), 24), nr = (gq == 0 || gq == 7) ? 8 : 11;
                att::Args a; a.Q = PR + (size_t)row0 * PRW + PR_NAQ + h * 128; a.ldq = PRW; a.Kn = PR + PR_NAK + h * 128; a.ldk = PRW; a.Kr = nullptr; a.ldkr = 0; a.V = PR + PR_NAV + h * 128; a.ldv = PRW;
                a.O = YC + (size_t)row0 * DM + 1536 + h * 128; a.ldo = DM; a.nt = 4 + nr; a.n1 = 4; a.base1 = NLAT + b * CTXL; a.base2 = b * SEQ + rlo * 64; a.scale = NA_SCALE; a.g = gq; a.rlo = rlo; a.bias = rpb + h * 15 * 31;
                att::unit<128, true>(a, al);
            }
#if PROBE_MULT && PROBE_SUB
            xcd_barrier(xb); STAMP();
#endif
            if (l == 0 && PH(12)) {
                for (int uidx = vcu - 128; uidx >= 0 && uidx < 32; uidx += G) { const int b = uidx >> 3, h = uidx & 7; const int row0 = NLAT + b * CTXL;
                    att::Args a; a.Q = Qb + (size_t)row0 * 1536 + h * 192; a.ldq = 1536; a.Kn = KVb + h * 256; a.ldk = 2048; a.Kr = PR + PR_KR; a.ldkr = PRW; a.V = KVb + h * 256 + 128; a.ldv = 2048;
                    a.O = YC + (size_t)row0 * DM + 512 + h * 128; a.ldo = DM; a.nt = 4; a.n1 = 4; a.base1 = row0; a.base2 = row0; a.scale = MLA_SCALE; a.g = 0; a.rlo = 0; a.bias = nullptr;
                    att::unit<192, false>(a, al); }
                for (int uidx = vcu - 160; uidx >= 0 && uidx < 16; uidx += G) { const int b = uidx >> 2, h = uidx & 3; const int row0 = NLAT + b * CTXL;
                    att::Args a; a.Q = PR + (size_t)row0 * PRW + PR_NAQ + h * 128; a.ldq = PRW; a.Kn = PR + PR_NAK + h * 128; a.ldk = PRW; a.Kr = nullptr; a.ldkr = 0; a.V = PR + PR_NAV + h * 128; a.ldv = PRW;
                    a.O = YC + (size_t)row0 * DM + 1536 + h * 128; a.ldo = DM; a.nt = 4; a.n1 = 4; a.base1 = row0; a.base2 = row0; a.scale = NA_SCALE; a.g = 0; a.rlo = 0; a.bias = nullptr;
                    att::unit<128, false>(a, al); }
            }
#if PROBE_MULT && PROBE_SUB
            xcd_barrier(xb); STAMP();
#endif
            if (PH(13)) {
                const float* cw = INP(I_HCW) + (size_t)l * 3 * 1536; const float* cb = INP(I_HCB) + (size_t)l * 1536; const float* hbias = INP(I_HBIAS) + (size_t)l * HYW;
                { const int c0h = vcu < 128 ? vcu : 128 + 3 * (vcu - 128), nch = vcu < 128 ? 1 : 3;
                  for (int k4 = 0; k4 < nch; ++k4) { const int c = c0h + k4; hyena_unit<SEQ, 1>(c, 0, PT, FILT + ((size_t)l * HYW + c) * 2 * FLEN, 0, (bf16_t*)(ws + A_YH), cw, cb, hbias, lds); } }
                if (l == 0) for (int u = (vcu + 64) % G; u < HYW / 8; u += G) hyena_unit<CTXL, 8>(8 * u, NLAT, PT, FILTC + (size_t)(8 * u) * 2 * FLENC, 2 * FLENC, (bf16_t*)(ws + A_YH), cw, cb, hbias, lds);
            }
        }
        xcd_barrier(xb); STAMP();
        if (PH(13)) {
            DECL_PTRS(l)
            const bf16_t* YH = (const bf16_t*)(ws + A_YH); LAS unsigned short* tt = (LAS unsigned short*)(ldsl + wave * 16384);
            const int ntok = MR / 64;
            for (int it = gw; it < 8 * ntok; it += NGW) { const int cb8 = it / ntok, tb = it % ntok, ch0 = cb8 * 64, t0 = tb * 64;
#pragma unroll
                for (int j = 0; j < 8; ++j) { const int chl = 8 * j + (lane >> 3), tq = (lane & 7) * 8; const u32x4 w = *(const u32x4*)(YH + (size_t)(ch0 + chl) * TOK + t0 + tq);
                    LAS unsigned* d = (LAS unsigned*)(tt + chl * 66 + tq); d[0] = w.x; d[1] = w.y; d[2] = w.z; d[3] = w.w; }
                asm volatile("s_waitcnt lgkmcnt(0)" ::: "memory");
#pragma unroll
                for (int j = 0; j < 8; ++j) { const int tl = 8 * j + (lane >> 3), cq = (lane & 7) * 8; u32x4 o;
                    o.x = (unsigned)tt[(cq + 0) * 66 + tl] | ((unsigned)tt[(cq + 1) * 66 + tl] << 16); o.y = (unsigned)tt[(cq + 2) * 66 + tl] | ((unsigned)tt[(cq + 3) * 66 + tl] << 16);
                    o.z = (unsigned)tt[(cq + 4) * 66 + tl] | ((unsigned)tt[(cq + 5) * 66 + tl] << 16); o.w = (unsigned)tt[(cq + 6) * 66 + tl] | ((unsigned)tt[(cq + 7) * 66 + tl] << 16);
                    *(u32x4*)(YC + (size_t)(t0 + tl) * DM + ch0 + cq) = o; }
                asm volatile("s_waitcnt lgkmcnt(0)" ::: "memory");
            }
        }
        xcd_barrier(xb); STAMP();
        if (PH(5)) { DECL_PTRS(l) { pg8::Gemm g{YC, (const bf16_t*)(wl + W_OUT), NLAT, DM, DM, DM, DM}; pg8::StaticOrder S; S.init(NLAT, DM, G, bx);
              unsigned* ctl = (unsigned*)(ws + S_CTL); f32x4* xbs = (f32x4*)(ws + A_XB); const int set = l * 2 + 0;
              const pg8::RowExchange rx{xbs + (size_t)set * 65536, ctl + CW_XCH + set * 2048, ctl + CW_TMO, DBGP(set)};
              if (l == 0) { pg8::EpiNormRes<true, true> E{INP(I_X), XR, INP(I_GAPOST) + l * DM, mod + 2 * DM, INP(I_GFPRE) + l * DM, mod + 3 * DM, mod + 4 * DM, XR, Hb, nullptr, rx}; pg8::gemm_phase(ldsl, g, S, E); }
              else { pg8::EpiNormRes<false, true> E{nullptr, XR, INP(I_GAPOST) + l * DM, mod + 2 * DM, INP(I_GFPRE) + l * DM, mod + 3 * DM, mod + 4 * DM, XR, Hb, nullptr, rx}; pg8::gemm_phase(ldsl, g, S, E); } }
            if (l == 0) { pg8::Gemm g{YC, (const bf16_t*)(wl + W_OUT), TOK, DM, DM / 4, DM, DM}; pg8::CtxSplitOrder S{bx, DM / 4}; pg8::EpiPart E{(float*)(ws + A_YP), DM / 4}; pg8::gemm_phase(ldsl, g, S, E); } }
        xcd_barrier(xb); STAMP();
        if (l == 0) {
        if (PH(6)) {
            DECL_PTRS(l)
            const float* gpost = INP(I_GAPOST) + l * DM; const float* gfpre = INP(I_GFPRE) + l * DM;
            for (int row = NLAT + gw; row < TOK; row += NGW) {
                const float* xs = (row < NLAT) ? INP(I_X) + (size_t)row * DM : INP(I_CTX) + (size_t)(row - NLAT) * DM;
                const int bm = (row < NLAT) ? (row >> 11) : 4; const float* mrow = mod + (size_t)bm * ADA;
                f32x4 y[8]; float sy;
                if (row < NLAT) { sy = (lane < 32) ? SSQY[(size_t)row * 32 + lane] : 0.f;
#pragma unroll
                    for (int j = 0; j < 8; ++j) y[j] = ldbf4(YF + (size_t)row * DM + 4 * lane + 256 * j); }
                else { const float* yp = (const float*)(ws + A_YP) + (size_t)(row - NLAT) * DM + 4 * lane; sy = 0.f;
#pragma unroll
                    for (int j = 0; j < 8; ++j) { y[j] = (*(const f32x4*)(yp + 256 * j) + *(const f32x4*)(yp + (size_t)NCTX * DM + 256 * j)) + (*(const f32x4*)(yp + (size_t)2 * NCTX * DM + 256 * j) + *(const f32x4*)(yp + (size_t)3 * NCTX * DM + 256 * j)); sy += pg8::dot4(y[j]); } }
                sy = wave_sum(sy);
                const float rsy = 1.0f / sqrtf(sy * (1.0f / DM) + RMS_EPS);
                f32x4 v[8]; float ss = 0.f;
#pragma unroll
                for (int j = 0; j < 8; ++j) { const int k = 4 * lane + 256 * j; const f32x4 xv = (l == 0) ? *(const f32x4*)(xs + k) : ldbf4(XR + (size_t)row * DM + k), yv = y[j], gg = *(const f32x4*)(gpost + k), gt = *(const f32x4*)(mrow + 2 * DM + k);
                    v[j] = xv + gt * (yv * rsy * gg); ss += pg8::dot4(v[j]); stbf4(XR + (size_t)row * DM + k, v[j]); }
                const float rs = 1.0f / sqrtf(wave_sum(ss) * (1.0f / DM) + RMS_EPS);
#pragma unroll
                for (int j = 0; j < 8; ++j) { const int k = 4 * lane + 256 * j; const f32x4 gg = *(const f32x4*)(gfpre + k), sh = *(const f32x4*)(mrow + 3 * DM + k), sc = *(const f32x4*)(mrow + 4 * DM + k);
                    const f32x4 hh = v[j] * rs * gg * (sc + 1.0f) + sh; u32x2 w; w.x = cvt_pk_bf16(hh[0], hh[1]); w.y = cvt_pk_bf16(hh[2], hh[3]); *(u32x2*)(Hb + (size_t)row * DM + k) = w; }
            }
        }
        xcd_barrier(xb); STAMP();
        }
        if (PH(7)) { DECL_PTRS(l) pg8::Gemm g{Hb, (const bf16_t*)(wl + W_GU), MR, 2 * FF, DM, DM, DM}; pg8::StaticOrder S; S.init(MR, 2 * FF, G, bx); pg8::EpiSwiGLU E{ACT}; pg8::gemm_phase(ldsl, g, S, E); }
        xcd_barrier(xb); STAMP();
        if (PH(8)) { DECL_PTRS(l) { pg8::Gemm g{ACT, (const bf16_t*)(wl + W_DN), NLAT, DM, FF, FF, FF}; pg8::StaticOrder S; S.init(NLAT, DM, G, bx);
              unsigned* ctl = (unsigned*)(ws + S_CTL); f32x4* xbs = (f32x4*)(ws + A_XB); const int set = l * 2 + 1; const float* modn = MOD + (size_t)5 * ADA;
              const pg8::RowExchange rx{xbs + (size_t)set * 65536, ctl + CW_XCH + set * 2048, ctl + CW_TMO, DBGP(set)};
              if (l == 0) { pg8::EpiNormRes<false, true> E{nullptr, XR, INP(I_GFPOST) + l * DM, mod + 5 * DM, INP(I_GAPRE) + DM, modn, modn + DM, XR, Hb, nullptr, rx}; pg8::gemm_phase(ldsl, g, S, E); }
              else { pg8::EpiNormRes<false, false> E{nullptr, XR, INP(I_GFPOST) + l * DM, mod + 5 * DM, nullptr, modn, modn, XR, Hb, (float*)INP(29), rx}; pg8::gemm_phase(ldsl, g, S, E); } }
            if (l == 0) { pg8::Gemm g{ACT, (const bf16_t*)(wl + W_DN), TOK, DM, FF / 4, FF, FF}; pg8::CtxSplitOrder S{bx, FF / 4}; pg8::EpiPart E{(float*)(ws + A_YP), FF / 4}; pg8::gemm_phase(ldsl, g, S, E); } }
        xcd_barrier(xb); STAMP();
        if (l == 0 && PH(9)) {
            DECL_PTRS(l)
            const float* gpost = INP(I_GFPOST) + l * DM; const float* gnext = INP(I_GAPRE) + DM; const float* modn = MOD + (size_t)5 * ADA;
            for (int row = NLAT + gw; row < TOK; row += NGW) {
                const int bm = (row < NLAT) ? (row >> 11) : 4; const float* mrow = mod + (size_t)bm * ADA; const float* mnext = modn + (size_t)bm * ADA;
                f32x4 y[8]; float sy;
                if (row < NLAT) { sy = (lane < 32) ? SSQY[(size_t)row * 32 + lane] : 0.f;
#pragma unroll
                    for (int j = 0; j < 8; ++j) y[j] = ldbf4(YF + (size_t)row * DM + 4 * lane + 256 * j); }
                else { const float* yp = (const float*)(ws + A_YP) + (size_t)(row - NLAT) * DM + 4 * lane; sy = 0.f;
#pragma unroll
                    for (int j = 0; j < 8; ++j) { y[j] = (*(const f32x4*)(yp + 256 * j) + *(const f32x4*)(yp + (size_t)NCTX * DM + 256 * j)) + (*(const f32x4*)(yp + (size_t)2 * NCTX * DM + 256 * j) + *(const f32x4*)(yp + (size_t)3 * NCTX * DM + 256 * j)); sy += pg8::dot4(y[j]); } }
                sy = wave_sum(sy);
                const float rsy = 1.0f / sqrtf(sy * (1.0f / DM) + RMS_EPS);
                f32x4 v[8]; float ss = 0.f;
#pragma unroll
                for (int j = 0; j < 8; ++j) { const int k = 4 * lane + 256 * j; const f32x4 xv = ldbf4(XR + (size_t)row * DM + k), yv = y[j], gg = *(const f32x4*)(gpost + k), gt = *(const f32x4*)(mrow + 5 * DM + k);
                    v[j] = xv + gt * (yv * rsy * gg); ss += pg8::dot4(v[j]); if (l == 0) stbf4(XR + (size_t)row * DM + k, v[j]); else *(f32x4*)((float*)INP(29) + (size_t)row * DM + k) = v[j]; }
                if (l == 0) {
                    const float rs = 1.0f / sqrtf(wave_sum(ss) * (1.0f / DM) + RMS_EPS);
#pragma unroll
                    for (int j = 0; j < 8; ++j) { const int k = 4 * lane + 256 * j; const f32x4 gg = *(const f32x4*)(gnext + k), sh = *(const f32x4*)(mnext + k), sc = *(const f32x4*)(mnext + DM + k);
                        const f32x4 hh = v[j] * rs * gg * (sc + 1.0f) + sh; u32x2 w; w.x = cvt_pk_bf16(hh[0], hh[1]); w.y = cvt_pk_bf16(hh[2], hh[3]); *(u32x2*)(Hb + (size_t)row * DM + k) = w; }
                }
            }
        }
        if (l == 0) { xcd_barrier(xb); STAMP(); }
    }
#if PROBE_MULT
    STAMP();
    if (bx0 == 0 && threadIdx.x == 0) { const unsigned long long q1 = (stamps[PROBE_B1] - stamps[PROBE_B0] + PROBE_UNIT / 2) / PROBE_UNIT, q2 = (stamps[PROBE_C1] - stamps[PROBE_C0] + PROBE_UNIT / 2) / PROBE_UNIT; const unsigned long long d = (q1 > 99 ? 99 : q1) * 400000ull + (q2 > 99 ? 99 : q2) * 4000ull, t0 = __builtin_amdgcn_s_memrealtime(); while (__builtin_amdgcn_s_memrealtime() - t0 < d) __builtin_amdgcn_s_sleep(8); }
#endif
}

extern "C" void kernel_launch(void* const* d_in, const int* in_sizes, int n_in, void* d_out, int out_size, void* d_ws, size_t ws_size, hipStream_t stream) {
    static int grid = 0;
    if (grid == 0) {
        if (n_in != 29 || out_size != NLAT * DM || ws_size < WS_NEED) { fprintf(stderr, "kernel_launch: unexpected shapes: n_in %d out %d ws %zu\n", n_in, out_size, ws_size); grid = -1; return; }
        int dev = 0, cus = 0, per_cu = 0;
        (void)hipGetDevice(&dev); (void)hipDeviceGetAttribute(&cus, hipDeviceAttributeMultiprocessorCount, dev);
        (void)hipFuncSetAttribute((const void*)fwd_mega, hipFuncAttributeMaxDynamicSharedMemorySize, LDS_BYTES);
        (void)hipOccupancyMaxActiveBlocksPerMultiprocessor(&per_cu, (const void*)fwd_mega, 512, LDS_BYTES);
        if (per_cu < 1) { fprintf(stderr, "kernel_launch: occupancy query reports %d blocks per CU\n", per_cu); }
        grid = cus;
    }
    if (grid < 0) return;
    Params p{};
    for (int i = 0; i < 29; ++i) p.in[i] = (const float*)d_in[i];
    p.out = (float*)d_out; p.ws = (unsigned char*)d_ws;
    void* args[] = {&p};
    hipError_t e = hipLaunchCooperativeKernel((const void*)fwd_mega, dim3(grid), dim3(512), args, LDS_BYTES, stream);
    if (e != hipSuccess) fprintf(stderr, "cooperative launch failed: %s (grid %d)\n", hipGetErrorString(e), grid);
}
```

```cpp
#include <hip/hip_runtime.h>
#include <hip/hip_cooperative_groups.h>
#include <cstdio>
#include <cstdint>
namespace cg = cooperative_groups;

#define LAS __attribute__((address_space(3)))
typedef unsigned short bf16_t;
typedef short bf16x8 __attribute__((ext_vector_type(8)));
typedef short s16x4 __attribute__((ext_vector_type(4)));
typedef float f32x4 __attribute__((ext_vector_type(4)));
typedef float f32x2 __attribute__((ext_vector_type(2)));
typedef float f32x16 __attribute__((ext_vector_type(16)));
typedef unsigned u32x4 __attribute__((ext_vector_type(4)));
typedef unsigned u32x2 __attribute__((ext_vector_type(2)));

constexpr int DM = 2048, NBATCH = 4, SEQ = 2048, CTXL = 256, NLAT = NBATCH * SEQ, NCTX = NBATCH * CTXL, TOK = NLAT + NCTX;
constexpr int INC = 4416, HYW = 512, QLORA = 768, KVLORA = 512, FF = 5632, ADA = 6 * DM;
constexpr int PRW = 3072;
constexpr int PR_KR = 1280, PR_NAQ = 1344, PR_NAK = 1856, PR_NAV = 2368;
constexpr float RMS_EPS = 1e-6f;
constexpr float MLA_SCALE = 0.07216878364870322f;
constexpr float NA_SCALE = 0.08838834764831845f;

constexpr size_t MiB = 1u << 20;
constexpr size_t WL_STRIDE = 98 * MiB;
constexpr size_t W_INR = 0, W_INH = 12 * MiB, W_UQ = 18 * MiB, W_UKV = 21 * MiB, W_OUT = 23 * MiB, W_GU = 31 * MiB, W_DN = 75 * MiB;
constexpr size_t A_H = 196 * MiB, A_YC = 232 * MiB, A_YF = 268 * MiB, A_XR = 340 * MiB, A_PR = 412 * MiB, A_PT = 466 * MiB, A_Q = 493 * MiB, A_KV = 520 * MiB, A_ACT = 412 * MiB;
constexpr size_t S_MOD = 556 * MiB, S_ROPE = 557 * MiB, S_SSQ = 558 * MiB, S_SSQY = 559 * MiB, S_FILT = 561 * MiB, S_FILTC = 578 * MiB, S_CTL = 580 * MiB, S_H2T = 581 * MiB, A_YH = 583 * MiB, A_YP = 593 * MiB, A_XB = 626 * MiB, WS_NEED = 631 * MiB;
constexpr int FLEN = 2 * SEQ + 64, FLENC = 2 * CTXL + 64;

constexpr int LDS_BYTES = 147456;
#ifndef PHMASK
#define PHMASK 0xFFFFFFFFu
#endif
#define PH(n) ((PHMASK >> (n)) & 1u)
#ifndef PROBE_MULT
#define PROBE_MULT 0
#define PROBE_B0 0
#define PROBE_B1 1
#define PROBE_C0 0
#define PROBE_C1 1
#endif
#ifndef PROBE_UNIT
#define PROBE_UNIT 400
#endif
#ifndef PROBE_SUB
#define PROBE_SUB 0
#endif

__device__ __forceinline__ unsigned cvt_pk_bf16(float lo, float hi) { unsigned r; asm volatile("v_cvt_pk_bf16_f32 %0, %1, %2" : "=v"(r) : "v"(lo), "v"(hi)); return r; }
__device__ __forceinline__ bf16_t f2bf(float f) { return (bf16_t)(cvt_pk_bf16(f, 0.f) & 0xffffu); }
__device__ __forceinline__ float bf2f(bf16_t h) { return __uint_as_float(((unsigned)h) << 16); }
__device__ __forceinline__ f32x4 ldbf4(const bf16_t* p) { const u32x2 w = *(const u32x2*)p; return (f32x4){__uint_as_float(w.x << 16), __uint_as_float(w.x & 0xffff0000u), __uint_as_float(w.y << 16), __uint_as_float(w.y & 0xffff0000u)}; }
__device__ __forceinline__ void stbf4(bf16_t* p, f32x4 v) { u32x2 w; w.x = cvt_pk_bf16(v[0], v[1]); w.y = cvt_pk_bf16(v[2], v[3]); *(u32x2*)p = w; }
__device__ __forceinline__ float wave_sum(float v) {
#pragma unroll
    for (int o = 1; o < 64; o <<= 1) v += __shfl_xor(v, o);
    return v;
}

constexpr int CW_TMO = 4096, CW_XCH = 8192, CW_END = CW_XCH + 8 * 32 * 64;
#define RLX_AGENT __ATOMIC_RELAXED, __HIP_MEMORY_SCOPE_AGENT
__device__ __forceinline__ void st16f_wt(void* p, f32x4 v) { asm volatile("global_store_dwordx4 %0, %1, off sc1\n\ts_nop 1" :: "v"(p), "v"(v) : "memory"); }
__device__ __forceinline__ f32x4 ld16_sc1(const void* p) { f32x4 v; asm volatile("global_load_dwordx4 %0, %1, off sc1\n\ts_waitcnt vmcnt(0)" : "=&v"(v) : "v"(p) : "memory"); return v; }

namespace pg8 {
constexpr int BM = 256, BK = 64, HALF = 128, HTB = HALF * BK * 2, STAGE_BYTES = 8 * HTB, NXCD = 8, WGM = 8;
__host__ __device__ __forceinline__ int lds_byte(int r, int c) { const int st = (r >> 4) * 2 + (c >> 5), rr = r & 15, cc = c & 31, ob = rr * 64 + cc * 2; return st * 1024 + (ob ^ (((ob >> 9) & 1) << 5)); }
__host__ __device__ __forceinline__ void stage_rc(int b, int& R, int& C) { const int st = b / 1024, sb = b % 1024, swz = sb ^ (((sb >> 9) & 1) << 5); R = (st >> 1) * 16 + swz / 64; C = (st & 1) * 32 + (swz % 64) / 2; }
__host__ __device__ __forceinline__ int perm32(int rho) { const int n = rho >> 4, i = rho & 15; return 8 * (i >> 2) + 4 * n + (i & 3); }

struct Unit { int pm, pn, koff; };
struct Gemm { const bf16_t* A; const bf16_t* Bt; int M, N, K, lda, ldb; };

struct StaticOrder {
    int nM, nN, nwg, G, c;
    __host__ __device__ void init(int M, int N, int G_, int c_) { nM = M / BM; nN = N / BM; nwg = nM * nN; G = G_; c = c_; }
    __host__ __device__ bool next(int i, Unit& u) const {
        const long L = (long)i * G + c; if (L >= nwg) return false;
        int wgid = (int)L; { const int q = nwg / NXCD, r = nwg % NXCD, xcd = wgid % NXCD, off = wgid / NXCD; wgid = (xcd < r ? xcd * (q + 1) : r * (q + 1) + (xcd - r) * q) + off; }
        const int nig = WGM * nN, gid = wgid / nig, fm = gid * WGM, gsz = (nM - fm) < WGM ? (nM - fm) : WGM;
        u.pm = fm + ((wgid % nig) % gsz); u.pn = (wgid % nig) / gsz; u.koff = 0; return true;
    }
};

template <class Epi, class Sched>
__device__ __forceinline__ void gemm_phase(LAS unsigned char* lds, const Gemm g, const Sched& S, const Epi& E) {
    int tid = threadIdx.x; asm volatile("" : "+v"(tid));
    const int wid = __builtin_amdgcn_readfirstlane(tid >> 6), lane = tid & 63, wr = wid >> 2, wc = wid & 3, fr = lane & 15, fq = lane >> 4;
    const int K = g.K, nt = K / BK;
    unsigned voffA[2], voffB[2];
#pragma unroll
    for (int i = 0; i < 2; ++i) { int R, C; stage_rc(tid * 16 + i * 8192, R, C); const int Rb = Epi::PERM ? ((R & ~31) + perm32(R & 31)) : R;
        voffA[i] = (unsigned)(R * g.lda + C) * 2u; voffB[i] = (unsigned)(Rb * g.ldb + C) * 2u; }
    const size_t kstep = (size_t)(BK * 2);
    const size_t hstepA = (size_t)HALF * g.lda * 2, hstepB = (size_t)HALF * g.ldb * 2;
    const size_t tstepA = 2 * hstepA, tstepB = 2 * hstepB;
    const unsigned ldsw = (unsigned)wid * 1024u;
    const int aoff = lds_byte(wr * 64 + fr, fq * 8), boff = lds_byte(wc * 32 + fr, fq * 8);
#define PG8_SA(b, h) (((b) * 2 + (h)) * HTB)
#define PG8_SB(b, h) ((4 + (b) * 2 + (h)) * HTB)
#define PG8_STAGE(bufoff, gbase, voff) do { _Pragma("unroll") for (int _i = 0; _i < 2; ++_i) \
        __builtin_amdgcn_global_load_lds((const unsigned*)((const char*)(gbase) + (voff)[_i]), (LAS unsigned*)(lds + (bufoff) + ldsw + _i * 8192), 16, 0, 0); } while (0)
#define PG8_LDA(dst, b, h) do { _Pragma("unroll") for (int m = 0; m < 4; ++m) _Pragma("unroll") for (int k = 0; k < 2; ++k) dst[m][k] = *(const LAS bf16x8*)(lds + PG8_SA(b, h) + aoff + m * 2048 + k * 1024); } while (0)
#define PG8_LDB(dst, b, h) do { _Pragma("unroll") for (int n = 0; n < 2; ++n) _Pragma("unroll") for (int k = 0; k < 2; ++k) dst[n][k] = *(const LAS bf16x8*)(lds + PG8_SB(b, h) + boff + n * 2048 + k * 1024); } while (0)
#define PG8_MMA(ai, bj, At, Bt) do { __builtin_amdgcn_s_setprio(1); _Pragma("unroll") for (int m = 0; m < 4; ++m) _Pragma("unroll") for (int n = 0; n < 2; ++n) _Pragma("unroll") for (int k = 0; k < 2; ++k) \
        acc[ai][bj][m][n] = __builtin_amdgcn_mfma_f32_16x16x32_bf16(Bt[n][k], At[m][k], acc[ai][bj][m][n], 0, 0, 0); __builtin_amdgcn_s_setprio(0); } while (0)
#define PG8_WAIT_V(n) asm volatile("s_waitcnt vmcnt(" #n ")" ::: "memory")
#define PG8_WAIT_L(n) asm volatile("s_waitcnt lgkmcnt(" #n ")" ::: "memory")
#define PG8_BAR __builtin_amdgcn_s_barrier()
#define PG8_SCHED __builtin_amdgcn_sched_barrier(0)
    Unit cur, nxt; int ui = 0;
    if (!S.next(0, cur)) return;
    f32x4 acc[2][2][4][2];
#pragma unroll
    for (int a = 0; a < 2; ++a)
#pragma unroll
        for (int b = 0; b < 2; ++b)
#pragma unroll
            for (int m = 0; m < 4; ++m)
#pragma unroll
                for (int n = 0; n < 2; ++n) acc[a][b][m][n] = (f32x4){0.f, 0.f, 0.f, 0.f};
    bf16x8 At[4][2], B0[2][2], B1[2][2];
    const char* cA = (const char*)g.A + (size_t)cur.pm * tstepA + (size_t)cur.koff * 2; const char* cB = (const char*)g.Bt + (size_t)cur.pn * tstepB + (size_t)cur.koff * 2;
    PG8_STAGE(PG8_SB(0, 0), cB, voffB); PG8_STAGE(PG8_SB(0, 1), cB + hstepB, voffB); PG8_STAGE(PG8_SA(0, 0), cA, voffA); PG8_STAGE(PG8_SA(0, 1), cA + hstepA, voffA);
    if (wr == 1) PG8_BAR;
    PG8_WAIT_V(2); PG8_BAR;
    PG8_STAGE(PG8_SB(1, 0), cB + kstep, voffB); PG8_STAGE(PG8_SA(1, 0), cA + kstep, voffA); PG8_STAGE(PG8_SB(1, 1), cB + hstepB + kstep, voffB);
    PG8_WAIT_V(6); PG8_BAR;
    for (;;) {
        const bool has_next = S.next(ui + 1, nxt);
        const char* nA = has_next ? (const char*)g.A + (size_t)nxt.pm * tstepA + (size_t)nxt.koff * 2 : cA; const char* nB = has_next ? (const char*)g.Bt + (size_t)nxt.pn * tstepB + (size_t)nxt.koff * 2 : cB;
        for (int t = 0; t < nt; t += 2) {
            const bool last = (t == nt - 2);
            const char* a1 = cA + (size_t)(t + 1) * kstep;
            const char* a2 = last ? nA : cA + (size_t)(t + 2) * kstep; const char* b2 = last ? nB : cB + (size_t)(t + 2) * kstep;
            const char* a3 = a2 + kstep; const char* b3 = b2 + kstep;
            PG8_LDB(B0, 0, 0); PG8_LDB(B1, 0, 1); PG8_SCHED; PG8_LDA(At, 0, 0); PG8_STAGE(PG8_SA(1, 1), a1 + hstepA, voffA);
            PG8_WAIT_V(8); PG8_WAIT_L(0); PG8_BAR; PG8_MMA(0, 0, At, B0); PG8_MMA(0, 1, At, B1); PG8_BAR; PG8_SCHED;
            PG8_LDA(At, 0, 1); PG8_STAGE(PG8_SB(0, 0), b2, voffB); PG8_STAGE(PG8_SB(0, 1), b2 + hstepB, voffB); PG8_STAGE(PG8_SA(0, 0), a2, voffA);
            PG8_WAIT_V(8); PG8_WAIT_L(0); PG8_BAR; PG8_MMA(1, 0, At, B0); PG8_MMA(1, 1, At, B1); PG8_BAR; PG8_SCHED;
            PG8_LDB(B0, 1, 0); PG8_LDB(B1, 1, 1); PG8_SCHED; PG8_LDA(At, 1, 0); PG8_STAGE(PG8_SA(0, 1), a2 + hstepA, voffA);
            PG8_WAIT_V(8); PG8_WAIT_L(0); PG8_BAR; PG8_MMA(0, 0, At, B0); PG8_MMA(0, 1, At, B1); PG8_BAR; PG8_SCHED;
            PG8_LDA(At, 1, 1); PG8_STAGE(PG8_SB(1, 0), b3, voffB); PG8_STAGE(PG8_SB(1, 1), b3 + hstepB, voffB); PG8_STAGE(PG8_SA(1, 0), a3, voffA);
            PG8_WAIT_V(8); PG8_WAIT_L(0); PG8_BAR; PG8_MMA(1, 0, At, B0); PG8_MMA(1, 1, At, B1); PG8_BAR; PG8_SCHED;
        }
        if (wr == 0) PG8_BAR;
        if constexpr (!Epi::AFTER_DRAIN) E(acc, cur, wr, wc, fr, fq);
        if (!has_next) break;
#pragma unroll
        for (int a = 0; a < 2; ++a)
#pragma unroll
            for (int b = 0; b < 2; ++b)
#pragma unroll
                for (int m = 0; m < 4; ++m)
#pragma unroll
                    for (int n = 0; n < 2; ++n) acc[a][b][m][n] = (f32x4){0.f, 0.f, 0.f, 0.f};
        cur = nxt; cA = nA; cB = nB; ++ui;
        if (wr == 1) PG8_BAR;
    }
    PG8_WAIT_V(0);
    PG8_BAR;
    if constexpr (Epi::AFTER_DRAIN) E.fused(acc, cur, wr, wc, fr, fq, lds, wid, lane);
#undef PG8_SA
#undef PG8_SB
#undef PG8_STAGE
#undef PG8_LDA
#undef PG8_LDB
#undef PG8_MMA
#undef PG8_WAIT_V
#undef PG8_WAIT_L
#undef PG8_BAR
#undef PG8_SCHED
}

__device__ __forceinline__ float dot4(f32x4 v) { return (v[0] * v[0] + v[1] * v[1]) + (v[2] * v[2] + v[3] * v[3]); }
__device__ __forceinline__ void rope4(f32x4& v, const float* rope_row, int i0) {
    const f32x4 cs = *(const f32x4*)(rope_row + 2 * i0);
    const float a0 = v[0] * cs[0] - v[1] * cs[1], b0 = v[1] * cs[0] + v[0] * cs[1];
    const float a1 = v[2] * cs[2] - v[3] * cs[3], b1 = v[3] * cs[2] + v[2] * cs[3];
    v = (f32x4){a0, b0, a1, b1};
}
__device__ __forceinline__ u32x4 pack8(f32x4 v0, f32x4 v1) { u32x4 w; w.x = cvt_pk_bf16(v0[0], v0[1]); w.y = cvt_pk_bf16(v0[2], v0[3]); w.z = cvt_pk_bf16(v1[0], v1[1]); w.w = cvt_pk_bf16(v1[2], v1[3]); return w; }

struct EpiBf16 {
    static constexpr bool PERM = true, AFTER_DRAIN = false;
    bf16_t* O; int ldc;
    __device__ __forceinline__ void operator()(const f32x4 (&acc)[2][2][4][2], const Unit& u, int wr, int wc, int fr, int fq) const {
        const int row0 = u.pm * BM + wr * 64 + fr, col0 = u.pn * BM + wc * 32 + 8 * fq;
#pragma unroll
        for (int ai = 0; ai < 2; ++ai)
#pragma unroll
            for (int m = 0; m < 4; ++m) { bf16_t* rowp = O + (size_t)(row0 + ai * HALF + m * 16) * ldc + col0;
#pragma unroll
                for (int bj = 0; bj < 2; ++bj) *(u32x4*)(rowp + bj * HALF) = pack8(acc[ai][bj][m][0], acc[ai][bj][m][1]); }
    }
};
struct EpiPR {
    static constexpr bool PERM = true, AFTER_DRAIN = false;
    bf16_t* O; float* ssq; const float* rope;
    __device__ __forceinline__ void operator()(const f32x4 (&acc)[2][2][4][2], const Unit& u, int wr, int wc, int fr, int fq) const {
        const int row0 = u.pm * BM + wr * 64 + fr, col0 = u.pn * BM + wc * 32 + 8 * fq;
        const bool dorope = (u.pn == 5) && (wc < 2);
#pragma unroll
        for (int ai = 0; ai < 2; ++ai)
#pragma unroll
            for (int m = 0; m < 4; ++m) { const int row = row0 + ai * HALF + m * 16; bf16_t* rowp = O + (size_t)row * PRW + col0; float ss = 0.f;
#pragma unroll
                for (int bj = 0; bj < 2; ++bj) { f32x4 v0 = acc[ai][bj][m][0], v1 = acc[ai][bj][m][1];
                    if (bj == 0 && dorope && row < NLAT) { const float* rr = rope + (size_t)(row & (SEQ - 1)) * 64; const int i0 = 16 * wc + 4 * fq; rope4(v0, rr, i0); rope4(v1, rr, i0 + 2); }
                    ss += dot4(v0) + dot4(v1);
                    *(u32x4*)(rowp + bj * HALF) = pack8(v0, v1); }
                if (u.pn < 5) { ss += __shfl_xor(ss, 16); ss += __shfl_xor(ss, 32); if (fq == 0) ssq[(size_t)row * 20 + u.pn * 4 + wc] = ss; }
                asm volatile("" ::: "memory"); }
    }
};
struct EpiQ {
    static constexpr bool PERM = true, AFTER_DRAIN = false;
    bf16_t* O; const float* ssq; const float* rope;
    __device__ __forceinline__ void operator()(const f32x4 (&acc)[2][2][4][2], const Unit& u, int wr, int wc, int fr, int fq) const {
        const int row0 = u.pm * BM + wr * 64 + fr, col0 = u.pn * BM + wc * 32 + 8 * fq;
#pragma unroll
        for (int ai = 0; ai < 2; ++ai)
#pragma unroll
            for (int m = 0; m < 4; ++m) { const int row = row0 + ai * HALF + m * 16; bf16_t* rowp = O + (size_t)row * 1536 + col0;
                const f32x4* sp = (const f32x4*)(ssq + (size_t)row * 20); const f32x4 s0 = sp[0], s1 = sp[1], s2 = sp[2];
                const float tot = ((s0[0] + s0[1]) + (s0[2] + s0[3])) + ((s1[0] + s1[1]) + (s1[2] + s1[3])) + ((s2[0] + s2[1]) + (s2[2] + s2[3]));
                const float rs = 1.0f / sqrtf(tot * (1.0f / QLORA) + RMS_EPS);
#pragma unroll
                for (int bj = 0; bj < 2; ++bj) { f32x4 v0 = acc[ai][bj][m][0] * rs, v1 = acc[ai][bj][m][1] * rs;
                    const int j0 = (col0 + bj * HALF) % 192;
                    if (j0 >= 128 && row < NLAT) { const float* rr = rope + (size_t)(row & (SEQ - 1)) * 64; const int i0 = (j0 - 128) >> 1; rope4(v0, rr, i0); rope4(v1, rr, i0 + 2); }
                    *(u32x4*)(rowp + bj * HALF) = pack8(v0, v1); }
                asm volatile("" ::: "memory"); }
    }
};
struct EpiKV {
    static constexpr bool PERM = true, AFTER_DRAIN = false;
    bf16_t* O; const float* ssq;
    __device__ __forceinline__ void operator()(const f32x4 (&acc)[2][2][4][2], const Unit& u, int wr, int wc, int fr, int fq) const {
        const int row0 = u.pm * BM + wr * 64 + fr, col0 = u.pn * BM + wc * 32 + 8 * fq;
#pragma unroll
        for (int ai = 0; ai < 2; ++ai)
#pragma unroll
            for (int m = 0; m < 4; ++m) { const int row = row0 + ai * HALF + m * 16; bf16_t* rowp = O + (size_t)row * 2048 + col0;
                const f32x4* sp = (const f32x4*)(ssq + (size_t)row * 20 + 12); const f32x4 s0 = sp[0], s1 = sp[1];
                const float tot = ((s0[0] + s0[1]) + (s0[2] + s0[3])) + ((s1[0] + s1[1]) + (s1[2] + s1[3]));
                const float rs = 1.0f / sqrtf(tot * (1.0f / KVLORA) + RMS_EPS);
#pragma unroll
                for (int bj = 0; bj < 2; ++bj) *(u32x4*)(rowp + bj * HALF) = pack8(acc[ai][bj][m][0] * rs, acc[ai][bj][m][1] * rs);
                asm volatile("" ::: "memory"); }
    }
};
struct EpiF32S {
    static constexpr bool PERM = true, AFTER_DRAIN = false;
    bf16_t* C; float* ssq;
    __device__ __forceinline__ void operator()(const f32x4 (&acc)[2][2][4][2], const Unit& u, int wr, int wc, int fr, int fq) const {
        const int row0 = u.pm * BM + wr * 64 + fr, col0 = u.pn * BM + wc * 32 + 8 * fq;
#pragma unroll
        for (int ai = 0; ai < 2; ++ai)
#pragma unroll
            for (int m = 0; m < 4; ++m) { const int row = row0 + ai * HALF + m * 16; bf16_t* rowp = C + (size_t)row * DM + col0; float ss = 0.f;
#pragma unroll
                for (int bj = 0; bj < 2; ++bj) { const f32x4 v0 = acc[ai][bj][m][0], v1 = acc[ai][bj][m][1]; ss += dot4(v0) + dot4(v1); *(u32x4*)(rowp + bj * HALF) = pack8(v0, v1); }
                ss += __shfl_xor(ss, 16); ss += __shfl_xor(ss, 32); if (fq == 0) ssq[(size_t)row * 32 + u.pn * 4 + wc] = ss; }
    }
};
struct EpiSwiGLU {
    static constexpr bool PERM = true, AFTER_DRAIN = false;
    bf16_t* O;
    __device__ __forceinline__ void operator()(const f32x4 (&acc)[2][2][4][2], const Unit& u, int wr, int wc, int fr, int fq) const {
        const int row0 = u.pm * BM + wr * 64 + fr, col0 = u.pn * HALF + wc * 32 + 8 * fq;
#pragma unroll
        for (int ai = 0; ai < 2; ++ai)
#pragma unroll
            for (int m = 0; m < 4; ++m) { bf16_t* rowp = O + (size_t)(row0 + ai * HALF + m * 16) * FF + col0; f32x4 r[2];
#pragma unroll
                for (int n = 0; n < 2; ++n) { const f32x4 gt = acc[ai][0][m][n], up = acc[ai][1][m][n];
#pragma unroll
                    for (int e = 0; e < 4; ++e) { const float sg = __builtin_amdgcn_rcpf(1.0f + __builtin_amdgcn_exp2f(-1.4426950408889634f * gt[e])); r[n][e] = gt[e] * sg * up[e]; } }
                *(u32x4*)rowp = pack8(r[0], r[1]); }
    }
};
struct RowExchange { f32x4* slots; unsigned* cnt; unsigned* tmo; unsigned long long* dbg; };
template <bool XF32, bool SECOND>
struct EpiNormRes {
    static constexpr bool PERM = true, AFTER_DRAIN = true;
    const float* xf; const bf16_t* xb;
    const float* gpost; const float* gate;
    const float* g2; const float* shift2; const float* scale2;
    bf16_t* XRo; bf16_t* Ho; float* outf;
    RowExchange x1;
    __device__ __forceinline__ f32x4 ldx(unsigned o) const { if constexpr (XF32) return *(const f32x4*)(xf + o); else return ldbf4(xb + o); }
    __device__ __forceinline__ void fused(f32x4 (&acc)[2][2][4][2], const Unit& u, int wr, int wc, int fr, int fq, LAS unsigned char* lds, int wid, int lane) const {
        LAS f32x4* P = (LAS f32x4*)lds; LAS f32x2* S = (LAS f32x2*)(lds + 16384);
#define DBGS(i) do { if (x1.dbg && blockIdx.x == 0 && threadIdx.x == 0) x1.dbg[i] = __builtin_amdgcn_s_memrealtime(); } while (0)
        DBGS(0);
        const int b = u.pm >> 3, col0 = u.pn * BM + wc * 32 + 8 * fq;
        const float* gt = gate + (size_t)b * ADA;
        f32x4 G[2][2];
#pragma unroll
        for (int bj = 0; bj < 2; ++bj)
#pragma unroll
            for (int n = 0; n < 2; ++n) { const int cc = col0 + bj * HALF + n * 4; G[bj][n] = *(const f32x4*)(gpost + cc) * *(const f32x4*)(gt + cc); }
        f32x4 xl[2][2][2][2];
#define NR_LOAD(SET, AM) do { _Pragma("unroll") for (int mm = 0; mm < 2; ++mm) { const unsigned off_ = (unsigned)(u.pm * BM + ((AM) >> 1) * HALF + wr * 64 + (((AM) & 1) * 2 + mm) * 16 + fr) * DM + col0; \
            _Pragma("unroll") for (int bj = 0; bj < 2; ++bj) _Pragma("unroll") for (int n = 0; n < 2; ++n) xl[SET][mm][bj][n] = ldx(off_ + bj * HALF + n * 4); } } while (0)
        NR_LOAD(0, 0);
#pragma unroll
        for (int am = 0; am < 4; ++am) { const int ai = am >> 1, m0 = (am & 1) * 2;
            if (am + 1 < 4) NR_LOAD((am + 1) & 1, am + 1);
#pragma unroll
            for (int mm = 0; mm < 2; ++mm) { const int m = m0 + mm; f32x4 s = {0.f, 0.f, 0.f, 0.f};
#pragma unroll
                for (int bj = 0; bj < 2; ++bj)
#pragma unroll
                    for (int n = 0; n < 2; ++n) { const f32x4 y = acc[ai][bj][m][n], x = xl[am & 1][mm][bj][n], gy = G[bj][n] * y; acc[ai][bj][m][n] = gy;
                        s[0] += dot4(y); s[1] += dot4(x); s[2] += (x[0] * gy[0] + x[1] * gy[1]) + (x[2] * gy[2] + x[3] * gy[3]); s[3] += dot4(gy); }
#pragma unroll
                for (int e = 0; e < 4; ++e) { s[e] += __shfl_xor(s[e], 16); s[e] += __shfl_xor(s[e], 32); }
                if (fq == 0) P[(ai * HALF + wr * 64 + m * 16 + fr) * 4 + wc] = s; } }
#undef NR_LOAD
        asm volatile("s_waitcnt lgkmcnt(0)" ::: "memory"); __builtin_amdgcn_s_barrier(); asm volatile("" ::: "memory");
        DBGS(1);
        const int row = wid * 64 + lane;
        if (row < 256) { const f32x4 tot = (P[row * 4 + 0] + P[row * 4 + 1]) + (P[row * 4 + 2] + P[row * 4 + 3]); st16f_wt(x1.slots + ((size_t)u.pm * 256 + row) * 8 + u.pn, tot); }
        asm volatile("s_waitcnt vmcnt(0)" ::: "memory");
        if (lane == 0) __hip_atomic_fetch_add(x1.cnt + 64 * u.pm, 1u, RLX_AGENT);
        if (wid == 0) { unsigned polls = 0;
            while ((unsigned)__builtin_amdgcn_readfirstlane(__hip_atomic_load(x1.cnt + 64 * u.pm, RLX_AGENT)) < 64u) {
                if ((++polls & 255u) == 0u) { if (__builtin_amdgcn_readfirstlane(__hip_atomic_load(x1.tmo, RLX_AGENT)) != 0u) break; if (polls > (1u << 21)) { if (lane == 0) __hip_atomic_store(x1.tmo, 1u, RLX_AGENT); break; } }
                __builtin_amdgcn_s_sleep(1); } }
        asm volatile("s_waitcnt vmcnt(0) lgkmcnt(0)" ::: "memory"); __builtin_amdgcn_s_barrier(); asm volatile("" ::: "memory");
        DBGS(2);
        if (row < 256) { const f32x4* sl = x1.slots + ((size_t)u.pm * 256 + row) * 8; f32x4 t0, t1, t2, t3;
            asm volatile("global_load_dwordx4 %0, %4, off sc1\n\tglobal_load_dwordx4 %1, %4, off offset:16 sc1\n\tglobal_load_dwordx4 %2, %4, off offset:32 sc1\n\tglobal_load_dwordx4 %3, %4, off offset:48 sc1\n\ts_waitcnt vmcnt(0)"
                         : "=&v"(t0), "=&v"(t1), "=&v"(t2), "=&v"(t3) : "v"(sl) : "memory");
            f32x4 t = (t0 + t1) + (t2 + t3);
            asm volatile("global_load_dwordx4 %0, %4, off offset:64 sc1\n\tglobal_load_dwordx4 %1, %4, off offset:80 sc1\n\tglobal_load_dwordx4 %2, %4, off offset:96 sc1\n\tglobal_load_dwordx4 %3, %4, off offset:112 sc1\n\ts_waitcnt vmcnt(0)"
                         : "=&v"(t0), "=&v"(t1), "=&v"(t2), "=&v"(t3) : "v"(sl) : "memory");
            t = t + ((t0 + t1) + (t2 + t3));
            const float rsy = __builtin_amdgcn_rsqf(t[0] * (1.0f / DM) + RMS_EPS);
            const float sx2 = t[1] + (rsy + rsy) * t[2] + rsy * rsy * t[3];
            S[row] = (f32x2){rsy, __builtin_amdgcn_rsqf(fmaxf(sx2, 0.f) * (1.0f / DM) + RMS_EPS)}; }
        asm volatile("s_waitcnt lgkmcnt(0)" ::: "memory"); __builtin_amdgcn_s_barrier(); asm volatile("" ::: "memory");
        DBGS(3);
        int fr2 = fr, fq2 = fq; asm volatile("" : "+v"(fr2), "+v"(fq2)); const int col2 = u.pn * BM + wc * 32 + 8 * fq2;
        const float* sh = shift2 + (size_t)b * ADA; const float* sc = scale2 + (size_t)b * ADA;
        f32x4 gg[2][2], shv[2][2], scv[2][2];
        if constexpr (SECOND) {
#pragma unroll
            for (int bj = 0; bj < 2; ++bj)
#pragma unroll
                for (int n = 0; n < 2; ++n) { const int cc = col2 + bj * HALF + n * 4; gg[bj][n] = *(const f32x4*)(g2 + cc); shv[bj][n] = *(const f32x4*)(sh + cc); scv[bj][n] = *(const f32x4*)(sc + cc) + 1.0f; } }
#pragma unroll
        for (int am = 0; am < 4; ++am) { const int ai = am >> 1, m0 = (am & 1) * 2;
            f32x4 x2l[2][2][2];
#pragma unroll
            for (int mm = 0; mm < 2; ++mm) { const unsigned off = (unsigned)(u.pm * BM + ai * HALF + wr * 64 + (m0 + mm) * 16 + fr2) * DM + col2;
#pragma unroll
                for (int bj = 0; bj < 2; ++bj)
#pragma unroll
                    for (int n = 0; n < 2; ++n) x2l[mm][bj][n] = ldx(off + bj * HALF + n * 4); }
#pragma unroll
            for (int mm = 0; mm < 2; ++mm) { const int m = m0 + mm; const int r = ai * HALF + wr * 64 + m * 16 + fr2; const f32x2 st = S[r]; const unsigned off = (unsigned)(u.pm * BM + r) * DM + col2;
#pragma unroll
                for (int bj = 0; bj < 2; ++bj) { const unsigned o2 = off + bj * HALF;
                    const f32x4 xn0 = x2l[mm][bj][0] + acc[ai][bj][m][0] * st.x, xn1 = x2l[mm][bj][1] + acc[ai][bj][m][1] * st.x;
                    if constexpr (SECOND) { *(u32x4*)(XRo + o2) = pack8(xn0, xn1); *(u32x4*)(Ho + o2) = pack8(xn0 * st.y * gg[bj][0] * scv[bj][0] + shv[bj][0], xn1 * st.y * gg[bj][1] * scv[bj][1] + shv[bj][1]); }
                    else { *(f32x4*)(outf + o2) = xn0; *(f32x4*)(outf + o2 + 4) = xn1; } } }
            asm volatile("" ::: "memory"); }
        asm volatile("s_waitcnt lgkmcnt(0)" ::: "memory"); __builtin_amdgcn_s_barrier(); asm volatile("" ::: "memory");
        DBGS(4);
#undef DBGS
    }
};
struct CtxSplitOrder {
    int c, ksub;
    __device__ bool next(int i, Unit& u) const { if (i > 0 || c >= 128) return false; const int kp = c >> 5, r = c & 31; u.pm = 32 + (r >> 3); u.pn = r & 7; u.koff = kp * ksub; return true; }
};
struct EpiPart {
    static constexpr bool PERM = false, AFTER_DRAIN = false;
    float* P; int ksub;
    __device__ __forceinline__ void operator()(const f32x4 (&acc)[2][2][4][2], const Unit& u, int wr, int wc, int fr, int fq) const {
        const int row0 = u.pm * BM + wr * 64 + fr - NLAT, col0 = u.pn * BM + wc * 32 + 4 * fq; float* base = P + (size_t)(u.koff / ksub) * NCTX * DM;
#pragma unroll
        for (int ai = 0; ai < 2; ++ai)
#pragma unroll
            for (int m = 0; m < 4; ++m) { float* rowp = base + (size_t)(row0 + ai * HALF + m * 16) * DM + col0;
#pragma unroll
                for (int bj = 0; bj < 2; ++bj)
#pragma unroll
                    for (int n = 0; n < 2; ++n) *(f32x4*)(rowp + bj * HALF + n * 16) = acc[ai][bj][m][n]; }
    }
};
}

namespace att {
constexpr int NW = 8, QBLK = 32, KVBLK = 64;
#define SBAR() __builtin_amdgcn_sched_barrier(0)
__device__ __forceinline__ int crow(int r, int hi) { return (r & 3) + 8 * (r >> 2) + 4 * hi; }
__device__ __forceinline__ int v_st(int k, int c) { const int kk = (k & ~0xC) | ((k & 4) << 1) | ((k & 8) >> 1); return ((kk >> 3) * 4 + (c >> 5)) * 512 + ((kk & 7) * 32 + (c & 31)) * 2; }
__device__ __forceinline__ int v_rd_base(int lane) { return ((lane & 3) << 3) | (((lane >> 2) & 3) << 6) | (((lane >> 4) & 1) << 5) | (((lane >> 5) & 1) << 8); }
constexpr int v_rd_off(int d0, int ks, int half) { return d0 * 512 + ks * 4096 + half * 2048; }
template <int OFF> __device__ __forceinline__ s16x4 tr_read(int vb) { s16x4 r; asm volatile("ds_read_b64_tr_b16 %0, %1 offset:%2" : "=&v"(r) : "v"(vb), "i"(OFF) : "memory"); return r; }
template <int D0> __device__ __forceinline__ void pv_one(f32x16& od, int vb, bf16x8 pa0, bf16x8 pa1, bf16x8 pa2, bf16x8 pa3) {
    const s16x4 l0 = tr_read<v_rd_off(D0, 0, 0)>(vb), h0 = tr_read<v_rd_off(D0, 0, 1)>(vb), l1 = tr_read<v_rd_off(D0, 1, 0)>(vb), h1 = tr_read<v_rd_off(D0, 1, 1)>(vb);
    const s16x4 l2 = tr_read<v_rd_off(D0, 2, 0)>(vb), h2 = tr_read<v_rd_off(D0, 2, 1)>(vb), l3 = tr_read<v_rd_off(D0, 3, 0)>(vb), h3 = tr_read<v_rd_off(D0, 3, 1)>(vb);
    asm volatile("s_waitcnt lgkmcnt(0)" ::: "memory"); SBAR();
#define PKV(L, H) (bf16x8){L[0], L[1], L[2], L[3], H[0], H[1], H[2], H[3]}
    od = __builtin_amdgcn_mfma_f32_32x32x16_bf16(pa0, PKV(l0, h0), od, 0, 0, 0);
    od = __builtin_amdgcn_mfma_f32_32x32x16_bf16(pa1, PKV(l1, h1), od, 0, 0, 0);
    od = __builtin_amdgcn_mfma_f32_32x32x16_bf16(pa2, PKV(l2, h2), od, 0, 0, 0);
    od = __builtin_amdgcn_mfma_f32_32x32x16_bf16(pa3, PKV(l3, h3), od, 0, 0, 0);
#undef PKV
}
__device__ __forceinline__ void pv_d0(f32x16* o, int vb, bf16x8 pa0, bf16x8 pa1, bf16x8 pa2, bf16x8 pa3) {
    pv_one<0>(o[0], vb, pa0, pa1, pa2, pa3); pv_one<1>(o[1], vb, pa0, pa1, pa2, pa3); pv_one<2>(o[2], vb, pa0, pa1, pa2, pa3); pv_one<3>(o[3], vb, pa0, pa1, pa2, pa3);
}
__device__ __forceinline__ void partialSM(f32x16& p0, f32x16& p1, float& m_reg, float& alpha, float C, float thr) {
    float pmax = p0[0];
#pragma unroll
    for (int r = 1; r < 16; ++r) pmax = fmaxf(pmax, p0[r]);
#pragma unroll
    for (int r = 0; r < 16; ++r) pmax = fmaxf(pmax, p1[r]);
    { auto rr = __builtin_amdgcn_permlane32_swap(__float_as_uint(pmax), __float_as_uint(pmax), false, false); pmax = fmaxf(__uint_as_float(rr[0]), __uint_as_float(rr[1])); }
    float mn;
    if (__builtin_expect(__all(pmax - m_reg <= thr), 1)) { mn = m_reg; alpha = 1.f; }
    else { mn = fmaxf(m_reg, pmax); alpha = __builtin_amdgcn_exp2f((m_reg - mn) * C); m_reg = mn; }
    const float mnC = -mn * C;
#pragma unroll
    for (int r = 0; r < 16; ++r) p0[r] = fmaf(p0[r], C, mnC);
#pragma unroll
    for (int r = 0; r < 16; ++r) p1[r] = fmaf(p1[r], C, mnC);
#pragma unroll
    for (int r = 0; r < 16; ++r) p0[r] = __builtin_amdgcn_exp2f(p0[r]);
}
__device__ __forceinline__ void finishSM(f32x16& p0, f32x16& p1, float alpha, float& l_reg, bf16x8& pa0, bf16x8& pa1, bf16x8& pa2, bf16x8& pa3) {
#pragma unroll
    for (int r = 0; r < 16; ++r) p1[r] = __builtin_amdgcn_exp2f(p1[r]);
    float ps = 0;
#pragma unroll
    for (int r = 0; r < 16; ++r) ps += p0[r];
#pragma unroll
    for (int r = 0; r < 16; ++r) ps += p1[r];
    { auto rr = __builtin_amdgcn_permlane32_swap(__float_as_uint(ps), __float_as_uint(ps), false, false); ps = __uint_as_float(rr[0]) + __uint_as_float(rr[1]); }
    l_reg = l_reg * alpha + ps;
#define PK4(P, BASE, OUT) do { unsigned a0 = cvt_pk_bf16(P[BASE + 0], P[BASE + 1]), a1 = cvt_pk_bf16(P[BASE + 2], P[BASE + 3]);   \
    unsigned b0 = cvt_pk_bf16(P[BASE + 4], P[BASE + 5]), b1 = cvt_pk_bf16(P[BASE + 6], P[BASE + 7]);                              \
    auto r0 = __builtin_amdgcn_permlane32_swap(a0, b0, false, false); auto r1 = __builtin_amdgcn_permlane32_swap(a1, b1, false, false); \
    u32x4 w = {r0[0], r1[0], r0[1], r1[1]}; OUT = __builtin_bit_cast(bf16x8, w); } while (0)
    PK4(p0, 0, pa0); PK4(p0, 8, pa1); PK4(p1, 0, pa2); PK4(p1, 8, pa3);
#undef PK4
}

struct Args {
    const bf16_t* Q; int ldq;
    const bf16_t* Kn; int ldk;
    const bf16_t* Kr; int ldkr;
    const bf16_t* V; int ldv;
    bf16_t* O; int ldo;
    int nt, n1, base1, base2;
    float scale;
    int g, rlo; const float* bias;
};

template <int DQK, bool NA>
__device__ __forceinline__ void unit(const Args& a, char* lds) {
    constexpr int ND = DQK / 16, KROW = DQK * 2, SHM_V = KVBLK * 128 * 2, SHM_K = KVBLK * KROW;
#define KSWZ(row, colB) ((row) * KROW + ((colB) ^ (((row) & 7) << 4)))
    int tid = threadIdx.x; asm volatile("" : "+v"(tid));
    const int wid = tid >> 6, lane = tid & 63, r32 = lane & 31, hi = lane >> 5;
    char* V_lds = lds; char* K_lds = lds + 2 * SHM_V;
    float* ws = (float*)(lds + 2 * SHM_V + 2 * SHM_K) + wid * 64; float* li_l = ws; float* al_l = ws + 32;
    float* bt = (float*)(lds + 2 * SHM_V + 2 * SHM_K + NW * 256);
    const float C = a.scale * 1.4426950408889634f, thr = 8.0f / a.scale;
    __syncthreads();
    if (NA) { const float inv = 1.0f / a.scale; for (int i = tid; i < 15 * 128; i += 512) { const int c = (i & 127) - 48; bt[i] = (c >= 0 && c < 31) ? a.bias[(i >> 7) * 31 + c] * inv : 0.f; } }
    float m_reg = -1e30f, l_reg = 0; f32x16 o[4] = {}; bf16x8 qr[ND];
    { const bf16_t* Qw = a.Q + (size_t)(wid * QBLK + r32) * a.ldq + hi * 8;
#pragma unroll
      for (int d0 = 0; d0 < ND; ++d0) qr[d0] = *(const bf16x8*)(Qw + d0 * 16); }
    const int sr = tid >> 4, sc = (tid & 15) * 8, vst0 = v_st(sr, sc), vst1 = v_st(32 + sr, sc);
    const int krr = tid >> 3, krc = (tid & 7) * 8;
    const int vb0 = (int)(uintptr_t)V_lds + v_rd_base(lane);
    const int qidx = wid * 32 + r32, qr_row = 4 * a.g + (qidx >> 6), qc = qidx & 63;
    const int r0w = min(max(qr_row - 4, 0), 24), csw = min(max(qc - 8, 0), 48);
    unsigned cmask = 0u;
    if (NA) {
#pragma unroll
        for (int i = 0; i < 16; ++i) { const int kc_ = crow(i, hi); if (kc_ >= csw && kc_ < csw + 16) cmask |= 1u << i; if (kc_ + 32 >= csw && kc_ + 32 < csw + 16) cmask |= 1u << (16 + i); } }
    const float* btl = bt + (4 * hi - qc + 15 + 48);
    bf16x8 vs0, vs1, ks0, ks1, kr0;
#define TOKOF(j) ((j) < a.n1 ? a.base1 + 64 * (j) : a.base2 + 64 * ((j) - a.n1))
#define SLOAD(j) do { const int t0_ = TOKOF(j); \
    vs0 = *(const bf16x8*)(a.V + (size_t)(t0_ + sr) * a.ldv + sc); vs1 = *(const bf16x8*)(a.V + (size_t)(t0_ + 32 + sr) * a.ldv + sc); \
    ks0 = *(const bf16x8*)(a.Kn + (size_t)(t0_ + sr) * a.ldk + sc); ks1 = *(const bf16x8*)(a.Kn + (size_t)(t0_ + 32 + sr) * a.ldk + sc); \
    if (DQK == 192) kr0 = *(const bf16x8*)(a.Kr + (size_t)(t0_ + krr) * a.ldkr + krc); } while (0)
#define SWRITE(b) do { *(bf16x8*)(V_lds + (b) * SHM_V + vst0) = vs0; *(bf16x8*)(V_lds + (b) * SHM_V + vst1) = vs1; \
    *(bf16x8*)(K_lds + (b) * SHM_K + KSWZ(sr, sc * 2)) = ks0; *(bf16x8*)(K_lds + (b) * SHM_K + KSWZ(32 + sr, sc * 2)) = ks1; \
    if (DQK == 192) *(bf16x8*)(K_lds + (b) * SHM_K + KSWZ(krr, 256 + krc * 2)) = kr0; } while (0)
#define QKT(P0, P1, b) do { P0 = f32x16{}; P1 = f32x16{}; const char* Ks_ = K_lds + (b) * SHM_K; \
    _Pragma("unroll") for (int d0 = 0; d0 < ND; ++d0) { const int cb = (d0 * 16 + hi * 8) * 2; \
      const bf16x8 b0_ = *(const bf16x8*)(Ks_ + KSWZ(r32, cb)); const bf16x8 b1_ = *(const bf16x8*)(Ks_ + KSWZ(32 + r32, cb)); \
      P0 = __builtin_amdgcn_mfma_f32_32x32x16_bf16(b0_, qr[d0], P0, 0, 0, 0); P1 = __builtin_amdgcn_mfma_f32_32x32x16_bf16(b1_, qr[d0], P1, 0, 0, 0); } } while (0)
#define MASK(P0, P1, j) do { if (NA && (j) >= a.n1) { const int rr_ = a.rlo + (j) - a.n1; const float* bp_ = btl + 128 * (rr_ - qr_row + 7); \
      _Pragma("unroll") for (int i = 0; i < 16; ++i) { const int ko_ = (i & 3) + 8 * (i >> 2); \
        P0[i] = ((cmask >> i) & 1u) ? P0[i] + bp_[ko_] : -INFINITY; P1[i] = ((cmask >> (16 + i)) & 1u) ? P1[i] + bp_[ko_ + 32] : -INFINITY; } } } while (0)
#define RESC(al) do { if (__any((al) < 1.f)) { if (hi == 0) al_l[r32] = (al); asm volatile("s_waitcnt lgkmcnt(0)" ::: "memory"); \
    _Pragma("unroll") for (int d = 0; d < 4; ++d) _Pragma("unroll") for (int r = 0; r < 16; ++r) o[d][r] *= al_l[crow(r, hi)]; } } while (0)
    f32x16 p0, p1; float al; bf16x8 pa0, pa1, pa2, pa3; const int NT = a.nt;
    SLOAD(0); SWRITE(0); __syncthreads();
    for (int j = 0; j < NT; ++j) {
        const int cb_ = j & 1;
        if (j + 1 < NT) SLOAD(j + 1);
        bool live = true;
        if (NA && j >= a.n1) { const int rr_ = a.rlo + j - a.n1; const int r0u = __builtin_amdgcn_readfirstlane(r0w); live = (rr_ >= r0u) && (rr_ < r0u + 8); }
        if (live) {
        SBAR(); QKT(p0, p1, cb_); MASK(p0, p1, j);
        partialSM(p0, p1, m_reg, al, C, thr);
        RESC(al);
        finishSM(p0, p1, al, l_reg, pa0, pa1, pa2, pa3); SBAR();
        pv_d0(o, vb0 + cb_ * SHM_V, pa0, pa1, pa2, pa3);
        }
        if (j + 1 < NT) SWRITE(cb_ ^ 1);
        __syncthreads();
    }
    if (hi == 0) li_l[r32] = l_reg; asm volatile("s_waitcnt lgkmcnt(0)" ::: "memory");
    float rli[16];
#pragma unroll
    for (int r = 0; r < 16; ++r) rli[r] = __builtin_amdgcn_rcpf(li_l[crow(r, hi)]);
    bf16_t* Ow = a.O + (size_t)(wid * QBLK) * a.ldo;
#pragma unroll
    for (int r = 0; r < 16; ++r) { const int orow = crow(r, hi);
#pragma unroll
        for (int d0 = 0; d0 < 4; ++d0) Ow[(size_t)orow * a.ldo + d0 * 32 + r32] = f2bf(o[d0][r] * rli[r]); }
#undef KSWZ
#undef TOKOF
#undef SLOAD
#undef SWRITE
#undef QKT
#undef MASK
#undef RESC
}
#undef SBAR
}

template <int N, int NCH>
__device__ __forceinline__ void hyena_unit(int c0, int col0, const bf16_t* PT, const bf16_t* filt0, int fstride, bf16_t* YH, const float* cw, const float* cb, const float* hbias, unsigned char* lds) {
    constexpr int LZ = N + 40, FL = 2 * N + 64, CHB = (16 * LZ + 2 * FL + 4 * N) * 2;
    int tid = threadIdx.x; asm volatile("" : "+v"(tid));
    const int lane = tid & 63, wave = __builtin_amdgcn_readfirstlane(tid >> 6);
    __syncthreads();
    for (int i = tid; i < NCH * 16 * 40; i += 512) { const int ch = i / 640, r = (i % 640) / 40, e = i % 40, sg = r >> 2; bf16_t* zr = (bf16_t*)(lds + ch * CHB) + r * LZ;
        zr[e < 32 - sg ? e : N + 32 - sg + (e - (32 - sg))] = 0; }
    for (int i = tid; i < NCH * (2 * FL) / 8; i += 512) { const int ch = i / ((2 * FL) / 8), e = i % ((2 * FL) / 8);
        ((u32x4*)(lds + ch * CHB + 16 * LZ * 2))[e] = ((const u32x4*)(filt0 + (size_t)ch * fstride))[e]; }
    u32x2 wv[4], wa[4], wx[4]; unsigned short hv[4][2], ha[4][2], hx[4][2];
#pragma unroll
    for (int q = 0; q < 4; ++q) { const int i = tid + 512 * q, ch = i / N, ii = i % N, b = ii / (N / 4), s0 = (ii % (N / 4)) * 4, c = c0 + ch; const size_t off = (size_t)col0 + (size_t)b * N + s0;
        const bf16_t* pv_ = PT + (size_t)c * TOK + off; const bf16_t* pa_ = PT + (size_t)(HYW + c) * TOK + off; const bf16_t* px_ = PT + (size_t)(2 * HYW + c) * TOK + off;
        wv[q] = *(const u32x2*)pv_; wa[q] = *(const u32x2*)pa_; wx[q] = *(const u32x2*)px_;
        hv[q][0] = s0 > 0 ? pv_[-1] : 0; hv[q][1] = s0 + 4 < N ? pv_[4] : 0; ha[q][0] = s0 > 0 ? pa_[-1] : 0; ha[q][1] = s0 + 4 < N ? pa_[4] : 0; hx[q][0] = s0 > 0 ? px_[-1] : 0; hx[q][1] = s0 + 4 < N ? px_[4] : 0; }
#pragma unroll
    for (int q = 0; q < 4; ++q) { const int i = tid + 512 * q, ch = i / N, ii = i % N, b = ii / (N / 4), s0 = (ii % (N / 4)) * 4, c = c0 + ch;
        const float wv0 = cw[c], wv1 = cw[1536 + c], wv2 = cw[3072 + c], bv = cb[c];
        const float wa0 = cw[HYW + c], wa1 = cw[1536 + HYW + c], wa2 = cw[3072 + HYW + c], ba = cb[HYW + c];
        const float wx0 = cw[2 * HYW + c], wx1 = cw[1536 + 2 * HYW + c], wx2 = cw[3072 + 2 * HYW + c], bx2 = cb[2 * HYW + c];
        float v[6], x1[6], x2[6];
        v[0] = bf2f(hv[q][0]); v[1] = bf2f(wv[q].x & 0xffff); v[2] = bf2f(wv[q].x >> 16); v[3] = bf2f(wv[q].y & 0xffff); v[4] = bf2f(wv[q].y >> 16); v[5] = bf2f(hv[q][1]);
        x1[0] = bf2f(ha[q][0]); x1[1] = bf2f(wa[q].x & 0xffff); x1[2] = bf2f(wa[q].x >> 16); x1[3] = bf2f(wa[q].y & 0xffff); x1[4] = bf2f(wa[q].y >> 16); x1[5] = bf2f(ha[q][1]);
        x2[0] = bf2f(hx[q][0]); x2[1] = bf2f(wx[q].x & 0xffff); x2[2] = bf2f(wx[q].x >> 16); x2[3] = bf2f(wx[q].y & 0xffff); x2[4] = bf2f(wx[q].y >> 16); x2[5] = bf2f(hx[q][1]);
        float z[4], ux[4];
#pragma unroll
        for (int e = 0; e < 4; ++e) { const float uv = wv0 * v[e] + wv1 * v[e + 1] + wv2 * v[e + 2] + bv, ua = wa0 * x1[e] + wa1 * x1[e + 1] + wa2 * x1[e + 2] + ba; z[e] = ua * uv; ux[e] = wx0 * x2[e] + wx1 * x2[e + 1] + wx2 * x2[e + 2] + bx2; }
        const unsigned p01 = cvt_pk_bf16(z[0], z[1]), p23 = cvt_pk_bf16(z[2], z[3]), p12 = (p01 >> 16) | (p23 << 16);
        bf16_t* ZS = (bf16_t*)(lds + ch * CHB); bf16_t* X2S = ZS + 16 * LZ + 2 * FL;
        { u32x2 w; w.x = p01; w.y = p23; *(u32x2*)(ZS + (0 * 4 + b) * LZ + s0 + 32) = w; }
        { bf16_t* r = ZS + (2 * 4 + b) * LZ + s0 + 30; *(unsigned*)r = p01; *(unsigned*)(r + 2) = p23; }
        { bf16_t* r = ZS + (1 * 4 + b) * LZ + s0 + 31; r[0] = (bf16_t)(p01 & 0xffff); *(unsigned*)(r + 1) = p12; r[3] = (bf16_t)(p23 >> 16); }
        { bf16_t* r = ZS + (3 * 4 + b) * LZ + s0 + 29; r[0] = (bf16_t)(p01 & 0xffff); *(unsigned*)(r + 1) = p12; r[3] = (bf16_t)(p23 >> 16); }
        { u32x2 w; w.x = cvt_pk_bf16(ux[0], ux[1]); w.y = cvt_pk_bf16(ux[2], ux[3]); *(u32x2*)(X2S + b * N + s0) = w; }
    }
    __syncthreads();
    {
        const int ch = (NCH == 1) ? 0 : wave, T0a = (NCH == 1) ? 256 * wave : 0, c = c0 + ch;
        const bf16_t* ZS = (const bf16_t*)(lds + ch * CHB); const bf16_t* RF = ZS + 16 * LZ; const bf16_t* X2S = RF + 2 * FL;
        constexpr int nks = (N + 32) / 32;
        const int rho = lane & 15, gq4 = lane >> 4, colb = (lane & 15) >> 2, sg = lane & 3;
        const bf16_t* zrow = ZS + (sg * 4 + colb) * LZ + 8 * gq4;
        const bf16_t* ra = RF + (N - T0a - 8 * rho + 8 * gq4);
        f32x4 acc[2][2] = {{{0.f, 0.f, 0.f, 0.f}, {0.f, 0.f, 0.f, 0.f}}, {{0.f, 0.f, 0.f, 0.f}, {0.f, 0.f, 0.f, 0.f}}};
#define HY_LD(B, A0, A1, A2, A3, ks) do { B = *(const bf16x8*)(zrow + 32 * (ks)); A0 = *(const bf16x8*)(ra + 32 * (ks)); A1 = *(const bf16x8*)(ra + FL + 32 * (ks)); A2 = *(const bf16x8*)(ra - 128 + 32 * (ks)); A3 = *(const bf16x8*)(ra - 128 + FL + 32 * (ks)); } while (0)
#define HY_MM(B, A0, A1, A2, A3) do { acc[0][0] = __builtin_amdgcn_mfma_f32_16x16x32_bf16(A0, B, acc[0][0], 0, 0, 0); acc[0][1] = __builtin_amdgcn_mfma_f32_16x16x32_bf16(A1, B, acc[0][1], 0, 0, 0); \
            acc[1][0] = __builtin_amdgcn_mfma_f32_16x16x32_bf16(A2, B, acc[1][0], 0, 0, 0); acc[1][1] = __builtin_amdgcn_mfma_f32_16x16x32_bf16(A3, B, acc[1][1], 0, 0, 0); } while (0)
        bf16x8 b0, p0, p1, p2, p3, b1, q0, q1, q2, q3;
        HY_LD(b0, p0, p1, p2, p3, 0);
        static_assert(nks % 2 == 1, "odd step count");
        for (int ks = 0; ks + 2 < nks; ks += 2) {
            HY_LD(b1, q0, q1, q2, q3, ks + 1); __builtin_amdgcn_sched_barrier(0);
            HY_MM(b0, p0, p1, p2, p3); __builtin_amdgcn_sched_barrier(0);
            HY_LD(b0, p0, p1, p2, p3, ks + 2); __builtin_amdgcn_sched_barrier(0);
            HY_MM(b1, q0, q1, q2, q3); __builtin_amdgcn_sched_barrier(0);
        }
        HY_MM(b0, p0, p1, p2, p3);
#undef HY_LD
#undef HY_MM
        const float hb_ = hbias[c];
        bf16_t* OS = (bf16_t*)(lds + NCH * CHB) + ch * 4 * N;
#pragma unroll
        for (int ti = 0; ti < 2; ++ti)
#pragma unroll
            for (int di = 0; di < 2; ++di)
#pragma unroll
                for (int rg = 0; rg < 4; ++rg) { const int t = T0a + 128 * ti + 8 * (4 * gq4 + rg) + 4 * di + sg;
                    const float zt = bf2f(ZS[colb * LZ + t + 32]), x2v = bf2f(X2S[colb * N + t]);
                    OS[colb * N + t] = f2bf(x2v * (acc[ti][di][rg] + zt * hb_)); }
    }
    __syncthreads();
#pragma unroll
    for (int j = 0; j < (NCH * 4 * N) / (8 * 512); ++j) { const int e = (tid + 512 * j) * 8, ch = e / (4 * N), r = e % (4 * N);
        *(u32x4*)(YH + (size_t)(c0 + ch) * TOK + col0 + r) = *(const u32x4*)((const bf16_t*)(lds + NCH * CHB) + e); }
}

#define XB_TMO      128
#define XB_XCNT(j)  (256  + 64 * (j))
#define XB_XSUB(j)  (1280 + 64 * (j))
#define XB_XGEN(j)  (2304 + 64 * (j))
#define XB_TOP      3328
#define XB_TOPGEN   3392
#define XCD_BAR_WORDS 3456
#define XB_SPIN_CAP (1u << 18)
__device__ __forceinline__ unsigned xb_ld(unsigned* p)              { return __hip_atomic_load(p, __ATOMIC_RELAXED, __HIP_MEMORY_SCOPE_AGENT); }
__device__ __forceinline__ unsigned xb_add(unsigned* p, unsigned v) { return __hip_atomic_fetch_add(p, v, __ATOMIC_RELAXED, __HIP_MEMORY_SCOPE_AGENT); }
__device__ __forceinline__ unsigned xb_xcc_id() { return (unsigned)__builtin_amdgcn_s_getreg((3 << 11) | 20) & 0xFu; }
#define XB_SPIN(cond, bar) do { unsigned _sp = 0; while (cond) { __builtin_amdgcn_s_sleep(1); \
    if ((++_sp & 255u) == 0u) { if (xb_ld(&(bar)[XB_TMO])) break; if (_sp > XB_SPIN_CAP) { atomicAdd(&(bar)[XB_TMO], 1u); break; } } } } while (0)
struct XcdBarrier { unsigned* bar; volatile LAS unsigned* st; };
__device__ __forceinline__ XcdBarrier xcd_barrier_post(unsigned* bar, volatile LAS unsigned* st) {
    XcdBarrier b; b.bar = bar; b.st = st;
    if (threadIdx.x == 0) (void)xb_add(&bar[XB_XCNT(xb_xcc_id())], 1u);
    return b;
}
__device__ __forceinline__ void xcd_barrier_complete(unsigned* bar, unsigned x, unsigned& nloc, unsigned& nx) {
    const unsigned G = gridDim.x * gridDim.y * gridDim.z;
    unsigned sum, cnt, mine, sp = 0u;
    for (;;) {
        sum = 0u; cnt = 0u; mine = 0u;
#pragma unroll
        for (unsigned j = 0; j < 16; ++j) { const unsigned c = xb_ld(&bar[XB_XCNT(j)]); sum += c; cnt += (c > 0u) ? 1u : 0u; mine = (j == x) ? c : mine; }
        if (sum == G) break;
        __builtin_amdgcn_s_sleep(1);
        if ((++sp & 255u) == 0u) { if (xb_ld(&bar[XB_TMO])) break; if (sp > XB_SPIN_CAP) { atomicAdd(&bar[XB_TMO], 1u); break; } }
    }
    nloc = mine > 0u ? mine : 1u; nx = cnt > 0u ? cnt : 1u;
}
__device__ __forceinline__ void xcd_barrier(const XcdBarrier& b) {
    asm volatile("s_waitcnt vmcnt(0)" ::: "memory");
    __syncthreads();
    if (threadIdx.x == 0) {
        unsigned* bar = b.bar; asm volatile("" : "+s"(bar));
        __builtin_amdgcn_s_waitcnt(0);
        const unsigned bxid = xb_xcc_id();
        unsigned nloc = b.st[0], nx = b.st[1];
        if (nloc == 0u) { xcd_barrier_complete(bar, bxid, nloc, nx); b.st[0] = nloc; b.st[1] = nx; }
        const unsigned old = xb_add(&bar[XB_XSUB(bxid)], 1u);
        const unsigned gen = old / nloc;
        if (old + 1u == (gen + 1u) * nloc) {
            __builtin_amdgcn_fence(__ATOMIC_RELEASE, "agent");
            asm volatile("s_waitcnt vmcnt(0)" ::: "memory");
            const unsigned og = xb_add(&bar[XB_TOP], 1u);
            const unsigned tg = og / nx;
            if (og + 1u == (tg + 1u) * nx) xb_add(&bar[XB_TOPGEN], 1u);
            else XB_SPIN(xb_ld(&bar[XB_TOPGEN]) == tg, bar);
            __builtin_amdgcn_fence(__ATOMIC_ACQUIRE, "agent");
            xb_add(&bar[XB_XGEN(bxid)], 1u);
            asm volatile("s_waitcnt vmcnt(0)" ::: "memory");
        } else {
            XB_SPIN(xb_ld(&bar[XB_XGEN(bxid)]) == gen, bar);
            __builtin_amdgcn_fence(__ATOMIC_ACQUIRE, "agent");
            asm volatile("s_waitcnt vmcnt(0)" ::: "memory");
        }
    }
    __syncthreads();
}

struct Params { const float* in[29]; float* out; unsigned char* ws; };
enum { I_X = 0, I_C, I_CTX, I_CCTX, I_WADA, I_BADA, I_GAPRE, I_GAPOST, I_GFPRE, I_GFPOST, I_WIN, I_HCW, I_HCB, I_FW1, I_FB1, I_FW2, I_FB2, I_FW3, I_FFREQ, I_HBIAS,
       I_GQ, I_WUQ, I_GKV, I_WUKV, I_RPB, I_WOUT, I_WG, I_WU, I_WD };

__device__ __forceinline__ const float* INP(int i) { int j = i; asm volatile("" : "+s"(j)); return ((const float* const __attribute__((address_space(4)))*)__builtin_amdgcn_kernarg_segment_ptr())[j]; }
template <class Map>
__device__ __forceinline__ void transpose_item(const float* W, int K, int N, bf16_t* WT, const float* kscale, LAS float* scr, int item, int lane, const Map& map) {
    const int nblk = N / 32, kb = item / nblk, nb = item % nblk, k0 = 64 * kb, n0 = 32 * nb;
    f32x4 ld[8];
#pragma unroll
    for (int j = 0; j < 8; ++j) ld[j] = __builtin_nontemporal_load((const f32x4*)(W + (size_t)(k0 + 8 * j + (lane >> 3)) * N + n0 + 4 * (lane & 7)));
#pragma unroll
    for (int j = 0; j < 8; ++j) { const int kk = 8 * j + (lane >> 3); f32x4 v = ld[j]; if (kscale) v = v * kscale[k0 + kk];
#pragma unroll
        for (int e = 0; e < 4; ++e) scr[kk * 33 + 4 * (lane & 7) + e] = v[e]; }
    asm volatile("s_waitcnt lgkmcnt(0)" ::: "memory");
    const int c = lane & 7;
#pragma unroll
    for (int j = 0; j < 4; ++j) { const int n = (lane >> 3) + 8 * j; const LAS float* s = scr + (8 * c) * 33 + n;
        u32x4 o; o.x = cvt_pk_bf16(s[0 * 33], s[1 * 33]); o.y = cvt_pk_bf16(s[2 * 33], s[3 * 33]); o.z = cvt_pk_bf16(s[4 * 33], s[5 * 33]); o.w = cvt_pk_bf16(s[6 * 33], s[7 * 33]);
        const int drow = map(n0 + n);
        if (drow >= 0) __builtin_nontemporal_store(o, (u32x4*)(WT + (size_t)drow * K + k0 + 8 * c)); }
    asm volatile("s_waitcnt lgkmcnt(0)" ::: "memory");
}
struct MapIdent { __device__ int operator()(int n) const { return n; } };
struct MapInH   { __device__ int operator()(int n) const { return n < 1536 ? n : -1; } };
struct MapInR   { __device__ int operator()(int n) const { if (n < 1536) return -1; const int r = n - 1536; if (r >= PR_KR && r < PR_KR + 64) { const int i = r - PR_KR; return PR_KR + (i < 32 ? 2 * i : 2 * (i - 32) + 1); } return r; } };
struct MapUQ    { __device__ int operator()(int n) const { const int h = n / 192, j = n % 192; if (j < 128) return n; const int i = j - 128; return h * 192 + 128 + (i < 32 ? 2 * i : 2 * (i - 32) + 1); } };
struct MapGate  { __device__ int operator()(int n) const { return 256 * (n >> 7) + (n & 127); } };
struct MapUp    { __device__ int operator()(int n) const { return 256 * (n >> 7) + 128 + (n & 127); } };

constexpr int WI_IN = 32 * (INC / 32), WI_UQ = (QLORA / 64) * (1536 / 32), WI_UKV = (KVLORA / 64) * (2048 / 32), WI_OUT = 32 * 64, WI_G = 32 * (FF / 32), WI_D = (FF / 64) * 64;
constexpr int WPER_L = WI_IN + WI_UQ + WI_UKV + WI_OUT + 2 * WI_G + WI_D;
constexpr int W_EARLY = 2560;
__device__ __forceinline__ void weight_item(int l, int r, LAS float* scr, int lane, unsigned char* ws) {
    unsigned char* wl2 = ws + (size_t)l * WL_STRIDE;
    if (r < WI_IN) { const int nb = r % (INC / 32); const float* W = INP(I_WIN) + (size_t)l * DM * INC;
        if (nb < 48) transpose_item(W, DM, INC, (bf16_t*)(wl2 + W_INH), nullptr, scr, r, lane, MapInH()); else transpose_item(W, DM, INC, (bf16_t*)(wl2 + W_INR), nullptr, scr, r, lane, MapInR()); return; } r -= WI_IN;
    if (r < WI_UQ) { transpose_item(INP(I_WUQ) + (size_t)l * QLORA * 1536, QLORA, 1536, (bf16_t*)(wl2 + W_UQ), INP(I_GQ) + l * QLORA, scr, r, lane, MapUQ()); return; } r -= WI_UQ;
    if (r < WI_UKV) { transpose_item(INP(I_WUKV) + (size_t)l * KVLORA * 2048, KVLORA, 2048, (bf16_t*)(wl2 + W_UKV), INP(I_GKV) + l * KVLORA, scr, r, lane, MapIdent()); return; } r -= WI_UKV;
    if (r < WI_OUT) { transpose_item(INP(I_WOUT) + (size_t)l * DM * DM, DM, DM, (bf16_t*)(wl2 + W_OUT), nullptr, scr, r, lane, MapIdent()); return; } r -= WI_OUT;
    if (r < WI_G) { transpose_item(INP(I_WG) + (size_t)l * DM * FF, DM, FF, (bf16_t*)(wl2 + W_GU), nullptr, scr, r, lane, MapGate()); return; } r -= WI_G;
    if (r < WI_G) { transpose_item(INP(I_WU) + (size_t)l * DM * FF, DM, FF, (bf16_t*)(wl2 + W_GU), nullptr, scr, r, lane, MapUp()); return; } r -= WI_G;
    transpose_item(INP(I_WD) + (size_t)l * FF * DM, FF, DM, (bf16_t*)(wl2 + W_DN), nullptr, scr, r, lane, MapIdent());
}

__global__ void __launch_bounds__(512, 2) fwd_mega(Params p) {
    extern __shared__ __attribute__((aligned(16))) unsigned char lds[];
    LAS unsigned char* ldsl = (LAS unsigned char*)lds;
    const int wave = __builtin_amdgcn_readfirstlane(threadIdx.x >> 6);
    const int G = gridDim.x, NGW = G * 8;
#define bx0 ((int)blockIdx.x)
#define DECL_PTRS(L) unsigned char* ws = (unsigned char*)INP(30); asm volatile("" : "+s"(ws)); int tid = threadIdx.x; asm volatile("" : "+v"(tid)); const int lane = tid & 63; (void)lane; \
    int bx = blockIdx.x; asm volatile("" : "+s"(bx)); const int vcu = (G % 8 == 0) ? (bx % 8) * (G / 8) + bx / 8 : bx; const int gw = vcu * 8 + wave; (void)gw;   \
    float* MOD = (float*)(ws + S_MOD); float* ROPE = (float*)(ws + S_ROPE); float* SSQ = (float*)(ws + S_SSQ); float* SSQY = (float*)(ws + S_SSQY); \
    bf16_t* FILT = (bf16_t*)(ws + S_FILT); bf16_t* FILTC = (bf16_t*)(ws + S_FILTC); \
    bf16_t* Hb = (bf16_t*)(ws + A_H); bf16_t* YC = (bf16_t*)(ws + A_YC); bf16_t* YF = (bf16_t*)(ws + A_YF); bf16_t* XR = (bf16_t*)(ws + A_XR); \
    bf16_t* PR = (bf16_t*)(ws + A_PR); bf16_t* PT = (bf16_t*)(ws + A_PT); bf16_t* Qb = (bf16_t*)(ws + A_Q); bf16_t* KVb = (bf16_t*)(ws + A_KV); bf16_t* ACT = (bf16_t*)(ws + A_ACT); \
    unsigned char* wl = ws + (size_t)(L) * WL_STRIDE; const float* mod = MOD + (size_t)(L) * 5 * ADA; \
    (void)ROPE; (void)SSQ; (void)SSQY; (void)FILT; (void)FILTC; (void)Hb; (void)YC; (void)YF; (void)XR; (void)PR; (void)PT; (void)Qb; (void)KVb; (void)ACT; (void)wl; (void)mod;

#if PROBE_MULT
    unsigned long long* stamps = (unsigned long long*)((unsigned char*)INP(30) + S_CTL + 524288); int sidx = 0;
#define STAMP() do { if (bx0 == 0 && threadIdx.x == 0) stamps[sidx] = __builtin_amdgcn_s_memrealtime(); ++sidx; } while (0)
#else
#define STAMP() do {} while (0)
#endif
#if PROBE_MULT
#define DBGP(set) (stamps + 40 + 8 * (set))
#else
#define DBGP(set) nullptr
#endif
    STAMP();
    volatile LAS unsigned* MISC = (volatile LAS unsigned*)(ldsl + 131072);
    if (threadIdx.x == 0) { MISC[0] = 0u; MISC[1] = 0u; }
    __syncthreads();
    XcdBarrier xb = xcd_barrier_post((unsigned*)((unsigned char*)INP(30) + S_CTL), MISC);
    {
        DECL_PTRS(0)
        for (int i = bx * 512 + tid; i < SEQ * 32; i += G * 512) { const int t = i >> 5, f = i & 31; const float pos = (f < 16) ? (float)(t >> 6) : (float)(t & 63);
            const float inv = powf(10000.0f, -(float)(f & 15) / 16.0f); const float ang = pos * inv; ROPE[2 * i] = cosf(ang); ROPE[2 * i + 1] = sinf(ang); }
        for (int l = 0; l < 2; ++l) { u32x4* z = (u32x4*)(ws + l * WL_STRIDE + W_INR + (size_t)2880 * DM * 2); const int n16 = 192 * DM * 2 / 16;
            for (int i = bx * 512 + tid; i < n16; i += G * 512) z[i] = (u32x4){0u, 0u, 0u, 0u}; }
        for (int i = bx * 512 + tid; i < 2 * HYW * 2 * 128; i += G * 512) {
            const int s = i & 127, cd = i >> 7, d = (cd & 1) * 4; bf16_t* f = FILT + (size_t)cd * FLEN;
            if (s < 64) { if (s <= d + 32) f[s] = 0; } else { const int ii = FLEN - 128 + s; if (ii >= d + 2 * SEQ + 32) f[ii] = 0; } }
        for (int i = bx * 512 + tid; i < HYW * 2 * 128; i += G * 512) {
            const int s = i & 127, cd = i >> 7, d = (cd & 1) * 4; bf16_t* f = FILTC + (size_t)cd * FLENC;
            if (s < 64) { if (s <= d + 32) f[s] = 0; } else { const int ii = FLENC - 128 + s; if (ii >= d + 2 * CTXL + 32) f[ii] = 0; } }
        if (vcu < 192) {
            if (PH(14)) {
            LAS float* sS = (LAS float*)ldsl;
            LAS float* red = (LAS float*)(ldsl + 5 * 2048 * 4);
            for (int i = tid; i < 5 * DM; i += 512) { const int m = i / DM, k = i % DM; const float v = (m < 4) ? INP(I_C)[m * DM + k] : INP(I_CCTX)[k]; sS[i] = v / (1.0f + __expf(-v)); }
            __syncthreads();
            {
                const int item = vcu, l = item / 96, n0 = (item % 96) * 128;
                const float* W = INP(I_WADA) + (size_t)l * DM * ADA + n0 + 4 * (lane & 31);
                f32x4 acc[5];
#pragma unroll
                for (int m = 0; m < 5; ++m) acc[m] = (f32x4){0.f, 0.f, 0.f, 0.f};
                const int kbase = wave * 256 + (lane >> 5);
#pragma unroll 16
                for (int kk = 0; kk < 128; ++kk) { const int k = kbase + 2 * kk; const f32x4 w = __builtin_nontemporal_load((const f32x4*)(W + (size_t)k * ADA));
#pragma unroll
                    for (int m = 0; m < 5; ++m) acc[m] += w * sS[m * DM + k]; }
#pragma unroll
                for (int m = 0; m < 5; ++m) {
#pragma unroll
                    for (int e = 0; e < 4; ++e) acc[m][e] += __shfl_xor(acc[m][e], 32);
                    if (lane < 32) *(LAS f32x4*)(red + (wave * 5 + m) * 128 + 4 * lane) = acc[m]; }
                __syncthreads();
                for (int i = tid; i < 640; i += 512) { const int m = i >> 7, c = i & 127; float s = 0.f;
#pragma unroll
                    for (int w = 0; w < 8; ++w) s += red[(w * 5 + m) * 128 + c];
                    MOD[((size_t)l * 5 + m) * ADA + n0 + c] = s + INP(I_BADA)[(size_t)l * ADA + n0 + c]; }
            }
            }
        } else if (PH(15)) {
            LAS float* tb = (LAS float*)(ldsl + wave * 16384);
            float* H2T = (float*)(ws + S_H2T);
            for (int it = (vcu - 192) * 8 + wave; it < 136; it += (G - 192) * 8) {
                const int set = it < 64 ? 0 : (it < 128 ? 1 : 2), r = it - 64 * set, l = (set == 1) ? 1 : 0, n = (set == 2) ? CTXL : SEQ, pos0 = r * 32, li = lane & 31, hh = lane >> 5;
                const float* w1 = INP(I_FW1) + l * 33 * 64; const float* b1 = INP(I_FB1) + l * 64; const float* w2 = INP(I_FW2) + l * 64 * 64; const float* b2 = INP(I_FB2) + l * 64; const float* fr = INP(I_FFREQ) + l * 64;
                constexpr float INV2PI = 0.15915494309189535f;
                const int pos = pos0 + li;
                f32x16 acc[2] = {f32x16{}, f32x16{}};
#pragma unroll
                for (int s = 0; s < 17; ++s) { const int k = 2 * s + hh; float a;
                    if (k == 0) a = (float)pos / (float)(n - 1);
                    else if (k == 33) a = 0.f;
                    else { const int bi = (k - 1) & 15; const float band = 1e-4f + (float)bi * ((15.0f - 1e-4f) / 15.0f); const float rev = (float)pos * band / (float)n;
                        a = (k <= 16) ? __builtin_amdgcn_cosf(rev) : -__builtin_amdgcn_sinf(rev); }
                    const int kc = k < 33 ? k : 32;
#pragma unroll
                    for (int cb = 0; cb < 2; ++cb) { const float b = (k < 33) ? w1[kc * 64 + 32 * cb + li] : 0.f; acc[cb] = __builtin_amdgcn_mfma_f32_32x32x2f32(a, b, acc[cb], 0, 0, 0); } }
#pragma unroll
                for (int cb = 0; cb < 2; ++cb) { const int j = 32 * cb + li; const float frj = fr[j] * INV2PI, bj = b1[j];
#pragma unroll
                    for (int rg = 0; rg < 16; ++rg) { const int prow = (rg & 3) + 8 * (rg >> 2) + 4 * hh; tb[prow * 65 + j] = __builtin_amdgcn_sinf(frj * (acc[cb][rg] + bj)); } }
                asm volatile("s_waitcnt lgkmcnt(0)" ::: "memory");
                acc[0] = f32x16{}; acc[1] = f32x16{};
#pragma unroll 8
                for (int s = 0; s < 32; ++s) { const int k = 2 * s + hh; const float a = tb[li * 65 + k];
#pragma unroll
                    for (int cb = 0; cb < 2; ++cb) acc[cb] = __builtin_amdgcn_mfma_f32_32x32x2f32(a, w2[k * 64 + 32 * cb + li], acc[cb], 0, 0, 0); }
                asm volatile("s_waitcnt lgkmcnt(0)" ::: "memory");
#pragma unroll
                for (int cb = 0; cb < 2; ++cb) { const int j = 32 * cb + li; const float frj = fr[j] * INV2PI, bj = b2[j]; float* o = H2T + (size_t)set * 64 * SEQ + (size_t)j * n + pos0;
#pragma unroll
                    for (int rg = 0; rg < 16; ++rg) { const int prow = (rg & 3) + 8 * (rg >> 2) + 4 * hh; o[prow] = __builtin_amdgcn_sinf(frj * (acc[cb][rg] + bj)); } }
            }
            if (PH(16)) { asm volatile("s_waitcnt lgkmcnt(0)" ::: "memory"); for (int it = (vcu - 192) * 8 + wave; it < W_EARLY; it += (G - 192) * 8) weight_item(0, it, tb, lane, ws); }
        }
    }
    xcd_barrier(xb);
    STAMP();
    {
        DECL_PTRS(0)
        LAS float* scr = (LAS float*)(ldsl + wave * 16384);
        constexpr int I_IN = 32 * (INC / 32), I_UQ = (QLORA / 64) * (1536 / 32), I_UKV = (KVLORA / 64) * (2048 / 32), I_OUT = 32 * 64, I_G = 32 * (FF / 32), I_D = (FF / 64) * 64;
        constexpr int PER_L = I_IN + I_UQ + I_UKV + I_OUT + 2 * I_G + I_D;
        constexpr int N_F3 = 2 * (SEQ / 32) * 8 + (CTXL / 32) * 8, N_TR = 2 * PER_L - W_EARLY, N_ALL = N_F3 + N_TR + TOK;
        for (int it0 = gw; it0 < N_ALL; it0 += NGW) {
            int it = it0;
            if (it < N_F3) {
                if (!PH(15)) continue;
                int set, r; if (it < 512) { set = 0; r = it; } else if (it < 1024) { set = 1; r = it - 512; } else { set = 2; r = it - 1024; }
                const int l = (set == 1) ? 1 : 0, n = (set == 2) ? CTXL : SEQ, pos0 = (r >> 3) * 32, c0 = (r & 7) * 128, li = lane & 31, hh = lane >> 5;
                const float* H2T = (const float*)(ws + S_H2T) + (size_t)set * 64 * SEQ + pos0 + li; const float* w3 = INP(I_FW3) + (size_t)l * 64 * 1024 + c0 + li;
                f32x16 acc[4];
#pragma unroll
                for (int cb = 0; cb < 4; ++cb) acc[cb] = f32x16{};
#pragma unroll 8
                for (int s = 0; s < 32; ++s) { const int k = 2 * s + hh; const float a = H2T[(size_t)k * n];
#pragma unroll
                    for (int cb = 0; cb < 4; ++cb) acc[cb] = __builtin_amdgcn_mfma_f32_32x32x2f32(a, w3[k * 1024 + 32 * cb], acc[cb], 0, 0, 0); }
                bf16_t* F = (set == 2) ? FILTC : FILT + (size_t)l * HYW * 2 * FLEN; const int flen = (set == 2) ? FLENC : FLEN;
                const float invn = 1.0f / (float)(n - 1);
#pragma unroll
                for (int cb = 0; cb < 4; ++cb) {
                    const int cabs = c0 + 32 * cb + li, ch = cabs & (HYW - 1);
                    const float delta = fabsf(-15.350567286626973f + (float)ch * ((-3.0701134573253945f + 15.350567286626973f) / 511.0f));
#pragma unroll
                    for (int rg = 0; rg < 16; ++rg) { const int prow = (rg & 3) + 8 * (rg >> 2) + 4 * hh; scr[li * 33 + prow] = acc[cb][rg] * __expf(-(float)(pos0 + prow) * invn * delta); }
                    asm volatile("s_waitcnt lgkmcnt(0)" ::: "memory");
                    const int pos = pos0 + li;
#pragma unroll 4
                    for (int i2 = 0; i2 < 16; ++i2) { const int col = 2 * i2 + hh, c2 = c0 + 32 * cb + col; const bool bwd = c2 >= HYW; const bf16_t kb = f2bf(scr[col * 33 + li]);
                        bf16_t* f0 = F + (size_t)((c2 & (HYW - 1)) * 2) * flen;
                        if (!bwd) { f0[n + 32 - pos] = kb; f0[flen + 4 + n + 32 - pos] = kb; }
                        else if (pos >= 1) { f0[n + 32 + pos] = kb; f0[flen + 4 + n + 32 + pos] = kb; } }
                    asm volatile("s_waitcnt lgkmcnt(0)" ::: "memory");
                }
                continue;
            }
            it -= N_F3;
            if (it < N_TR) {
                if (!PH(16)) continue;
                { const int gi = it + W_EARLY; weight_item(gi / WPER_L, gi % WPER_L, scr, lane, ws); }
                continue;
            }
            it -= N_TR;
            if (PH(1)) {
                const int row = it; const float* gpre = INP(I_GAPRE);
                const float* src = (row < NLAT) ? INP(I_X) + (size_t)row * DM : INP(I_CTX) + (size_t)(row - NLAT) * DM;
                const int bm = (row < NLAT) ? (row >> 11) : 4; const float* mrow = mod + (size_t)bm * ADA;
                f32x4 v[8]; float ss = 0.f;
#pragma unroll
                for (int j = 0; j < 8; ++j) { v[j] = *(const f32x4*)(src + 4 * lane + 256 * j); ss += pg8::dot4(v[j]); }
                const float rs = 1.0f / sqrtf(wave_sum(ss) * (1.0f / DM) + RMS_EPS);
#pragma unroll
                for (int j = 0; j < 8; ++j) { const int k = 4 * lane + 256 * j; const f32x4 gg = *(const f32x4*)(gpre + k), sh = *(const f32x4*)(mrow + k), sc = *(const f32x4*)(mrow + DM + k);
                    const f32x4 hh = v[j] * rs * gg * (sc + 1.0f) + sh; u32x2 w; w.x = cvt_pk_bf16(hh[0], hh[1]); w.y = cvt_pk_bf16(hh[2], hh[3]); *(u32x2*)(Hb + (size_t)row * DM + k) = w; }
            }
        }
    }
    xcd_barrier(xb); STAMP();

    for (int l = 0; l < 2; ++l) {
        const int MR = (l == 0) ? TOK : NLAT;
        if (PH(2)) {
            DECL_PTRS(l)
            { pg8::Gemm g{Hb, (const bf16_t*)(wl + W_INR), TOK, PRW, DM, DM, DM}; pg8::StaticOrder S; S.init(TOK, PRW, G, bx); pg8::EpiPR E{PR, SSQ, ROPE}; pg8::gemm_phase(ldsl, g, S, E); }
            { pg8::Gemm g{(const bf16_t*)(wl + W_INH), Hb, 1536, TOK, DM, DM, DM}; pg8::StaticOrder S; S.init(1536, TOK, G, (bx + 176) % G); pg8::EpiBf16 E{PT, TOK}; pg8::gemm_phase(ldsl, g, S, E); }
        }
        xcd_barrier(xb); STAMP();
        if (PH(3)) {
            DECL_PTRS(l)
            const int MQ = (l == 0) ? TOK : NLAT;
            { pg8::Gemm g{PR, (const bf16_t*)(wl + W_UQ), MQ, 1536, QLORA, PRW, QLORA}; pg8::StaticOrder S; S.init(MQ, 1536, G, bx); pg8::EpiQ E{Qb, SSQ, ROPE}; pg8::gemm_phase(ldsl, g, S, E); }
            { pg8::Gemm g{PR + QLORA, (const bf16_t*)(wl + W_UKV), TOK, 2048, KVLORA, PRW, KVLORA}; pg8::StaticOrder S; S.init(TOK, 2048, G, (bx + 40) % G); pg8::EpiKV E{KVb, SSQ}; pg8::gemm_phase(ldsl, g, S, E); }
        }
        xcd_barrier(xb); STAMP();
        {
            DECL_PTRS(l)
            char* al = (char*)lds;
            if (PH(10))
            for (int uidx = vcu; uidx < 256; uidx += G) {
                const int bh = uidx >> 3, qb = uidx & 7, b = bh >> 3, h = bh & 7; const int row0 = b * SEQ + qb * 256;
                att::Args a; a.Q = Qb + (size_t)row0 * 1536 + h * 192; a.ldq = 1536; a.Kn = KVb + h * 256; a.ldk = 2048; a.Kr = PR + PR_KR; a.ldkr = PRW; a.V = KVb + h * 256 + 128; a.ldv = 2048;
                a.O = YC + (size_t)row0 * DM + 512 + h * 128; a.ldo = DM; a.nt = 36; a.n1 = 32; a.base1 = b * SEQ; a.base2 = NLAT + b * CTXL; a.scale = MLA_SCALE; a.g = 0; a.rlo = 0; a.bias = nullptr;
                att::unit<192, false>(a, al);
            }
#if PROBE_MULT && PROBE_SUB
            xcd_barrier(xb); STAMP();
#endif
            const float* rpb = INP(I_RPB) + (size_t)l * 4 * 15 * 31;
            if (PH(11))
            for (int uidx = vcu; uidx < 128; uidx += G) {
                const int bh = uidx >> 3, gq = uidx & 7, b = bh >> 2, h = bh & 3; const int row0 = b * SEQ + gq * 256;
                const int rlo = min(max(4 * gq - 4, 0), 24), nr = (gq == 0 || gq == 7) ? 8 : 11;
                att::Args a; a.Q = PR + (size_t)row0 * PRW + PR_NAQ + h * 128; a.ldq = PRW; a.Kn = PR + PR_NAK + h * 128; a.ldk = PRW; a.Kr = nullptr; a.ldkr = 0; a.V = PR + PR_NAV + h * 128; a.ldv = PRW;
                a.O = YC + (size_t)row0 * DM + 1536 + h * 128; a.ldo = DM; a.nt = 4 + nr; a.n1 = 4; a.base1 = NLAT + b * CTXL; a.base2 = b * SEQ + rlo * 64; a.scale = NA_SCALE; a.g = gq; a.rlo = rlo; a.bias = rpb + h * 15 * 31;
                att::unit<128, true>(a, al);
            }
#if PROBE_MULT && PROBE_SUB
            xcd_barrier(xb); STAMP();
#endif
            if (l == 0 && PH(12)) {
                for (int uidx = vcu - 128; uidx >= 0 && uidx < 32; uidx += G) { const int b = uidx >> 3, h = uidx & 7; const int row0 = NLAT + b * CTXL;
                    att::Args a; a.Q = Qb + (size_t)row0 * 1536 + h * 192; a.ldq = 1536; a.Kn = KVb + h * 256; a.ldk = 2048; a.Kr = PR + PR_KR; a.ldkr = PRW; a.V = KVb + h * 256 + 128; a.ldv = 2048;
                    a.O = YC + (size_t)row0 * DM + 512 + h * 128; a.ldo = DM; a.nt = 4; a.n1 = 4; a.base1 = row0; a.base2 = row0; a.scale = MLA_SCALE; a.g = 0; a.rlo = 0; a.bias = nullptr;
                    att::unit<192, false>(a, al); }
                for (int uidx = vcu - 160; uidx >= 0 && uidx < 16; uidx += G) { const int b = uidx >> 2, h = uidx & 3; const int row0 = NLAT + b * CTXL;
                    att::Args a; a.Q = PR + (size_t)row0 * PRW + PR_NAQ + h * 128; a.ldq = PRW; a.Kn = PR + PR_NAK + h * 128; a.ldk = PRW; a.Kr = nullptr; a.ldkr = 0; a.V = PR + PR_NAV + h * 128; a.ldv = PRW;
                    a.O = YC + (size_t)row0 * DM + 1536 + h * 128; a.ldo = DM; a.nt = 4; a.n1 = 4; a.base1 = row0; a.base2 = row0; a.scale = NA_SCALE; a.g = 0; a.rlo = 0; a.bias = nullptr;
                    att::unit<128, false>(a, al); }
            }
#if PROBE_MULT && PROBE_SUB
            xcd_barrier(xb); STAMP();
#endif
            if (PH(13)) {
                const float* cw = INP(I_HCW) + (size_t)l * 3 * 1536; const float* cb = INP(I_HCB) + (size_t)l * 1536; const float* hbias = INP(I_HBIAS) + (size_t)l * HYW;
                { const int c0h = vcu < 128 ? vcu : 128 + 3 * (vcu - 128), nch = vcu < 128 ? 1 : 3;
                  for (int k4 = 0; k4 < nch; ++k4) { const int c = c0h + k4; hyena_unit<SEQ, 1>(c, 0, PT, FILT + ((size_t)l * HYW + c) * 2 * FLEN, 0, (bf16_t*)(ws + A_YH), cw, cb, hbias, lds); } }
                if (l == 0) for (int u = (vcu + 64) % G; u < HYW / 8; u += G) hyena_unit<CTXL, 8>(8 * u, NLAT, PT, FILTC + (size_t)(8 * u) * 2 * FLENC, 2 * FLENC, (bf16_t*)(ws + A_YH), cw, cb, hbias, lds);
            }
        }
        xcd_barrier(xb); STAMP();
        if (PH(13)) {
            DECL_PTRS(l)
            const bf16_t* YH = (const bf16_t*)(ws + A_YH); LAS unsigned short* tt = (LAS unsigned short*)(ldsl + wave * 16384);
            const int ntok = MR / 64;
            for (int it = gw; it < 8 * ntok; it += NGW) { const int cb8 = it / ntok, tb = it % ntok, ch0 = cb8 * 64, t0 = tb * 64;
#pragma unroll
                for (int j = 0; j < 8; ++j) { const int chl = 8 * j + (lane >> 3), tq = (lane & 7) * 8; const u32x4 w = *(const u32x4*)(YH + (size_t)(ch0 + chl) * TOK + t0 + tq);
                    LAS unsigned* d = (LAS unsigned*)(tt + chl * 66 + tq); d[0] = w.x; d[1] = w.y; d[2] = w.z; d[3] = w.w; }
                asm volatile("s_waitcnt lgkmcnt(0)" ::: "memory");
#pragma unroll
                for (int j = 0; j < 8; ++j) { const int tl = 8 * j + (lane >> 3), cq = (lane & 7) * 8; u32x4 o;
                    o.x = (unsigned)tt[(cq + 0) * 66 + tl] | ((unsigned)tt[(cq + 1) * 66 + tl] << 16); o.y = (unsigned)tt[(cq + 2) * 66 + tl] | ((unsigned)tt[(cq + 3) * 66 + tl] << 16);
                    o.z = (unsigned)tt[(cq + 4) * 66 + tl] | ((unsigned)tt[(cq + 5) * 66 + tl] << 16); o.w = (unsigned)tt[(cq + 6) * 66 + tl] | ((unsigned)tt[(cq + 7) * 66 + tl] << 16);
                    *(u32x4*)(YC + (size_t)(t0 + tl) * DM + ch0 + cq) = o; }
                asm volatile("s_waitcnt lgkmcnt(0)" ::: "memory");
            }
        }
        xcd_barrier(xb); STAMP();
        if (PH(5)) { DECL_PTRS(l) { pg8::Gemm g{YC, (const bf16_t*)(wl + W_OUT), NLAT, DM, DM, DM, DM}; pg8::StaticOrder S; S.init(NLAT, DM, G, bx);
              unsigned* ctl = (unsigned*)(ws + S_CTL); f32x4* xbs = (f32x4*)(ws + A_XB); const int set = l * 2 + 0;
              const pg8::RowExchange rx{xbs + (size_t)set * 65536, ctl + CW_XCH + set * 2048, ctl + CW_TMO, DBGP(set)};
              if (l == 0) { pg8::EpiNormRes<true, true> E{INP(I_X), XR, INP(I_GAPOST) + l * DM, mod + 2 * DM, INP(I_GFPRE) + l * DM, mod + 3 * DM, mod + 4 * DM, XR, Hb, nullptr, rx}; pg8::gemm_phase(ldsl, g, S, E); }
              else { pg8::EpiNormRes<false, true> E{nullptr, XR, INP(I_GAPOST) + l * DM, mod + 2 * DM, INP(I_GFPRE) + l * DM, mod + 3 * DM, mod + 4 * DM, XR, Hb, nullptr, rx}; pg8::gemm_phase(ldsl, g, S, E); } }
            if (l == 0) { pg8::Gemm g{YC, (const bf16_t*)(wl + W_OUT), TOK, DM, DM / 4, DM, DM}; pg8::CtxSplitOrder S{bx, DM / 4}; pg8::EpiPart E{(float*)(ws + A_YP), DM / 4}; pg8::gemm_phase(ldsl, g, S, E); } }
        xcd_barrier(xb); STAMP();
        if (l == 0) {
        if (PH(6)) {
            DECL_PTRS(l)
            const float* gpost = INP(I_GAPOST) + l * DM; const float* gfpre = INP(I_GFPRE) + l * DM;
            for (int row = NLAT + gw; row < TOK; row += NGW) {
                const float* xs = (row < NLAT) ? INP(I_X) + (size_t)row * DM : INP(I_CTX) + (size_t)(row - NLAT) * DM;
                const int bm = (row < NLAT) ? (row >> 11) : 4; const float* mrow = mod + (size_t)bm * ADA;
                f32x4 y[8]; float sy;
                if (row < NLAT) { sy = (lane < 32) ? SSQY[(size_t)row * 32 + lane] : 0.f;
#pragma unroll
                    for (int j = 0; j < 8; ++j) y[j] = ldbf4(YF + (size_t)row * DM + 4 * lane + 256 * j); }
                else { const float* yp = (const float*)(ws + A_YP) + (size_t)(row - NLAT) * DM + 4 * lane; sy = 0.f;
#pragma unroll
                    for (int j = 0; j < 8; ++j) { y[j] = (*(const f32x4*)(yp + 256 * j) + *(const f32x4*)(yp + (size_t)NCTX * DM + 256 * j)) + (*(const f32x4*)(yp + (size_t)2 * NCTX * DM + 256 * j) + *(const f32x4*)(yp + (size_t)3 * NCTX * DM + 256 * j)); sy += pg8::dot4(y[j]); } }
                sy = wave_sum(sy);
                const float rsy = 1.0f / sqrtf(sy * (1.0f / DM) + RMS_EPS);
                f32x4 v[8]; float ss = 0.f;
#pragma unroll
                for (int j = 0; j < 8; ++j) { const int k = 4 * lane + 256 * j; const f32x4 xv = (l == 0) ? *(const f32x4*)(xs + k) : ldbf4(XR + (size_t)row * DM + k), yv = y[j], gg = *(const f32x4*)(gpost + k), gt = *(const f32x4*)(mrow + 2 * DM + k);
                    v[j] = xv + gt * (yv * rsy * gg); ss += pg8::dot4(v[j]); stbf4(XR + (size_t)row * DM + k, v[j]); }
                const float rs = 1.0f / sqrtf(wave_sum(ss) * (1.0f / DM) + RMS_EPS);
#pragma unroll
                for (int j = 0; j < 8; ++j) { const int k = 4 * lane + 256 * j; const f32x4 gg = *(const f32x4*)(gfpre + k), sh = *(const f32x4*)(mrow + 3 * DM + k), sc = *(const f32x4*)(mrow + 4 * DM + k);
                    const f32x4 hh = v[j] * rs * gg * (sc + 1.0f) + sh; u32x2 w; w.x = cvt_pk_bf16(hh[0], hh[1]); w.y = cvt_pk_bf16(hh[2], hh[3]); *(u32x2*)(Hb + (size_t)row * DM + k) = w; }
            }
        }
        xcd_barrier(xb); STAMP();
        }
        if (PH(7)) { DECL_PTRS(l) pg8::Gemm g{Hb, (const bf16_t*)(wl + W_GU), MR, 2 * FF, DM, DM, DM}; pg8::StaticOrder S; S.init(MR, 2 * FF, G, bx); pg8::EpiSwiGLU E{ACT}; pg8::gemm_phase(ldsl, g, S, E); }
        xcd_barrier(xb); STAMP();
        if (PH(8)) { DECL_PTRS(l) { pg8::Gemm g{ACT, (const bf16_t*)(wl + W_DN), NLAT, DM, FF, FF, FF}; pg8::StaticOrder S; S.init(NLAT, DM, G, bx);
              unsigned* ctl = (unsigned*)(ws + S_CTL); f32x4* xbs = (f32x4*)(ws + A_XB); const int set = l * 2 + 1; const float* modn = MOD + (size_t)5 * ADA;
              const pg8::RowExchange rx{xbs + (size_t)set * 65536, ctl + CW_XCH + set * 2048, ctl + CW_TMO, DBGP(set)};
              if (l == 0) { pg8::EpiNormRes<false, true> E{nullptr, XR, INP(I_GFPOST) + l * DM, mod + 5 * DM, INP(I_GAPRE) + DM, modn, modn + DM, XR, Hb, nullptr, rx}; pg8::gemm_phase(ldsl, g, S, E); }
              else { pg8::EpiNormRes<false, false> E{nullptr, XR, INP(I_GFPOST) + l * DM, mod + 5 * DM, nullptr, modn, modn, XR, Hb, (float*)INP(29), rx}; pg8::gemm_phase(ldsl, g, S, E); } }
            if (l == 0) { pg8::Gemm g{ACT, (const bf16_t*)(wl + W_DN), TOK, DM, FF / 4, FF, FF}; pg8::CtxSplitOrder S{bx, FF / 4}; pg8::EpiPart E{(float*)(ws + A_YP), FF / 4}; pg8::gemm_phase(ldsl, g, S, E); } }
        xcd_barrier(xb); STAMP();
        if (l == 0 && PH(9)) {
            DECL_PTRS(l)
            const float* gpost = INP(I_GFPOST) + l * DM; const float* gnext = INP(I_GAPRE) + DM; const float* modn = MOD + (size_t)5 * ADA;
            for (int row = NLAT + gw; row < TOK; row += NGW) {
                const int bm = (row < NLAT) ? (row >> 11) : 4; const float* mrow = mod + (size_t)bm * ADA; const float* mnext = modn + (size_t)bm * ADA;
                f32x4 y[8]; float sy;
                if (row < NLAT) { sy = (lane < 32) ? SSQY[(size_t)row * 32 + lane] : 0.f;
#pragma unroll
                    for (int j = 0; j < 8; ++j) y[j] = ldbf4(YF + (size_t)row * DM + 4 * lane + 256 * j); }
                else { const float* yp = (const float*)(ws + A_YP) + (size_t)(row - NLAT) * DM + 4 * lane; sy = 0.f;
#pragma unroll
                    for (int j = 0; j < 8; ++j) { y[j] = (*(const f32x4*)(yp + 256 * j) + *(const f32x4*)(yp + (size_t)NCTX * DM + 256 * j)) + (*(const f32x4*)(yp + (size_t)2 * NCTX * DM + 256 * j) + *(const f32x4*)(yp + (size_t)3 * NCTX * DM + 256 * j)); sy += pg8::dot4(y[j]); } }
                sy = wave_sum(sy);
                const float rsy = 1.0f / sqrtf(sy * (1.0f / DM) + RMS_EPS);
                f32x4 v[8]; float ss = 0.f;
#pragma unroll
                for (int j = 0; j < 8; ++j) { const int k = 4 * lane + 256 * j; const f32x4 xv = ldbf4(XR + (size_t)row * DM + k), yv = y[j], gg = *(const f32x4*)(gpost + k), gt = *(const f32x4*)(mrow + 5 * DM + k);
                    v[j] = xv + gt * (yv * rsy * gg); ss += pg8::dot4(v[j]); if (l == 0) stbf4(XR + (size_t)row * DM + k, v[j]); else *(f32x4*)((float*)INP(29) + (size_t)row * DM + k) = v[j]; }
                if (l == 0) {
                    const float rs = 1.0f / sqrtf(wave_sum(ss) * (1.0f / DM) + RMS_EPS);
#pragma unroll
                    for (int j = 0; j < 8; ++j) { const int k = 4 * lane + 256 * j; const f32x4 gg = *(const f32x4*)(gnext + k), sh = *(const f32x4*)(mnext + k), sc = *(const f32x4*)(mnext + DM + k);
                        const f32x4 hh = v[j] * rs * gg * (sc + 1.0f) + sh; u32x2 w; w.x = cvt_pk_bf16(hh[0], hh[1]); w.y = cvt_pk_bf16(hh[2], hh[3]); *(u32x2*)(Hb + (size_t)row * DM + k) = w; }
                }
            }
        }
        if (l == 0) { xcd_barrier(xb); STAMP(); }
    }
#if PROBE_MULT
    STAMP();
    if (bx0 == 0 && threadIdx.x == 0) { const unsigned long long q1 = (stamps[PROBE_B1] - stamps[PROBE_B0] + PROBE_UNIT / 2) / PROBE_UNIT, q2 = (stamps[PROBE_C1] - stamps[PROBE_C0] + PROBE_UNIT / 2) / PROBE_UNIT; const unsigned long long d = (q1 > 99 ? 99 : q1) * 400000ull + (q2 > 99 ? 99 : q2) * 4000ull, t0 = __builtin_amdgcn_s_memrealtime(); while (__builtin_amdgcn_s_memrealtime() - t0 < d) __builtin_amdgcn_s_sleep(8); }
#endif
}

extern "C" void kernel_launch(void* const* d_in, const int* in_sizes, int n_in, void* d_out, int out_size, void* d_ws, size_t ws_size, hipStream_t stream) {
    static int grid = 0;
    if (grid == 0) {
        if (n_in != 29 || out_size != NLAT * DM || ws_size < WS_NEED) { fprintf(stderr, "kernel_launch: unexpected shapes: n_in %d out %d ws %zu\n", n_in, out_size, ws_size); grid = -1; return; }
        int dev = 0, cus = 0, per_cu = 0;
        (void)hipGetDevice(&dev); (void)hipDeviceGetAttribute(&cus, hipDeviceAttributeMultiprocessorCount, dev);
        (void)hipFuncSetAttribute((const void*)fwd_mega, hipFuncAttributeMaxDynamicSharedMemorySize, LDS_BYTES);
        (void)hipOccupancyMaxActiveBlocksPerMultiprocessor(&per_cu, (const void*)fwd_mega, 512, LDS_BYTES);
        if (per_cu < 1) { fprintf(stderr, "kernel_launch: occupancy query reports %d blocks per CU\n", per_cu); }
        grid = cus;
    }
    if (grid < 0) return;
    if (hipMemsetAsync((unsigned char*)d_ws + S_CTL, 0, (size_t)CW_END * 4, stream) != hipSuccess) { fprintf(stderr, "kernel_launch: hipMemsetAsync of the control words failed\n"); return; }
    Params p{};
    for (int i = 0; i < 29; ++i) p.in[i] = (const float*)d_in[i];
    p.out = (float*)d_out; p.ws = (unsigned char*)d_ws;
    void* args[] = {&p};
    hipError_t e = hipLaunchCooperativeKernel((const void*)fwd_mega, dim3(grid), dim3(512), args, LDS_BYTES, stream);
    if (e != hipSuccess) fprintf(stderr, "cooperative launch failed: %s (grid %d)\n", hipGetErrorString(e), grid);
}
```

```cpp
#include <hip/hip_runtime.h>
#include <hip/hip_cooperative_groups.h>
#include <cstdio>
#include <cstdint>
namespace cg = cooperative_groups;

#define LAS __attribute__((address_space(3)))
typedef unsigned short bf16_t;
typedef short bf16x8 __attribute__((ext_vector_type(8)));
typedef short s16x4 __attribute__((ext_vector_type(4)));
typedef float f32x4 __attribute__((ext_vector_type(4)));
typedef float f32x2 __attribute__((ext_vector_type(2)));
typedef float f32x16 __attribute__((ext_vector_type(16)));
typedef unsigned u32x4 __attribute__((ext_vector_type(4)));
typedef unsigned u32x2 __attribute__((ext_vector_type(2)));

constexpr int DM = 2048, NBATCH = 4, SEQ = 2048, CTXL = 256, NLAT = NBATCH * SEQ, NCTX = NBATCH * CTXL, TOK = NLAT + NCTX;
constexpr int INC = 4416, HYW = 512, QLORA = 768, KVLORA = 512, FF = 5632, ADA = 6 * DM;
constexpr int PRW = 3072;
constexpr int PR_KR = 1280, PR_NAQ = 1344, PR_NAK = 1856, PR_NAV = 2368;
constexpr float RMS_EPS = 1e-6f;
constexpr float MLA_SCALE = 0.07216878364870322f;
constexpr float NA_SCALE = 0.08838834764831845f;

constexpr size_t MiB = 1u << 20;
constexpr size_t WL_STRIDE = 98 * MiB;
constexpr size_t W_INR = 0, W_INH = 12 * MiB, W_UQ = 18 * MiB, W_UKV = 21 * MiB, W_OUT = 23 * MiB, W_GU = 31 * MiB, W_DN = 75 * MiB;
constexpr size_t A_H = 196 * MiB, A_YC = 232 * MiB, A_YF = 268 * MiB, A_XR = 340 * MiB, A_PR = 412 * MiB, A_PT = 466 * MiB, A_Q = 493 * MiB, A_KV = 520 * MiB, A_ACT = 412 * MiB;
constexpr size_t S_MOD = 556 * MiB, S_ROPE = 557 * MiB, S_SSQ = 558 * MiB, S_SSQY = 559 * MiB, S_FILT = 561 * MiB, S_FILTC = 578 * MiB, S_CTL = 580 * MiB, S_H2T = 581 * MiB, A_YH = 583 * MiB, A_YP = 593 * MiB, A_XB = 626 * MiB, WS_NEED = 631 * MiB;
constexpr int FLEN = 2 * SEQ + 64, FLENC = 2 * CTXL + 64;

constexpr int LDS_BYTES = 147456 + 64;
#ifndef PHMASK
#define PHMASK 0xFFFFFFFFu
#endif
#define PH(n) ((PHMASK >> (n)) & 1u)
#ifndef PROBE_MULT
#define PROBE_MULT 0
#define PROBE_B0 0
#define PROBE_B1 1
#define PROBE_C0 0
#define PROBE_C1 1
#endif
#ifndef PROBE_UNIT
#define PROBE_UNIT 400
#endif
#ifndef PROBE_EXP
#define PROBE_EXP 0
#endif
#ifndef PROBE_SUB
#define PROBE_SUB 0
#endif

__device__ __forceinline__ unsigned cvt_pk_bf16(float lo, float hi) { unsigned r; asm volatile("v_cvt_pk_bf16_f32 %0, %1, %2" : "=v"(r) : "v"(lo), "v"(hi)); return r; }
__device__ __forceinline__ bf16_t f2bf(float f) { return (bf16_t)(cvt_pk_bf16(f, 0.f) & 0xffffu); }
__device__ __forceinline__ float bf2f(bf16_t h) { return __uint_as_float(((unsigned)h) << 16); }
__device__ __forceinline__ f32x4 ldbf4(const bf16_t* p) { const u32x2 w = *(const u32x2*)p; return (f32x4){__uint_as_float(w.x << 16), __uint_as_float(w.x & 0xffff0000u), __uint_as_float(w.y << 16), __uint_as_float(w.y & 0xffff0000u)}; }
__device__ __forceinline__ void stbf4(bf16_t* p, f32x4 v) { u32x2 w; w.x = cvt_pk_bf16(v[0], v[1]); w.y = cvt_pk_bf16(v[2], v[3]); *(u32x2*)p = w; }
__device__ __forceinline__ float wave_sum(float v) {
#pragma unroll
    for (int o = 1; o < 64; o <<= 1) v += __shfl_xor(v, o);
    return v;
}

constexpr int CW_TMO = 4096, CW_XCH = 8192, CW_END = CW_XCH + 8 * 32 * 64;
#define RLX_AGENT __ATOMIC_RELAXED, __HIP_MEMORY_SCOPE_AGENT
__device__ __forceinline__ void st16f_wt(void* p, f32x4 v) { asm volatile("global_store_dwordx4 %0, %1, off sc1\n\ts_nop 1" :: "v"(p), "v"(v) : "memory"); }
constexpr int CW_HY = 4416;
constexpr int CW_ROWS = 4160;
__device__ __forceinline__ void st8_wt(void* p, u32x2 v) { asm volatile("global_store_dwordx2 %0, %1, off sc1\n\ts_nop 1" :: "v"(p), "v"(v) : "memory"); }
__device__ __forceinline__ void wave_arrive(unsigned* c) { asm volatile("s_waitcnt vmcnt(0)" ::: "memory"); if ((threadIdx.x & 63) == 0) __hip_atomic_fetch_add(c, 1u, RLX_AGENT); }
__device__ __forceinline__ void wave_wait_cnt(const unsigned* c, unsigned need, unsigned* tmo) {
    unsigned polls = 0;
    while ((unsigned)__builtin_amdgcn_readfirstlane(__hip_atomic_load(c, RLX_AGENT)) < need) {
        if ((++polls & 255u) == 0u) { if (__builtin_amdgcn_readfirstlane(__hip_atomic_load(tmo, RLX_AGENT)) != 0u) break; if (polls > (1u << 21)) { if ((threadIdx.x & 63) == 0) __hip_atomic_store(tmo, 1u, RLX_AGENT); break; } }
        __builtin_amdgcn_s_sleep(2); }
}
__device__ __forceinline__ f32x4 ld16_sc1(const void* p) { f32x4 v; asm volatile("global_load_dwordx4 %0, %1, off sc1\n\ts_waitcnt vmcnt(0)" : "=&v"(v) : "v"(p) : "memory"); return v; }

namespace pg8 {
constexpr int BM = 256, BK = 64, HALF = 128, HTB = HALF * BK * 2, STAGE_BYTES = 8 * HTB, NXCD = 8, WGM = 8;
__host__ __device__ __forceinline__ int lds_byte(int r, int c) { const int st = (r >> 4) * 2 + (c >> 5), rr = r & 15, cc = c & 31, ob = rr * 64 + cc * 2; return st * 1024 + (ob ^ (((ob >> 9) & 1) << 5)); }
__host__ __device__ __forceinline__ void stage_rc(int b, int& R, int& C) { const int st = b / 1024, sb = b % 1024, swz = sb ^ (((sb >> 9) & 1) << 5); R = (st >> 1) * 16 + swz / 64; C = (st & 1) * 32 + (swz % 64) / 2; }
__host__ __device__ __forceinline__ int perm32(int rho) { const int n = rho >> 4, i = rho & 15; return 8 * (i >> 2) + 4 * n + (i & 3); }

struct Unit { int pm, pn, koff; };
struct Gemm { const bf16_t* A; const bf16_t* Bt; int M, N, K, lda, ldb; };

struct StaticOrder {
    int nM, nN, nwg, G, c;
    __host__ __device__ void init(int M, int N, int G_, int c_) { nM = M / BM; nN = N / BM; nwg = nM * nN; G = G_; c = c_; }
    __host__ __device__ bool next(int i, Unit& u) const {
        const long L = (long)i * G + c; if (L >= nwg) return false;
        int wgid = (int)L; { const int q = nwg / NXCD, r = nwg % NXCD, xcd = wgid % NXCD, off = wgid / NXCD; wgid = (xcd < r ? xcd * (q + 1) : r * (q + 1) + (xcd - r) * q) + off; }
        const int nig = WGM * nN, gid = wgid / nig, fm = gid * WGM, gsz = (nM - fm) < WGM ? (nM - fm) : WGM;
        u.pm = fm + ((wgid % nig) % gsz); u.pn = (wgid % nig) / gsz; u.koff = 0; return true;
    }
};

template <class Epi, class Sched, int AUXA = 0>
__device__ __forceinline__ void gemm_phase(LAS unsigned char* lds, const Gemm g, const Sched& S, const Epi& E) {
    int tid = threadIdx.x; asm volatile("" : "+v"(tid));
    const int wid = __builtin_amdgcn_readfirstlane(tid >> 6), lane = tid & 63, wr = wid >> 2, wc = wid & 3, fr = lane & 15, fq = lane >> 4;
    const int K = g.K, nt = K / BK;
    unsigned voffA[2], voffB[2];
#pragma unroll
    for (int i = 0; i < 2; ++i) { int R, C; stage_rc(tid * 16 + i * 8192, R, C); const int Rb = Epi::PERM ? ((R & ~31) + perm32(R & 31)) : R;
        voffA[i] = (unsigned)(R * g.lda + C) * 2u; voffB[i] = (unsigned)(Rb * g.ldb + C) * 2u; }
    const size_t kstep = (size_t)(BK * 2);
    const size_t hstepA = (size_t)HALF * g.lda * 2, hstepB = (size_t)HALF * g.ldb * 2;
    const size_t tstepA = 2 * hstepA, tstepB = 2 * hstepB;
    const unsigned ldsw = (unsigned)wid * 1024u;
    const int aoff = lds_byte(wr * 64 + fr, fq * 8), boff = lds_byte(wc * 32 + fr, fq * 8);
#define PG8_SA(b, h) (((b) * 2 + (h)) * HTB)
#define PG8_SB(b, h) ((4 + (b) * 2 + (h)) * HTB)
#define PG8_STAGE_X(bufoff, gbase, voff, aux) do { _Pragma("unroll") for (int _i = 0; _i < 2; ++_i) \
        __builtin_amdgcn_global_load_lds((const unsigned*)((const char*)(gbase) + (voff)[_i]), (LAS unsigned*)(lds + (bufoff) + ldsw + _i * 8192), 16, 0, aux); } while (0)
#define PG8_STAGE(bufoff, gbase, voff) do { if (&(voff) == &voffA) PG8_STAGE_X(bufoff, gbase, voff, AUXA); else PG8_STAGE_X(bufoff, gbase, voff, 0); } while (0)
#define PG8_LDA(dst, b, h) do { _Pragma("unroll") for (int m = 0; m < 4; ++m) _Pragma("unroll") for (int k = 0; k < 2; ++k) dst[m][k] = *(const LAS bf16x8*)(lds + PG8_SA(b, h) + aoff + m * 2048 + k * 1024); } while (0)
#define PG8_LDB(dst, b, h) do { _Pragma("unroll") for (int n = 0; n < 2; ++n) _Pragma("unroll") for (int k = 0; k < 2; ++k) dst[n][k] = *(const LAS bf16x8*)(lds + PG8_SB(b, h) + boff + n * 2048 + k * 1024); } while (0)
#define PG8_MMA(ai, bj, At, Bt) do { __builtin_amdgcn_s_setprio(1); _Pragma("unroll") for (int m = 0; m < 4; ++m) _Pragma("unroll") for (int n = 0; n < 2; ++n) _Pragma("unroll") for (int k = 0; k < 2; ++k) \
        acc[ai][bj][m][n] = __builtin_amdgcn_mfma_f32_16x16x32_bf16(Bt[n][k], At[m][k], acc[ai][bj][m][n], 0, 0, 0); __builtin_amdgcn_s_setprio(0); } while (0)
#define PG8_WAIT_V(n) asm volatile("s_waitcnt vmcnt(" #n ")" ::: "memory")
#define PG8_WAIT_L(n) asm volatile("s_waitcnt lgkmcnt(" #n ")" ::: "memory")
#define PG8_BAR __builtin_amdgcn_s_barrier()
#define PG8_SCHED __builtin_amdgcn_sched_barrier(0)
    Unit cur, nxt; int ui = 0;
    if (!S.next(0, cur)) return;
    f32x4 acc[2][2][4][2];
#pragma unroll
    for (int a = 0; a < 2; ++a)
#pragma unroll
        for (int b = 0; b < 2; ++b)
#pragma unroll
            for (int m = 0; m < 4; ++m)
#pragma unroll
                for (int n = 0; n < 2; ++n) acc[a][b][m][n] = (f32x4){0.f, 0.f, 0.f, 0.f};
    bf16x8 At[4][2], B0[2][2], B1[2][2];
    const char* cA = (const char*)g.A + (size_t)cur.pm * tstepA + (size_t)cur.koff * 2; const char* cB = (const char*)g.Bt + (size_t)cur.pn * tstepB + (size_t)cur.koff * 2;
    PG8_STAGE(PG8_SB(0, 0), cB, voffB); PG8_STAGE(PG8_SB(0, 1), cB + hstepB, voffB); PG8_STAGE(PG8_SA(0, 0), cA, voffA); PG8_STAGE(PG8_SA(0, 1), cA + hstepA, voffA);
    if (wr == 1) PG8_BAR;
    PG8_WAIT_V(2); PG8_BAR;
    PG8_STAGE(PG8_SB(1, 0), cB + kstep, voffB); PG8_STAGE(PG8_SA(1, 0), cA + kstep, voffA); PG8_STAGE(PG8_SB(1, 1), cB + hstepB + kstep, voffB);
    PG8_WAIT_V(6); PG8_BAR;
    for (;;) {
        const bool has_next = S.next(ui + 1, nxt);
        const char* nA = has_next ? (const char*)g.A + (size_t)nxt.pm * tstepA + (size_t)nxt.koff * 2 : cA; const char* nB = has_next ? (const char*)g.Bt + (size_t)nxt.pn * tstepB + (size_t)nxt.koff * 2 : cB;
        for (int t = 0; t < nt; t += 2) {
            const bool last = (t == nt - 2);
            const char* a1 = cA + (size_t)(t + 1) * kstep;
            const char* a2 = last ? nA : cA + (size_t)(t + 2) * kstep; const char* b2 = last ? nB : cB + (size_t)(t + 2) * kstep;
            const char* a3 = a2 + kstep; const char* b3 = b2 + kstep;
            PG8_LDB(B0, 0, 0); PG8_LDB(B1, 0, 1); PG8_SCHED; PG8_LDA(At, 0, 0); PG8_STAGE(PG8_SA(1, 1), a1 + hstepA, voffA);
            PG8_WAIT_V(8); PG8_WAIT_L(0); PG8_BAR; PG8_MMA(0, 0, At, B0); PG8_MMA(0, 1, At, B1); PG8_BAR; PG8_SCHED;
            PG8_LDA(At, 0, 1); PG8_STAGE(PG8_SB(0, 0), b2, voffB); PG8_STAGE(PG8_SB(0, 1), b2 + hstepB, voffB); PG8_STAGE(PG8_SA(0, 0), a2, voffA);
            PG8_WAIT_V(8); PG8_WAIT_L(0); PG8_BAR; PG8_MMA(1, 0, At, B0); PG8_MMA(1, 1, At, B1); PG8_BAR; PG8_SCHED;
            PG8_LDB(B0, 1, 0); PG8_LDB(B1, 1, 1); PG8_SCHED; PG8_LDA(At, 1, 0); PG8_STAGE(PG8_SA(0, 1), a2 + hstepA, voffA);
            PG8_WAIT_V(8); PG8_WAIT_L(0); PG8_BAR; PG8_MMA(0, 0, At, B0); PG8_MMA(0, 1, At, B1); PG8_BAR; PG8_SCHED;
            PG8_LDA(At, 1, 1); PG8_STAGE(PG8_SB(1, 0), b3, voffB); PG8_STAGE(PG8_SB(1, 1), b3 + hstepB, voffB); PG8_STAGE(PG8_SA(1, 0), a3, voffA);
            PG8_WAIT_V(8); PG8_WAIT_L(0); PG8_BAR; PG8_MMA(1, 0, At, B0); PG8_MMA(1, 1, At, B1); PG8_BAR; PG8_SCHED;
        }
        if (wr == 0) PG8_BAR;
        if constexpr (!Epi::AFTER_DRAIN) E(acc, cur, wr, wc, fr, fq);
        if (!has_next) break;
#pragma unroll
        for (int a = 0; a < 2; ++a)
#pragma unroll
            for (int b = 0; b < 2; ++b)
#pragma unroll
                for (int m = 0; m < 4; ++m)
#pragma unroll
                    for (int n = 0; n < 2; ++n) acc[a][b][m][n] = (f32x4){0.f, 0.f, 0.f, 0.f};
        cur = nxt; cA = nA; cB = nB; ++ui;
        if (wr == 1) PG8_BAR;
    }
    PG8_WAIT_V(0);
    PG8_BAR;
    if constexpr (Epi::AFTER_DRAIN) E.fused(acc, cur, wr, wc, fr, fq, lds, wid, lane);
#undef PG8_SA
#undef PG8_SB
#undef PG8_STAGE
#undef PG8_STAGE_X
#undef PG8_LDA
#undef PG8_LDB
#undef PG8_MMA
#undef PG8_WAIT_V
#undef PG8_WAIT_L
#undef PG8_BAR
#undef PG8_SCHED
}

__device__ __forceinline__ float dot4(f32x4 v) { return (v[0] * v[0] + v[1] * v[1]) + (v[2] * v[2] + v[3] * v[3]); }
__device__ __forceinline__ void rope4(f32x4& v, const float* rope_row, int i0) {
    const f32x4 cs = *(const f32x4*)(rope_row + 2 * i0);
    const float a0 = v[0] * cs[0] - v[1] * cs[1], b0 = v[1] * cs[0] + v[0] * cs[1];
    const float a1 = v[2] * cs[2] - v[3] * cs[3], b1 = v[3] * cs[2] + v[2] * cs[3];
    v = (f32x4){a0, b0, a1, b1};
}
__device__ __forceinline__ u32x4 pack8(f32x4 v0, f32x4 v1) { u32x4 w; w.x = cvt_pk_bf16(v0[0], v0[1]); w.y = cvt_pk_bf16(v0[2], v0[3]); w.z = cvt_pk_bf16(v1[0], v1[1]); w.w = cvt_pk_bf16(v1[2], v1[3]); return w; }

struct EpiBf16 {
    static constexpr bool PERM = true, AFTER_DRAIN = false;
    bf16_t* O; int ldc;
    __device__ __forceinline__ void operator()(const f32x4 (&acc)[2][2][4][2], const Unit& u, int wr, int wc, int fr, int fq) const {
        const int row0 = u.pm * BM + wr * 64 + fr, col0 = u.pn * BM + wc * 32 + 8 * fq;
#pragma unroll
        for (int ai = 0; ai < 2; ++ai)
#pragma unroll
            for (int m = 0; m < 4; ++m) { bf16_t* rowp = O + (size_t)(row0 + ai * HALF + m * 16) * ldc + col0;
#pragma unroll
                for (int bj = 0; bj < 2; ++bj) *(u32x4*)(rowp + bj * HALF) = pack8(acc[ai][bj][m][0], acc[ai][bj][m][1]); }
    }
};
struct EpiPR {
    static constexpr bool PERM = true, AFTER_DRAIN = false;
    bf16_t* O; float* ssq; const float* rope;
    __device__ __forceinline__ void operator()(const f32x4 (&acc)[2][2][4][2], const Unit& u, int wr, int wc, int fr, int fq) const {
        const int row0 = u.pm * BM + wr * 64 + fr, col0 = u.pn * BM + wc * 32 + 8 * fq;
        const bool dorope = (u.pn == 5) && (wc < 2);
#pragma unroll
        for (int ai = 0; ai < 2; ++ai)
#pragma unroll
            for (int m = 0; m < 4; ++m) { const int row = row0 + ai * HALF + m * 16; bf16_t* rowp = O + (size_t)row * PRW + col0; float ss = 0.f;
#pragma unroll
                for (int bj = 0; bj < 2; ++bj) { f32x4 v0 = acc[ai][bj][m][0], v1 = acc[ai][bj][m][1];
                    if (bj == 0 && dorope && row < NLAT) { const float* rr = rope + (size_t)(row & (SEQ - 1)) * 64; const int i0 = 16 * wc + 4 * fq; rope4(v0, rr, i0); rope4(v1, rr, i0 + 2); }
                    ss += dot4(v0) + dot4(v1);
                    *(u32x4*)(rowp + bj * HALF) = pack8(v0, v1); }
                if (u.pn < 5) { ss += __shfl_xor(ss, 16); ss += __shfl_xor(ss, 32); if (fq == 0) ssq[(size_t)row * 20 + u.pn * 4 + wc] = ss; }
                asm volatile("" ::: "memory"); }
    }
};
struct EpiQ {
    static constexpr bool PERM = true, AFTER_DRAIN = false;
    bf16_t* O; const float* ssq; const float* rope;
    __device__ __forceinline__ void operator()(const f32x4 (&acc)[2][2][4][2], const Unit& u, int wr, int wc, int fr, int fq) const {
        const int row0 = u.pm * BM + wr * 64 + fr, col0 = u.pn * BM + wc * 32 + 8 * fq;
#pragma unroll
        for (int ai = 0; ai < 2; ++ai)
#pragma unroll
            for (int m = 0; m < 4; ++m) { const int row = row0 + ai * HALF + m * 16; bf16_t* rowp = O + (size_t)row * 1536 + col0;
                const f32x4* sp = (const f32x4*)(ssq + (size_t)row * 20); const f32x4 s0 = sp[0], s1 = sp[1], s2 = sp[2];
                const float tot = ((s0[0] + s0[1]) + (s0[2] + s0[3])) + ((s1[0] + s1[1]) + (s1[2] + s1[3])) + ((s2[0] + s2[1]) + (s2[2] + s2[3]));
                const float rs = 1.0f / sqrtf(tot * (1.0f / QLORA) + RMS_EPS);
#pragma unroll
                for (int bj = 0; bj < 2; ++bj) { f32x4 v0 = acc[ai][bj][m][0] * rs, v1 = acc[ai][bj][m][1] * rs;
                    const int j0 = (col0 + bj * HALF) % 192;
                    if (j0 >= 128 && row < NLAT) { const float* rr = rope + (size_t)(row & (SEQ - 1)) * 64; const int i0 = (j0 - 128) >> 1; rope4(v0, rr, i0); rope4(v1, rr, i0 + 2); }
                    *(u32x4*)(rowp + bj * HALF) = pack8(v0, v1); }
                asm volatile("" ::: "memory"); }
    }
};
struct EpiKV {
    static constexpr bool PERM = true, AFTER_DRAIN = false;
    bf16_t* O; const float* ssq;
    __device__ __forceinline__ void operator()(const f32x4 (&acc)[2][2][4][2], const Unit& u, int wr, int wc, int fr, int fq) const {
        const int row0 = u.pm * BM + wr * 64 + fr, col0 = u.pn * BM + wc * 32 + 8 * fq;
#pragma unroll
        for (int ai = 0; ai < 2; ++ai)
#pragma unroll
            for (int m = 0; m < 4; ++m) { const int row = row0 + ai * HALF + m * 16; bf16_t* rowp = O + (size_t)row * 2048 + col0;
                const f32x4* sp = (const f32x4*)(ssq + (size_t)row * 20 + 12); const f32x4 s0 = sp[0], s1 = sp[1];
                const float tot = ((s0[0] + s0[1]) + (s0[2] + s0[3])) + ((s1[0] + s1[1]) + (s1[2] + s1[3]));
                const float rs = 1.0f / sqrtf(tot * (1.0f / KVLORA) + RMS_EPS);
#pragma unroll
                for (int bj = 0; bj < 2; ++bj) *(u32x4*)(rowp + bj * HALF) = pack8(acc[ai][bj][m][0] * rs, acc[ai][bj][m][1] * rs);
                asm volatile("" ::: "memory"); }
    }
};
struct EpiF32S {
    static constexpr bool PERM = true, AFTER_DRAIN = false;
    bf16_t* C; float* ssq;
    __device__ __forceinline__ void operator()(const f32x4 (&acc)[2][2][4][2], const Unit& u, int wr, int wc, int fr, int fq) const {
        const int row0 = u.pm * BM + wr * 64 + fr, col0 = u.pn * BM + wc * 32 + 8 * fq;
#pragma unroll
        for (int ai = 0; ai < 2; ++ai)
#pragma unroll
            for (int m = 0; m < 4; ++m) { const int row = row0 + ai * HALF + m * 16; bf16_t* rowp = C + (size_t)row * DM + col0; float ss = 0.f;
#pragma unroll
                for (int bj = 0; bj < 2; ++bj) { const f32x4 v0 = acc[ai][bj][m][0], v1 = acc[ai][bj][m][1]; ss += dot4(v0) + dot4(v1); *(u32x4*)(rowp + bj * HALF) = pack8(v0, v1); }
                ss += __shfl_xor(ss, 16); ss += __shfl_xor(ss, 32); if (fq == 0) ssq[(size_t)row * 32 + u.pn * 4 + wc] = ss; }
    }
};
struct EpiSwiGLU {
    static constexpr bool PERM = true, AFTER_DRAIN = false;
    bf16_t* O;
    __device__ __forceinline__ void operator()(const f32x4 (&acc)[2][2][4][2], const Unit& u, int wr, int wc, int fr, int fq) const {
        const int row0 = u.pm * BM + wr * 64 + fr, col0 = u.pn * HALF + wc * 32 + 8 * fq;
#pragma unroll
        for (int ai = 0; ai < 2; ++ai)
#pragma unroll
            for (int m = 0; m < 4; ++m) { bf16_t* rowp = O + (size_t)(row0 + ai * HALF + m * 16) * FF + col0; f32x4 r[2];
#pragma unroll
                for (int n = 0; n < 2; ++n) { const f32x4 gt = acc[ai][0][m][n], up = acc[ai][1][m][n];
#pragma unroll
                    for (int e = 0; e < 4; ++e) { const float sg = __builtin_amdgcn_rcpf(1.0f + __builtin_amdgcn_exp2f(-1.4426950408889634f * gt[e])); r[n][e] = gt[e] * sg * up[e]; } }
                *(u32x4*)rowp = pack8(r[0], r[1]); }
    }
};
struct RowExchange { f32x4* slots; unsigned* cnt; unsigned* tmo; unsigned long long* dbg; };
template <bool XF32, bool SECOND>
struct EpiNormRes {
    static constexpr bool PERM = true, AFTER_DRAIN = true;
    const float* xf; const bf16_t* xb;
    const float* gpost; const float* gate;
    const float* g2; const float* shift2; const float* scale2;
    bf16_t* XRo; bf16_t* Ho; float* outf;
    RowExchange x1;
    __device__ __forceinline__ f32x4 ldx(unsigned o) const { if constexpr (XF32) return *(const f32x4*)(xf + o); else return ldbf4(xb + o); }
    __device__ __forceinline__ void fused(f32x4 (&acc)[2][2][4][2], const Unit& u, int wr, int wc, int fr, int fq, LAS unsigned char* lds, int wid, int lane) const {
        LAS f32x4* P = (LAS f32x4*)lds; LAS f32x2* S = (LAS f32x2*)lds;
        LAS u32x4* ST = (LAS u32x4*)(lds + 16384) + (wid * 64 + lane);
#define DBGS(i) do { if (x1.dbg && blockIdx.x == 0 && threadIdx.x == 0) x1.dbg[i] = __builtin_amdgcn_s_memrealtime(); } while (0)
        DBGS(0);
        const int b = u.pm >> 3, col0 = u.pn * BM + wc * 32 + 8 * fq;
        const float* gt = gate + (size_t)b * ADA;
        f32x4 G[2][2];
#pragma unroll
        for (int bj = 0; bj < 2; ++bj)
#pragma unroll
            for (int n = 0; n < 2; ++n) { const int cc = col0 + bj * HALF + n * 4; G[bj][n] = *(const f32x4*)(gpost + cc) * *(const f32x4*)(gt + cc); }
        f32x4 xl[2][2][2][2];
#define NR_LOAD(SET, AM) do { _Pragma("unroll") for (int mm = 0; mm < 2; ++mm) { const unsigned off_ = (unsigned)(u.pm * BM + ((AM) >> 1) * HALF + wr * 64 + (((AM) & 1) * 2 + mm) * 16 + fr) * DM + col0; \
            _Pragma("unroll") for (int bj = 0; bj < 2; ++bj) _Pragma("unroll") for (int n = 0; n < 2; ++n) xl[SET][mm][bj][n] = ldx(off_ + bj * HALF + n * 4); } } while (0)
        NR_LOAD(0, 0);
#pragma unroll
        for (int am = 0; am < 4; ++am) { const int ai = am >> 1, m0 = (am & 1) * 2;
            if (am + 1 < 4) NR_LOAD((am + 1) & 1, am + 1);
#pragma unroll
            for (int mm = 0; mm < 2; ++mm) { const int m = m0 + mm; f32x4 s = {0.f, 0.f, 0.f, 0.f};
#pragma unroll
                for (int bj = 0; bj < 2; ++bj)
#pragma unroll
                    for (int n = 0; n < 2; ++n) { const f32x4 y = acc[ai][bj][m][n], x = xl[am & 1][mm][bj][n], gy = G[bj][n] * y; acc[ai][bj][m][n] = gy;
                        s[0] += dot4(y); s[1] += dot4(x); s[2] += (x[0] * gy[0] + x[1] * gy[1]) + (x[2] * gy[2] + x[3] * gy[3]); s[3] += dot4(gy); }
                if constexpr (!XF32) {
#pragma unroll
                    for (int bj = 0; bj < 2; ++bj) ST[((am * 2 + mm) * 2 + bj) * 512] = pack8(xl[am & 1][mm][bj][0], xl[am & 1][mm][bj][1]); }
                else if (am < 2) {
#pragma unroll
                    for (int bj = 0; bj < 2; ++bj)
#pragma unroll
                        for (int n = 0; n < 2; ++n) ((LAS f32x4*)ST)[(((am * 2 + mm) * 2 + bj) * 2 + n) * 512] = xl[am & 1][mm][bj][n]; }
#pragma unroll
                for (int e = 0; e < 4; ++e) { s[e] += __shfl_xor(s[e], 16); s[e] += __shfl_xor(s[e], 32); }
                if (fq == 0) P[(ai * HALF + wr * 64 + m * 16 + fr) * 4 + wc] = s; } }
#undef NR_LOAD
        asm volatile("s_waitcnt lgkmcnt(0)" ::: "memory"); __builtin_amdgcn_s_barrier(); asm volatile("" ::: "memory");
        DBGS(1);
        const int row = wid * 64 + lane;
        if (row < 256) { const f32x4 tot = (P[row * 4 + 0] + P[row * 4 + 1]) + (P[row * 4 + 2] + P[row * 4 + 3]); st16f_wt(x1.slots + ((size_t)u.pm * 256 + row) * 8 + u.pn, tot); }
        asm volatile("s_waitcnt vmcnt(0)" ::: "memory");
        if (lane == 0) __hip_atomic_fetch_add(x1.cnt + 64 * u.pm, 1u, RLX_AGENT);
        int fr2 = fr, fq2 = fq; asm volatile("" : "+v"(fr2), "+v"(fq2)); const int col2 = u.pn * BM + wc * 32 + 8 * fq2;
        LAS u32x4* ST2 = (LAS u32x4*)(lds + 16384) + (wid * 64 + fq2 * 16 + fr2);
        const float* sh = shift2 + (size_t)b * ADA; const float* sc = scale2 + (size_t)b * ADA;
        f32x4 gg[2][2], shv[2][2], scv[2][2];
        if constexpr (SECOND) {
#pragma unroll
            for (int bj = 0; bj < 2; ++bj)
#pragma unroll
                for (int n = 0; n < 2; ++n) { const int cc = col2 + bj * HALF + n * 4; gg[bj][n] = *(const f32x4*)(g2 + cc); shv[bj][n] = *(const f32x4*)(sh + cc); scv[bj][n] = *(const f32x4*)(sc + cc); } }
        if (wid == 0) { unsigned polls = 0;
            while ((unsigned)__builtin_amdgcn_readfirstlane(__hip_atomic_load(x1.cnt + 64 * u.pm, RLX_AGENT)) < 64u) {
                if ((++polls & 255u) == 0u) { if (__builtin_amdgcn_readfirstlane(__hip_atomic_load(x1.tmo, RLX_AGENT)) != 0u) break; if (polls > (1u << 21)) { if (lane == 0) __hip_atomic_store(x1.tmo, 1u, RLX_AGENT); break; } }
                __builtin_amdgcn_s_sleep(1); } }
        asm volatile("s_waitcnt vmcnt(0) lgkmcnt(0)" ::: "memory"); __builtin_amdgcn_s_barrier(); asm volatile("" ::: "memory");
        DBGS(2);
        if (row < 256) { const f32x4* sl = x1.slots + ((size_t)u.pm * 256 + row) * 8; f32x4 t0, t1, t2, t3;
            asm volatile("global_load_dwordx4 %0, %4, off sc1\n\tglobal_load_dwordx4 %1, %4, off offset:16 sc1\n\tglobal_load_dwordx4 %2, %4, off offset:32 sc1\n\tglobal_load_dwordx4 %3, %4, off offset:48 sc1\n\ts_waitcnt vmcnt(0)"
                         : "=&v"(t0), "=&v"(t1), "=&v"(t2), "=&v"(t3) : "v"(sl) : "memory");
            f32x4 t = (t0 + t1) + (t2 + t3);
            asm volatile("global_load_dwordx4 %0, %4, off offset:64 sc1\n\tglobal_load_dwordx4 %1, %4, off offset:80 sc1\n\tglobal_load_dwordx4 %2, %4, off offset:96 sc1\n\tglobal_load_dwordx4 %3, %4, off offset:112 sc1\n\ts_waitcnt vmcnt(0)"
                         : "=&v"(t0), "=&v"(t1), "=&v"(t2), "=&v"(t3) : "v"(sl) : "memory");
            t = t + ((t0 + t1) + (t2 + t3));
            const float rsy = __builtin_amdgcn_rsqf(t[0] * (1.0f / DM) + RMS_EPS);
            const float sx2 = t[1] + (rsy + rsy) * t[2] + rsy * rsy * t[3];
            S[row] = (f32x2){rsy, __builtin_amdgcn_rsqf(fmaxf(sx2, 0.f) * (1.0f / DM) + RMS_EPS)}; }
        asm volatile("s_waitcnt lgkmcnt(0)" ::: "memory"); __builtin_amdgcn_s_barrier(); asm volatile("" ::: "memory");
        DBGS(3);
#pragma unroll
        for (int am = 0; am < 4; ++am) { const int ai = am >> 1, m0 = (am & 1) * 2;
            f32x4 x2l[2][2][2];
#pragma unroll
            for (int mm = 0; mm < 2; ++mm) {
                if constexpr (XF32) {
                    if (am < 2) {
#pragma unroll
                        for (int bj = 0; bj < 2; ++bj)
#pragma unroll
                            for (int n = 0; n < 2; ++n) x2l[mm][bj][n] = ((LAS f32x4*)ST2)[(((am * 2 + mm) * 2 + bj) * 2 + n) * 512];
                    } else { const unsigned off = (unsigned)(u.pm * BM + ai * HALF + wr * 64 + (m0 + mm) * 16 + fr2) * DM + col2;
#pragma unroll
                        for (int bj = 0; bj < 2; ++bj)
#pragma unroll
                            for (int n = 0; n < 2; ++n) x2l[mm][bj][n] = ldx(off + bj * HALF + n * 4); }
                } else {
#pragma unroll
                    for (int bj = 0; bj < 2; ++bj) { const u32x4 w = ST2[((am * 2 + mm) * 2 + bj) * 512];
                        x2l[mm][bj][0] = (f32x4){__uint_as_float(w.x << 16), __uint_as_float(w.x & 0xffff0000u), __uint_as_float(w.y << 16), __uint_as_float(w.y & 0xffff0000u)};
                        x2l[mm][bj][1] = (f32x4){__uint_as_float(w.z << 16), __uint_as_float(w.z & 0xffff0000u), __uint_as_float(w.w << 16), __uint_as_float(w.w & 0xffff0000u)}; } } }
#pragma unroll
            for (int mm = 0; mm < 2; ++mm) { const int m = m0 + mm; const int r = ai * HALF + wr * 64 + m * 16 + fr2; const f32x2 st = S[r]; const unsigned off = (unsigned)(u.pm * BM + r) * DM + col2;
#pragma unroll
                for (int bj = 0; bj < 2; ++bj) { const unsigned o2 = off + bj * HALF;
                    const f32x4 xn0 = x2l[mm][bj][0] + acc[ai][bj][m][0] * st.x, xn1 = x2l[mm][bj][1] + acc[ai][bj][m][1] * st.x;
                    if constexpr (SECOND) { *(u32x4*)(XRo + o2) = pack8(xn0, xn1); *(u32x4*)(Ho + o2) = pack8(xn0 * st.y * gg[bj][0] * (scv[bj][0] + 1.0f) + shv[bj][0], xn1 * st.y * gg[bj][1] * (scv[bj][1] + 1.0f) + shv[bj][1]); }
                    else { *(f32x4*)(outf + o2) = xn0; *(f32x4*)(outf + o2 + 4) = xn1; } } }
            asm volatile("" ::: "memory"); }
        asm volatile("s_waitcnt lgkmcnt(0)" ::: "memory"); __builtin_amdgcn_s_barrier(); asm volatile("" ::: "memory");
        DBGS(4);
#undef DBGS
    }
};
struct CtxUnitOrder { int idx, nN, pn0; __device__ bool next(int i, Unit& u) const { if (i > 0 || idx < 0) return false; u.pm = 32 + idx / nN; u.pn = pn0 + idx % nN; u.koff = 0; return true; } };
struct CtxSplitOrder {
    int c, ksub;
    __device__ bool next(int i, Unit& u) const { if (i > 0 || c >= 128) return false; const int kp = c >> 5, r = c & 31; u.pm = 32 + (r >> 3); u.pn = r & 7; u.koff = kp * ksub; return true; }
};
struct EpiPart {
    static constexpr bool PERM = false, AFTER_DRAIN = false;
    float* P; int ksub;
    __device__ __forceinline__ void operator()(const f32x4 (&acc)[2][2][4][2], const Unit& u, int wr, int wc, int fr, int fq) const {
        const int row0 = u.pm * BM + wr * 64 + fr - NLAT, col0 = u.pn * BM + wc * 32 + 4 * fq; float* base = P + (size_t)(u.koff / ksub) * NCTX * DM;
#pragma unroll
        for (int ai = 0; ai < 2; ++ai)
#pragma unroll
            for (int m = 0; m < 4; ++m) { float* rowp = base + (size_t)(row0 + ai * HALF + m * 16) * DM + col0;
#pragma unroll
                for (int bj = 0; bj < 2; ++bj)
#pragma unroll
                    for (int n = 0; n < 2; ++n) *(f32x4*)(rowp + bj * HALF + n * 16) = acc[ai][bj][m][n]; }
    }
};
}

namespace att {
constexpr int NW = 8, QBLK = 32, KVBLK = 64;
#define SBAR() __builtin_amdgcn_sched_barrier(0)
__device__ __forceinline__ int crow(int r, int hi) { return (r & 3) + 8 * (r >> 2) + 4 * hi; }
__device__ __forceinline__ int v_st(int k, int c) { const int kk = (k & ~0xC) | ((k & 4) << 1) | ((k & 8) >> 1); return ((kk >> 3) * 4 + (c >> 5)) * 512 + ((kk & 7) * 32 + (c & 31)) * 2; }
__device__ __forceinline__ int v_rd_base(int lane) { return ((lane & 3) << 3) | (((lane >> 2) & 3) << 6) | (((lane >> 4) & 1) << 5) | (((lane >> 5) & 1) << 8); }
constexpr int v_rd_off(int d0, int ks, int half) { return d0 * 512 + ks * 4096 + half * 2048; }
template <int OFF> __device__ __forceinline__ s16x4 tr_read(int vb) { s16x4 r; asm volatile("ds_read_b64_tr_b16 %0, %1 offset:%2" : "=&v"(r) : "v"(vb), "i"(OFF) : "memory"); return r; }
template <int D0> __device__ __forceinline__ void pv_one(f32x16& od, int vb, bf16x8 pa0, bf16x8 pa1, bf16x8 pa2, bf16x8 pa3) {
    const s16x4 l0 = tr_read<v_rd_off(D0, 0, 0)>(vb), h0 = tr_read<v_rd_off(D0, 0, 1)>(vb), l1 = tr_read<v_rd_off(D0, 1, 0)>(vb), h1 = tr_read<v_rd_off(D0, 1, 1)>(vb);
    const s16x4 l2 = tr_read<v_rd_off(D0, 2, 0)>(vb), h2 = tr_read<v_rd_off(D0, 2, 1)>(vb), l3 = tr_read<v_rd_off(D0, 3, 0)>(vb), h3 = tr_read<v_rd_off(D0, 3, 1)>(vb);
    asm volatile("s_waitcnt lgkmcnt(0)" ::: "memory"); SBAR();
#define PKV(L, H) (bf16x8){L[0], L[1], L[2], L[3], H[0], H[1], H[2], H[3]}
    od = __builtin_amdgcn_mfma_f32_32x32x16_bf16(pa0, PKV(l0, h0), od, 0, 0, 0);
    od = __builtin_amdgcn_mfma_f32_32x32x16_bf16(pa1, PKV(l1, h1), od, 0, 0, 0);
    od = __builtin_amdgcn_mfma_f32_32x32x16_bf16(pa2, PKV(l2, h2), od, 0, 0, 0);
    od = __builtin_amdgcn_mfma_f32_32x32x16_bf16(pa3, PKV(l3, h3), od, 0, 0, 0);
#undef PKV
}
__device__ __forceinline__ void pv_d0(f32x16* o, int vb, bf16x8 pa0, bf16x8 pa1, bf16x8 pa2, bf16x8 pa3) {
    pv_one<0>(o[0], vb, pa0, pa1, pa2, pa3); pv_one<1>(o[1], vb, pa0, pa1, pa2, pa3); pv_one<2>(o[2], vb, pa0, pa1, pa2, pa3); pv_one<3>(o[3], vb, pa0, pa1, pa2, pa3);
}
__device__ __forceinline__ void partialSM(f32x16& p0, f32x16& p1, float& m_reg, float& alpha, float C, float thr) {
    float pmax = p0[0];
#pragma unroll
    for (int r = 1; r < 16; ++r) pmax = fmaxf(pmax, p0[r]);
#pragma unroll
    for (int r = 0; r < 16; ++r) pmax = fmaxf(pmax, p1[r]);
    { auto rr = __builtin_amdgcn_permlane32_swap(__float_as_uint(pmax), __float_as_uint(pmax), false, false); pmax = fmaxf(__uint_as_float(rr[0]), __uint_as_float(rr[1])); }
    float mn;
    if (__builtin_expect(__all(pmax - m_reg <= thr), 1)) { mn = m_reg; alpha = 1.f; }
    else { mn = fmaxf(m_reg, pmax); alpha = __builtin_amdgcn_exp2f((m_reg - mn) * C); m_reg = mn; }
    const float mnC = -mn * C;
#pragma unroll
    for (int r = 0; r < 16; ++r) p0[r] = fmaf(p0[r], C, mnC);
#pragma unroll
    for (int r = 0; r < 16; ++r) p1[r] = fmaf(p1[r], C, mnC);
#pragma unroll
    for (int r = 0; r < 16; ++r) p0[r] = __builtin_amdgcn_exp2f(p0[r]);
}
__device__ __forceinline__ void finishSM(f32x16& p0, f32x16& p1, float alpha, float& l_reg, bf16x8& pa0, bf16x8& pa1, bf16x8& pa2, bf16x8& pa3) {
#pragma unroll
    for (int r = 0; r < 16; ++r) p1[r] = __builtin_amdgcn_exp2f(p1[r]);
    float ps = 0;
#pragma unroll
    for (int r = 0; r < 16; ++r) ps += p0[r];
#pragma unroll
    for (int r = 0; r < 16; ++r) ps += p1[r];
    { auto rr = __builtin_amdgcn_permlane32_swap(__float_as_uint(ps), __float_as_uint(ps), false, false); ps = __uint_as_float(rr[0]) + __uint_as_float(rr[1]); }
    l_reg = l_reg * alpha + ps;
#define PK4(P, BASE, OUT) do { unsigned a0 = cvt_pk_bf16(P[BASE + 0], P[BASE + 1]), a1 = cvt_pk_bf16(P[BASE + 2], P[BASE + 3]);   \
    unsigned b0 = cvt_pk_bf16(P[BASE + 4], P[BASE + 5]), b1 = cvt_pk_bf16(P[BASE + 6], P[BASE + 7]);                              \
    auto r0 = __builtin_amdgcn_permlane32_swap(a0, b0, false, false); auto r1 = __builtin_amdgcn_permlane32_swap(a1, b1, false, false); \
    u32x4 w = {r0[0], r1[0], r0[1], r1[1]}; OUT = __builtin_bit_cast(bf16x8, w); } while (0)
    PK4(p0, 0, pa0); PK4(p0, 8, pa1); PK4(p1, 0, pa2); PK4(p1, 8, pa3);
#undef PK4
}

struct Args {
    const bf16_t* Q; int ldq;
    const bf16_t* Kn; int ldk;
    const bf16_t* Kr; int ldkr;
    const bf16_t* V; int ldv;
    bf16_t* O; int ldo;
    int nt, n1, base1, base2;
    float scale;
    int g, rlo; const float* bias;
};

template <int DQK, bool NA, bool PP = false, int EXP = 0>
__device__ __forceinline__ void unit(const Args& a, char* lds) {
    constexpr int ND = DQK / 16, KROW = DQK * 2 + 16, SHM_V = KVBLK * 128 * 2, SHM_K = KVBLK * KROW;
#define KSWZ(row, colB) ((row) * KROW + (colB))
    int tid = threadIdx.x; asm volatile("" : "+v"(tid));
    const int wid = tid >> 6, lane = tid & 63, r32 = lane & 31, hi = lane >> 5;
    char* V_lds = lds; char* K_lds = lds + 2 * SHM_V;
    float* ws = (float*)(lds + 2 * SHM_V + 2 * SHM_K) + wid * 64; float* li_l = ws; float* al_l = ws + 32;
    float* bt = (float*)(lds + 2 * SHM_V + 2 * SHM_K + NW * 256);
    const float C = a.scale * 1.4426950408889634f, thr = 8.0f / a.scale;
    __syncthreads();
    if (NA) { const float inv = 1.0f / a.scale; for (int i = tid; i < 15 * 128; i += 512) { const int c = (i & 127) - 48; bt[i] = (c >= 0 && c < 31) ? a.bias[(i >> 7) * 31 + c] * inv : 0.f; } }
    float m_reg = -1e30f, l_reg = 0; f32x16 o[4] = {}; bf16x8 qr[ND];
    { const bf16_t* Qw = a.Q + (size_t)(wid * QBLK + r32) * a.ldq + hi * 8;
#pragma unroll
      for (int d0 = 0; d0 < ND; ++d0) qr[d0] = *(const bf16x8*)(Qw + d0 * 16); }
    const int sr = tid >> 4, sc = (tid & 15) * 8, vst0 = v_st(sr, sc), vst1 = v_st(32 + sr, sc);
    const int krr = tid >> 3, krc = (tid & 7) * 8;
    const int vb0 = (int)(uintptr_t)V_lds + v_rd_base(lane);
    const int qidx = wid * 32 + r32, qr_row = 4 * a.g + (qidx >> 6), qc = qidx & 63;
    const int r0w = min(max(qr_row - 4, 0), 24), csw = min(max(qc - 8, 0), 48);
    unsigned cmask = 0u;
    if (NA) {
#pragma unroll
        for (int i = 0; i < 16; ++i) { const int kc_ = crow(i, hi); if (kc_ >= csw && kc_ < csw + 16) cmask |= 1u << i; if (kc_ + 32 >= csw && kc_ + 32 < csw + 16) cmask |= 1u << (16 + i); } }
    const float* btl = bt + (4 * hi - qc + 15 + 48);
    bf16x8 vs0, vs1, ks0, ks1, kr0;
#define TOKOF(j) ((j) < a.n1 ? a.base1 + 64 * (j) : a.base2 + 64 * ((j) - a.n1))
#define SLOAD_V(j) do { const int t0_ = TOKOF(j); vs0 = *(const bf16x8*)(a.V + (size_t)(t0_ + sr) * a.ldv + sc); vs1 = *(const bf16x8*)(a.V + (size_t)(t0_ + 32 + sr) * a.ldv + sc); } while (0)
#define SLOAD_K(j) do { const int t0_ = TOKOF(j); ks0 = *(const bf16x8*)(a.Kn + (size_t)(t0_ + sr) * a.ldk + sc); ks1 = *(const bf16x8*)(a.Kn + (size_t)(t0_ + 32 + sr) * a.ldk + sc); \
    if (DQK == 192) kr0 = *(const bf16x8*)(a.Kr + (size_t)(t0_ + krr) * a.ldkr + krc); } while (0)
#define SLOAD(j) do { SLOAD_V(j); SLOAD_K(j); } while (0)
#define SWRITE_V(b) do { *(bf16x8*)(V_lds + (b) * SHM_V + vst0) = vs0; *(bf16x8*)(V_lds + (b) * SHM_V + vst1) = vs1; } while (0)
#define SWRITE_K(b) do { *(bf16x8*)(K_lds + (b) * SHM_K + KSWZ(sr, sc * 2)) = ks0; *(bf16x8*)(K_lds + (b) * SHM_K + KSWZ(32 + sr, sc * 2)) = ks1; \
    if (DQK == 192) *(bf16x8*)(K_lds + (b) * SHM_K + KSWZ(krr, 256 + krc * 2)) = kr0; } while (0)
#define SWRITE(b) do { SWRITE_V(b); SWRITE_K(b); } while (0)
#define KFR(B0, B1, d0) do { const int cb = ((d0) * 16 + hi * 8) * 2; B0 = *(const bf16x8*)(Ks_ + KSWZ(r32, cb)); B1 = *(const bf16x8*)(Ks_ + KSWZ(32 + r32, cb)); } while (0)
#define QKT(P0, P1, b) do { P0 = f32x16{}; P1 = f32x16{}; const char* Ks_ = K_lds + (b) * SHM_K; bf16x8 ka0, ka1, kb0, kb1, kc0, kc1; \
    KFR(ka0, ka1, 0); KFR(kb0, kb1, 1);   \
    _Pragma("unroll") for (int d0 = 0; d0 < ND; d0 += 3) { \
      if (d0 + 2 < ND) KFR(kc0, kc1, d0 + 2); SBAR(); \
      P0 = __builtin_amdgcn_mfma_f32_32x32x16_bf16(ka0, qr[d0], P0, 0, 0, 0); P1 = __builtin_amdgcn_mfma_f32_32x32x16_bf16(ka1, qr[d0], P1, 0, 0, 0); SBAR(); \
      if (d0 + 3 < ND) KFR(ka0, ka1, d0 + 3); SBAR(); \
      if (d0 + 1 < ND) { P0 = __builtin_amdgcn_mfma_f32_32x32x16_bf16(kb0, qr[d0 + 1], P0, 0, 0, 0); P1 = __builtin_amdgcn_mfma_f32_32x32x16_bf16(kb1, qr[d0 + 1], P1, 0, 0, 0); } SBAR(); \
      if (d0 + 4 < ND) KFR(kb0, kb1, d0 + 4); SBAR(); \
      if (d0 + 2 < ND) { P0 = __builtin_amdgcn_mfma_f32_32x32x16_bf16(kc0, qr[d0 + 2], P0, 0, 0, 0); P1 = __builtin_amdgcn_mfma_f32_32x32x16_bf16(kc1, qr[d0 + 2], P1, 0, 0, 0); } SBAR(); } } while (0)
#define MASK(P0, P1, j) do { if (NA && (j) >= a.n1) { const int rr_ = a.rlo + (j) - a.n1; const float* bp_ = btl + 128 * (rr_ - qr_row + 7); \
      _Pragma("unroll") for (int i = 0; i < 16; ++i) { const int ko_ = (i & 3) + 8 * (i >> 2); \
        P0[i] = ((cmask >> i) & 1u) ? P0[i] + bp_[ko_] : -INFINITY; P1[i] = ((cmask >> (16 + i)) & 1u) ? P1[i] + bp_[ko_ + 32] : -INFINITY; } } } while (0)
#define RESC(al) do { if (__any((al) < 1.f)) { if (hi == 0) al_l[r32] = (al); asm volatile("s_waitcnt lgkmcnt(0)" ::: "memory"); \
    _Pragma("unroll") for (int d = 0; d < 4; ++d) _Pragma("unroll") for (int r = 0; r < 16; ++r) o[d][r] *= al_l[crow(r, hi)]; } } while (0)
    f32x16 p0, p1; float al; bf16x8 pa0, pa1, pa2, pa3; const int NT = a.nt;
#define LIVE(t, out) do { out = true; if (NA && (t) >= a.n1) { const int rr_ = a.rlo + (t) - a.n1; const int r0u = __builtin_amdgcn_readfirstlane(r0w); out = (rr_ >= r0u) && (rr_ < r0u + 8); } } while (0)
    if constexpr (!PP) {
    SLOAD(0); SWRITE(0); __syncthreads();
    for (int j = 0; j < NT; ++j) {
        const int cb_ = j & 1;
        if (j + 1 < NT) SLOAD(j + 1);
        bool live; LIVE(j, live);
        if (live) {
        SBAR(); QKT(p0, p1, cb_); MASK(p0, p1, j);
        partialSM(p0, p1, m_reg, al, C, thr);
        RESC(al);
        finishSM(p0, p1, al, l_reg, pa0, pa1, pa2, pa3); SBAR();
        pv_d0(o, vb0 + cb_ * SHM_V, pa0, pa1, pa2, pa3);
        }
        if (j + 1 < NT) SWRITE(cb_ ^ 1);
        __syncthreads();
    }
    } else {
#define PPBAR() do { asm volatile("s_waitcnt lgkmcnt(0)" ::: "memory"); __builtin_amdgcn_s_barrier(); asm volatile("" ::: "memory"); } while (0)
    SLOAD_K(0); SWRITE_K(0); SLOAD_K(1); SLOAD_V(0);
    PPBAR();
    const int grp = __builtin_amdgcn_readfirstlane(wid >> 2);
    if (grp == 1) { SWRITE_K(1); SWRITE_V(0); if (2 < NT) SLOAD_K(2); if (1 < NT) SLOAD_V(1); PPBAR(); }
    { bool live; LIVE(0, live); if (live) { SBAR(); QKT(p0, p1, 0); } }
    for (int t = 0; t < NT; ++t) {
        PPBAR();
        bool live; LIVE(t, live);
        if (live && EXP != 2) { MASK(p0, p1, t); partialSM(p0, p1, m_reg, al, C, thr); RESC(al); finishSM(p0, p1, al, l_reg, pa0, pa1, pa2, pa3); SBAR(); }
        if (EXP == 2) { u32x4 w0 = {__float_as_uint(p0[0]), __float_as_uint(p0[5]), __float_as_uint(p1[3]), __float_as_uint(p1[9])}; pa0 = __builtin_bit_cast(bf16x8, w0); pa1 = pa0; pa2 = pa0; pa3 = pa0; l_reg = 1.f; }
        { const int kt = t + 1 + grp, vt = t + grp;
          if (EXP != 2 && EXP != 4) { if (kt < NT) SWRITE_K(kt & 1);
          if (vt < NT) SWRITE_V(vt & 1);
          if (kt + 1 < NT) SLOAD_K(kt + 1);
          if (vt + 1 < NT) SLOAD_V(vt + 1); } }
        PPBAR();
        if (EXP != 3) { if (live) { SBAR(); pv_d0(o, vb0 + (t & 1) * SHM_V, pa0, pa1, pa2, pa3); }
        if (t + 1 < NT) { bool ln; LIVE(t + 1, ln); if (ln) { SBAR(); QKT(p0, p1, (t + 1) & 1); } } }
        else { o[0][0] += __builtin_bit_cast(u32x4, pa0)[0] + __builtin_bit_cast(u32x4, pa1)[1] + __builtin_bit_cast(u32x4, pa2)[2] + __builtin_bit_cast(u32x4, pa3)[3]; p0[3] += o[0][0]; p1[7] -= o[0][0]; }
    }
    if (grp == 0) PPBAR();
#undef PPBAR
    }
    if (hi == 0) li_l[r32] = l_reg; asm volatile("s_waitcnt lgkmcnt(0)" ::: "memory");
    float rli[16];
#pragma unroll
    for (int r = 0; r < 16; ++r) rli[r] = __builtin_amdgcn_rcpf(li_l[crow(r, hi)]);
    if constexpr (PP) __syncthreads();
    char* Ost = lds + wid * 8192;
#pragma unroll
    for (int r = 0; r < 16; ++r) { const int orow = crow(r, hi);
#pragma unroll
        for (int d0 = 0; d0 < 4; ++d0) *(bf16_t*)(Ost + orow * 256 + (d0 * 32 + r32) * 2) = f2bf(o[d0][r] * rli[r]); }
    asm volatile("s_waitcnt lgkmcnt(0)" ::: "memory");
    bf16_t* Ow = a.O + (size_t)(wid * QBLK) * a.ldo;
#pragma unroll
    for (int i = 0; i < 8; ++i) { const int ch = i * 64 + lane, row = ch >> 4, cc = ch & 15;
        *(u32x4*)(Ow + (size_t)row * a.ldo + cc * 8) = *(const u32x4*)(Ost + row * 256 + cc * 16); }
#undef KSWZ
#undef TOKOF
#undef SLOAD
#undef SLOAD_K
#undef SLOAD_V
#undef SWRITE_K
#undef SWRITE_V
#undef LIVE
#undef SWRITE
#undef QKT
#undef KFR
#undef MASK
#undef RESC
}
#undef SBAR
}

template <int N, int NCH>
__device__ __forceinline__ void hyena_unit(int c0, int col0, const bf16_t* PT, const bf16_t* filt0, int fstride, bf16_t* YH, const float* cw, const float* cb, const float* hbias, unsigned char* lds) {
    constexpr int LZ = N + 40, FL = 2 * N + 64, CHB = (16 * LZ + 2 * FL + 4 * N) * 2;
    int tid = threadIdx.x; asm volatile("" : "+v"(tid));
    const int lane = tid & 63, wave = __builtin_amdgcn_readfirstlane(tid >> 6);
    __syncthreads();
    for (int i = tid; i < NCH * 16 * 40; i += 512) { const int ch = i / 640, r = (i % 640) / 40, e = i % 40, sg = r >> 2; bf16_t* zr = (bf16_t*)(lds + ch * CHB) + r * LZ;
        zr[e < 32 - sg ? e : N + 32 - sg + (e - (32 - sg))] = 0; }
    for (int i = tid; i < NCH * (2 * FL) / 8; i += 512) { const int ch = i / ((2 * FL) / 8), e = i % ((2 * FL) / 8);
        ((u32x4*)(lds + ch * CHB + 16 * LZ * 2))[e] = ((const u32x4*)(filt0 + (size_t)ch * fstride))[e]; }
    u32x2 wv[4], wa[4], wx[4]; unsigned short hv[4][2], ha[4][2], hx[4][2];
#pragma unroll
    for (int q = 0; q < 4; ++q) { const int i = tid + 512 * q, ch = i / N, ii = i % N, b = ii / (N / 4), s0 = (ii % (N / 4)) * 4, c = c0 + ch; const size_t off = (size_t)col0 + (size_t)b * N + s0;
        const bf16_t* pv_ = PT + (size_t)c * TOK + off; const bf16_t* pa_ = PT + (size_t)(HYW + c) * TOK + off; const bf16_t* px_ = PT + (size_t)(2 * HYW + c) * TOK + off;
        wv[q] = *(const u32x2*)pv_; wa[q] = *(const u32x2*)pa_; wx[q] = *(const u32x2*)px_;
        hv[q][0] = s0 > 0 ? pv_[-1] : 0; hv[q][1] = s0 + 4 < N ? pv_[4] : 0; ha[q][0] = s0 > 0 ? pa_[-1] : 0; ha[q][1] = s0 + 4 < N ? pa_[4] : 0; hx[q][0] = s0 > 0 ? px_[-1] : 0; hx[q][1] = s0 + 4 < N ? px_[4] : 0; }
#pragma unroll
    for (int q = 0; q < 4; ++q) { const int i = tid + 512 * q, ch = i / N, ii = i % N, b = ii / (N / 4), s0 = (ii % (N / 4)) * 4, c = c0 + ch;
        const float wv0 = cw[c], wv1 = cw[1536 + c], wv2 = cw[3072 + c], bv = cb[c];
        const float wa0 = cw[HYW + c], wa1 = cw[1536 + HYW + c], wa2 = cw[3072 + HYW + c], ba = cb[HYW + c];
        const float wx0 = cw[2 * HYW + c], wx1 = cw[1536 + 2 * HYW + c], wx2 = cw[3072 + 2 * HYW + c], bx2 = cb[2 * HYW + c];
        float v[6], x1[6], x2[6];
        v[0] = bf2f(hv[q][0]); v[1] = bf2f(wv[q].x & 0xffff); v[2] = bf2f(wv[q].x >> 16); v[3] = bf2f(wv[q].y & 0xffff); v[4] = bf2f(wv[q].y >> 16); v[5] = bf2f(hv[q][1]);
        x1[0] = bf2f(ha[q][0]); x1[1] = bf2f(wa[q].x & 0xffff); x1[2] = bf2f(wa[q].x >> 16); x1[3] = bf2f(wa[q].y & 0xffff); x1[4] = bf2f(wa[q].y >> 16); x1[5] = bf2f(ha[q][1]);
        x2[0] = bf2f(hx[q][0]); x2[1] = bf2f(wx[q].x & 0xffff); x2[2] = bf2f(wx[q].x >> 16); x2[3] = bf2f(wx[q].y & 0xffff); x2[4] = bf2f(wx[q].y >> 16); x2[5] = bf2f(hx[q][1]);
        float z[4], ux[4];
#pragma unroll
        for (int e = 0; e < 4; ++e) { const float uv = wv0 * v[e] + wv1 * v[e + 1] + wv2 * v[e + 2] + bv, ua = wa0 * x1[e] + wa1 * x1[e + 1] + wa2 * x1[e + 2] + ba; z[e] = ua * uv; ux[e] = wx0 * x2[e] + wx1 * x2[e + 1] + wx2 * x2[e + 2] + bx2; }
        const unsigned p01 = cvt_pk_bf16(z[0], z[1]), p23 = cvt_pk_bf16(z[2], z[3]), p12 = (p01 >> 16) | (p23 << 16);
        bf16_t* ZS = (bf16_t*)(lds + ch * CHB); bf16_t* X2S = ZS + 16 * LZ + 2 * FL;
        { u32x2 w; w.x = p01; w.y = p23; *(u32x2*)(ZS + (0 * 4 + b) * LZ + s0 + 32) = w; }
        { bf16_t* r = ZS + (2 * 4 + b) * LZ + s0 + 30; *(unsigned*)r = p01; *(unsigned*)(r + 2) = p23; }
        { bf16_t* r = ZS + (1 * 4 + b) * LZ + s0 + 31; r[0] = (bf16_t)(p01 & 0xffff); *(unsigned*)(r + 1) = p12; r[3] = (bf16_t)(p23 >> 16); }
        { bf16_t* r = ZS + (3 * 4 + b) * LZ + s0 + 29; r[0] = (bf16_t)(p01 & 0xffff); *(unsigned*)(r + 1) = p12; r[3] = (bf16_t)(p23 >> 16); }
        { u32x2 w; w.x = cvt_pk_bf16(ux[0], ux[1]); w.y = cvt_pk_bf16(ux[2], ux[3]); *(u32x2*)(X2S + b * N + s0) = w; }
    }
    __syncthreads();
    {
        const int ch = (NCH == 1) ? 0 : wave, T0a = (NCH == 1) ? 256 * wave : 0, c = c0 + ch;
        const bf16_t* ZS = (const bf16_t*)(lds + ch * CHB); const bf16_t* RF = ZS + 16 * LZ; const bf16_t* X2S = RF + 2 * FL;
        constexpr int nks = (N + 32) / 32;
        const int rho = lane & 15, gq4 = lane >> 4, colb = (lane & 15) >> 2, sg = lane & 3;
        const bf16_t* zrow = ZS + (sg * 4 + colb) * LZ + 8 * gq4;
        const bf16_t* ra = RF + (N - T0a - 8 * rho + 8 * gq4);
        f32x4 acc[2][2] = {{{0.f, 0.f, 0.f, 0.f}, {0.f, 0.f, 0.f, 0.f}}, {{0.f, 0.f, 0.f, 0.f}, {0.f, 0.f, 0.f, 0.f}}};
#define HY_LD(B, A0, A1, A2, A3, ks) do { B = *(const bf16x8*)(zrow + 32 * (ks)); A0 = *(const bf16x8*)(ra + 32 * (ks)); A1 = *(const bf16x8*)(ra + FL + 32 * (ks)); A2 = *(const bf16x8*)(ra - 128 + 32 * (ks)); A3 = *(const bf16x8*)(ra - 128 + FL + 32 * (ks)); } while (0)
#define HY_MM(B, A0, A1, A2, A3) do { acc[0][0] = __builtin_amdgcn_mfma_f32_16x16x32_bf16(A0, B, acc[0][0], 0, 0, 0); acc[0][1] = __builtin_amdgcn_mfma_f32_16x16x32_bf16(A1, B, acc[0][1], 0, 0, 0); \
            acc[1][0] = __builtin_amdgcn_mfma_f32_16x16x32_bf16(A2, B, acc[1][0], 0, 0, 0); acc[1][1] = __builtin_amdgcn_mfma_f32_16x16x32_bf16(A3, B, acc[1][1], 0, 0, 0); } while (0)
        bf16x8 b0, p0, p1, p2, p3, b1, q0, q1, q2, q3;
        HY_LD(b0, p0, p1, p2, p3, 0);
        static_assert(nks % 2 == 1, "odd step count");
        for (int ks = 0; ks + 2 < nks; ks += 2) {
            HY_LD(b1, q0, q1, q2, q3, ks + 1); __builtin_amdgcn_sched_barrier(0);
            HY_MM(b0, p0, p1, p2, p3); __builtin_amdgcn_sched_barrier(0);
            HY_LD(b0, p0, p1, p2, p3, ks + 2); __builtin_amdgcn_sched_barrier(0);
            HY_MM(b1, q0, q1, q2, q3); __builtin_amdgcn_sched_barrier(0);
        }
        HY_MM(b0, p0, p1, p2, p3);
#undef HY_LD
#undef HY_MM
        const float hb_ = hbias[c];
        bf16_t* OS = (bf16_t*)(lds + NCH * CHB) + ch * 4 * N;
#pragma unroll
        for (int ti = 0; ti < 2; ++ti)
#pragma unroll
            for (int di = 0; di < 2; ++di)
#pragma unroll
                for (int rg = 0; rg < 4; ++rg) { const int t = T0a + 128 * ti + 8 * (4 * gq4 + rg) + 4 * di + sg;
                    const float zt = bf2f(ZS[colb * LZ + t + 32]), x2v = bf2f(X2S[colb * N + t]);
                    OS[colb * N + t] = f2bf(x2v * (acc[ti][di][rg] + zt * hb_)); }
    }
    __syncthreads();
#pragma unroll
    for (int j = 0; j < (NCH * 4 * N) / (8 * 512); ++j) { const int e = (tid + 512 * j) * 8, ch = e / (4 * N), r = e % (4 * N);
        *(u32x4*)(YH + (size_t)(c0 + ch) * TOK + col0 + r) = *(const u32x4*)((const bf16_t*)(lds + NCH * CHB) + e); }
}

#define XB_TMO      128
#define XB_XCNT(j)  (256  + 64 * (j))
#define XB_XSUB(j)  (1280 + 64 * (j))
#define XB_XGEN(j)  (2304 + 64 * (j))
#define XB_TOP      3328
#define XB_TOPGEN   3392
#define XCD_BAR_WORDS 3456
#define XB_SPIN_CAP (1u << 18)
__device__ __forceinline__ unsigned xb_ld(unsigned* p)              { return __hip_atomic_load(p, __ATOMIC_RELAXED, __HIP_MEMORY_SCOPE_AGENT); }
__device__ __forceinline__ unsigned xb_add(unsigned* p, unsigned v) { return __hip_atomic_fetch_add(p, v, __ATOMIC_RELAXED, __HIP_MEMORY_SCOPE_AGENT); }
__device__ __forceinline__ unsigned xb_xcc_id() { return (unsigned)__builtin_amdgcn_s_getreg((3 << 11) | 20) & 0xFu; }
#define XB_SPIN(cond, bar) do { unsigned _sp = 0; while (cond) { __builtin_amdgcn_s_sleep(1); \
    if ((++_sp & 255u) == 0u) { if (xb_ld(&(bar)[XB_TMO])) break; if (_sp > XB_SPIN_CAP) { atomicAdd(&(bar)[XB_TMO], 1u); break; } } } } while (0)
struct XcdBarrier { unsigned* bar; volatile LAS unsigned* st; };
__device__ __forceinline__ XcdBarrier xcd_barrier_post(unsigned* bar, volatile LAS unsigned* st) {
    XcdBarrier b; b.bar = bar; b.st = st;
    if (threadIdx.x == 0) (void)xb_add(&bar[XB_XCNT(xb_xcc_id())], 1u);
    return b;
}
__device__ __forceinline__ void xcd_barrier_complete(unsigned* bar, unsigned x, unsigned& nloc, unsigned& nx) {
    const unsigned G = gridDim.x * gridDim.y * gridDim.z;
    unsigned sum, cnt, mine, sp = 0u;
    for (;;) {
        sum = 0u; cnt = 0u; mine = 0u;
#pragma unroll
        for (unsigned j = 0; j < 16; ++j) { const unsigned c = xb_ld(&bar[XB_XCNT(j)]); sum += c; cnt += (c > 0u) ? 1u : 0u; mine = (j == x) ? c : mine; }
        if (sum == G) break;
        __builtin_amdgcn_s_sleep(1);
        if ((++sp & 255u) == 0u) { if (xb_ld(&bar[XB_TMO])) break; if (sp > XB_SPIN_CAP) { atomicAdd(&bar[XB_TMO], 1u); break; } }
    }
    nloc = mine > 0u ? mine : 1u; nx = cnt > 0u ? cnt : 1u;
}
__device__ __forceinline__ void xcd_barrier(const XcdBarrier& b) {
    asm volatile("s_waitcnt vmcnt(0)" ::: "memory");
    __syncthreads();
    if (threadIdx.x == 0) {
        unsigned* bar = b.bar; asm volatile("" : "+s"(bar));
        __builtin_amdgcn_s_waitcnt(0);
        const unsigned bxid = xb_xcc_id();
        unsigned nloc = b.st[0], nx = b.st[1];
        if (nloc == 0u) { xcd_barrier_complete(bar, bxid, nloc, nx); b.st[0] = nloc; b.st[1] = nx; }
        const unsigned old = xb_add(&bar[XB_XSUB(bxid)], 1u);
        const unsigned gen = old / nloc;
        if (old + 1u == (gen + 1u) * nloc) {
            __builtin_amdgcn_fence(__ATOMIC_RELEASE, "agent");
            asm volatile("s_waitcnt vmcnt(0)" ::: "memory");
            const unsigned og = xb_add(&bar[XB_TOP], 1u);
            const unsigned tg = og / nx;
            if (og + 1u == (tg + 1u) * nx) xb_add(&bar[XB_TOPGEN], 1u);
            else XB_SPIN(xb_ld(&bar[XB_TOPGEN]) == tg, bar);
            __builtin_amdgcn_fence(__ATOMIC_ACQUIRE, "agent");
            xb_add(&bar[XB_XGEN(bxid)], 1u);
            asm volatile("s_waitcnt vmcnt(0)" ::: "memory");
        } else {
            XB_SPIN(xb_ld(&bar[XB_XGEN(bxid)]) == gen, bar);
            __builtin_amdgcn_fence(__ATOMIC_ACQUIRE, "agent");
            asm volatile("s_waitcnt vmcnt(0)" ::: "memory");
        }
    }
    __syncthreads();
}

struct Params { const float* in[29]; float* out; unsigned char* ws; };
enum { I_X = 0, I_C, I_CTX, I_CCTX, I_WADA, I_BADA, I_GAPRE, I_GAPOST, I_GFPRE, I_GFPOST, I_WIN, I_HCW, I_HCB, I_FW1, I_FB1, I_FW2, I_FB2, I_FW3, I_FFREQ, I_HBIAS,
       I_GQ, I_WUQ, I_GKV, I_WUKV, I_RPB, I_WOUT, I_WG, I_WU, I_WD };

#define GAS __attribute__((address_space(1)))
__device__ __forceinline__ const float* INP(int i) { int j = i; asm volatile("" : "+s"(j)); return (const float*)((const GAS float* const __attribute__((address_space(4)))*)__builtin_amdgcn_kernarg_segment_ptr())[j]; }
template <class Map>
__device__ __forceinline__ void transpose_item(const float* W, int K, int N, bf16_t* WT, const float* kscale, LAS float* scr, int item, int lane, const Map& map) {
    const int nblk = N / 32, kb = item / nblk, nb = item % nblk, k0 = 64 * kb, n0 = 32 * nb;
    f32x4 ld[8];
#pragma unroll
    for (int j = 0; j < 8; ++j) ld[j] = __builtin_nontemporal_load((const f32x4*)(W + (size_t)(k0 + 8 * j + (lane >> 3)) * N + n0 + 4 * (lane & 7)));
#pragma unroll
    for (int j = 0; j < 8; ++j) { const int kk = 8 * j + (lane >> 3); f32x4 v = ld[j]; if (kscale) v = v * kscale[k0 + kk];
#pragma unroll
        for (int e = 0; e < 4; ++e) scr[kk * 33 + 4 * (lane & 7) + e] = v[e]; }
    asm volatile("s_waitcnt lgkmcnt(0)" ::: "memory");
    const int c = lane & 7;
#pragma unroll
    for (int j = 0; j < 4; ++j) { const int n = (lane >> 3) + 8 * j; const LAS float* s = scr + (8 * c) * 33 + n;
        u32x4 o; o.x = cvt_pk_bf16(s[0 * 33], s[1 * 33]); o.y = cvt_pk_bf16(s[2 * 33], s[3 * 33]); o.z = cvt_pk_bf16(s[4 * 33], s[5 * 33]); o.w = cvt_pk_bf16(s[6 * 33], s[7 * 33]);
        const int drow = map(n0 + n);
        if (drow >= 0) *(u32x4*)(WT + (size_t)drow * K + k0 + 8 * c) = o; }
    asm volatile("s_waitcnt lgkmcnt(0)" ::: "memory");
}
struct MapIdent { __device__ int operator()(int n) const { return n; } };
struct MapInH   { __device__ int operator()(int n) const { return n < 1536 ? n : -1; } };
struct MapInR   { __device__ int operator()(int n) const { if (n < 1536) return -1; const int r = n - 1536; if (r >= PR_KR && r < PR_KR + 64) { const int i = r - PR_KR; return PR_KR + (i < 32 ? 2 * i : 2 * (i - 32) + 1); } return r; } };
struct MapUQ    { __device__ int operator()(int n) const { const int h = n / 192, j = n % 192; if (j < 128) return n; const int i = j - 128; return h * 192 + 128 + (i < 32 ? 2 * i : 2 * (i - 32) + 1); } };
struct MapGate  { __device__ int operator()(int n) const { return 256 * (n >> 7) + (n & 127); } };
struct MapUp    { __device__ int operator()(int n) const { return 256 * (n >> 7) + 128 + (n & 127); } };

constexpr int WI_IN = 32 * (INC / 32), WI_UQ = (QLORA / 64) * (1536 / 32), WI_UKV = (KVLORA / 64) * (2048 / 32), WI_OUT = 32 * 64, WI_G = 32 * (FF / 32), WI_D = (FF / 64) * 64;
constexpr int WPER_L = WI_IN + WI_UQ + WI_UKV + WI_OUT + 2 * WI_G + WI_D;
constexpr int W_LATE2 = 5760;
constexpr int W_LATE = 8320;
constexpr int W_EARLY = 2560;
__device__ __forceinline__ void weight_item(int l, int r, LAS float* scr, int lane, unsigned char* ws) {
    unsigned char* wl2 = ws + (size_t)l * WL_STRIDE;
    if (r < WI_IN) { const int nb = r % (INC / 32); const float* W = INP(I_WIN) + (size_t)l * DM * INC;
        if (nb < 48) transpose_item(W, DM, INC, (bf16_t*)(wl2 + W_INH), nullptr, scr, r, lane, MapInH()); else transpose_item(W, DM, INC, (bf16_t*)(wl2 + W_INR), nullptr, scr, r, lane, MapInR()); return; } r -= WI_IN;
    if (r < WI_UQ) { transpose_item(INP(I_WUQ) + (size_t)l * QLORA * 1536, QLORA, 1536, (bf16_t*)(wl2 + W_UQ), INP(I_GQ) + l * QLORA, scr, r, lane, MapUQ()); return; } r -= WI_UQ;
    if (r < WI_UKV) { transpose_item(INP(I_WUKV) + (size_t)l * KVLORA * 2048, KVLORA, 2048, (bf16_t*)(wl2 + W_UKV), INP(I_GKV) + l * KVLORA, scr, r, lane, MapIdent()); return; } r -= WI_UKV;
    if (r < WI_OUT) { transpose_item(INP(I_WOUT) + (size_t)l * DM * DM, DM, DM, (bf16_t*)(wl2 + W_OUT), nullptr, scr, r, lane, MapIdent()); return; } r -= WI_OUT;
    if (r < WI_G) { transpose_item(INP(I_WG) + (size_t)l * DM * FF, DM, FF, (bf16_t*)(wl2 + W_GU), nullptr, scr, r, lane, MapGate()); return; } r -= WI_G;
    if (r < WI_G) { transpose_item(INP(I_WU) + (size_t)l * DM * FF, DM, FF, (bf16_t*)(wl2 + W_GU), nullptr, scr, r, lane, MapUp()); return; } r -= WI_G;
    transpose_item(INP(I_WD) + (size_t)l * FF * DM, FF, DM, (bf16_t*)(wl2 + W_DN), nullptr, scr, r, lane, MapIdent());
}

__global__ void __launch_bounds__(512, 2) fwd_mega(Params p) {
    extern __shared__ __attribute__((aligned(16))) unsigned char lds[];
    LAS unsigned char* ldsl = (LAS unsigned char*)lds;
    const int wave = __builtin_amdgcn_readfirstlane(threadIdx.x >> 6);
    const int G = gridDim.x, NGW = G * 8;
#define bx0 ((int)blockIdx.x)
#define DECL_PTRS(L) GAS unsigned char* wsg_ = (GAS unsigned char*)INP(30); asm volatile("" : "+s"(wsg_)); unsigned char* ws = (unsigned char*)wsg_; int tid = threadIdx.x; asm volatile("" : "+v"(tid)); const int lane = tid & 63; (void)lane; \
    int bx = blockIdx.x; asm volatile("" : "+s"(bx)); const int vcu = (G % 8 == 0) ? (bx % 8) * (G / 8) + bx / 8 : bx; const int gw = vcu * 8 + wave; (void)gw;   \
    float* MOD = (float*)(ws + S_MOD); float* ROPE = (float*)(ws + S_ROPE); float* SSQ = (float*)(ws + S_SSQ); float* SSQY = (float*)(ws + S_SSQY); \
    bf16_t* FILT = (bf16_t*)(ws + S_FILT); bf16_t* FILTC = (bf16_t*)(ws + S_FILTC); \
    bf16_t* Hb = (bf16_t*)(ws + A_H); bf16_t* YC = (bf16_t*)(ws + A_YC); bf16_t* YF = (bf16_t*)(ws + A_YF); bf16_t* XR = (bf16_t*)(ws + A_XR); \
    bf16_t* PR = (bf16_t*)(ws + A_PR); bf16_t* PT = (bf16_t*)(ws + A_PT); bf16_t* Qb = (bf16_t*)(ws + A_Q); bf16_t* KVb = (bf16_t*)(ws + A_KV); bf16_t* ACT = (bf16_t*)(ws + A_ACT); \
    unsigned char* wl = ws + (size_t)(L) * WL_STRIDE; const float* mod = MOD + (size_t)(L) * 5 * ADA; \
    (void)ROPE; (void)SSQ; (void)SSQY; (void)FILT; (void)FILTC; (void)Hb; (void)YC; (void)YF; (void)XR; (void)PR; (void)PT; (void)Qb; (void)KVb; (void)ACT; (void)wl; (void)mod;

#if PROBE_MULT
    unsigned long long* stamps = (unsigned long long*)((unsigned char*)INP(30) + S_CTL + 524288); int sidx = 0;
#define STAMP() do { if (bx0 == 0 && threadIdx.x == 0) stamps[sidx] = __builtin_amdgcn_s_memrealtime(); ++sidx; } while (0)
#else
#define STAMP() do {} while (0)
#endif
#if PROBE_MULT
#define DBGP(set) (stamps + 40 + 8 * (set))
#else
#define DBGP(set) nullptr
#endif
    STAMP();
    volatile LAS unsigned* MISC = (volatile LAS unsigned*)(ldsl + 147456);
    if (threadIdx.x == 0) { MISC[0] = 0u; MISC[1] = 0u; }
    __syncthreads();
    XcdBarrier xb = xcd_barrier_post((unsigned*)((unsigned char*)INP(30) + S_CTL), MISC);
    {
        DECL_PTRS(0)
        for (int i = bx * 512 + tid; i < SEQ * 32; i += G * 512) { const int t = i >> 5, f = i & 31; const float pos = (f < 16) ? (float)(t >> 6) : (float)(t & 63);
            const float inv = powf(10000.0f, -(float)(f & 15) / 16.0f); const float ang = pos * inv; ROPE[2 * i] = cosf(ang); ROPE[2 * i + 1] = sinf(ang); }
        for (int l = 0; l < 2; ++l) { u32x4* z = (u32x4*)(ws + l * WL_STRIDE + W_INR + (size_t)2880 * DM * 2); const int n16 = 192 * DM * 2 / 16;
            for (int i = bx * 512 + tid; i < n16; i += G * 512) z[i] = (u32x4){0u, 0u, 0u, 0u}; }
        for (int i = bx * 512 + tid; i < 2 * HYW * 2 * 128; i += G * 512) {
            const int s = i & 127, cd = i >> 7, d = (cd & 1) * 4; bf16_t* f = FILT + (size_t)cd * FLEN;
            if (s < 64) { if (s <= d + 32) f[s] = 0; } else { const int ii = FLEN - 128 + s; if (ii >= d + 2 * SEQ + 32) f[ii] = 0; } }
        for (int i = bx * 512 + tid; i < HYW * 2 * 128; i += G * 512) {
            const int s = i & 127, cd = i >> 7, d = (cd & 1) * 4; bf16_t* f = FILTC + (size_t)cd * FLENC;
            if (s < 64) { if (s <= d + 32) f[s] = 0; } else { const int ii = FLENC - 128 + s; if (ii >= d + 2 * CTXL + 32) f[ii] = 0; } }
        if (vcu < 192) {
            if (PH(14)) {
            LAS float* sS = (LAS float*)ldsl;
            LAS float* red = (LAS float*)(ldsl + 5 * 2048 * 4);
            for (int i = tid; i < 5 * DM; i += 512) { const int m = i / DM, k = i % DM; const float v = (m < 4) ? INP(I_C)[m * DM + k] : INP(I_CCTX)[k]; sS[i] = v / (1.0f + __expf(-v)); }
            __syncthreads();
            {
                const int item = vcu, l = item / 96, n0 = (item % 96) * 128;
                const float* W = INP(I_WADA) + (size_t)l * DM * ADA + n0 + 4 * (lane & 31);
                f32x4 acc[5];
#pragma unroll
                for (int m = 0; m < 5; ++m) acc[m] = (f32x4){0.f, 0.f, 0.f, 0.f};
                const int kbase = wave * 256 + (lane >> 5);
#pragma unroll 16
                for (int kk = 0; kk < 128; ++kk) { const int k = kbase + 2 * kk; const f32x4 w = __builtin_nontemporal_load((const f32x4*)(W + (size_t)k * ADA));
#pragma unroll
                    for (int m = 0; m < 5; ++m) acc[m] += w * sS[m * DM + k]; }
#pragma unroll
                for (int m = 0; m < 5; ++m) {
#pragma unroll
                    for (int e = 0; e < 4; ++e) acc[m][e] += __shfl_xor(acc[m][e], 32);
                    if (lane < 32) *(LAS f32x4*)(red + (wave * 5 + m) * 128 + 4 * lane) = acc[m]; }
                __syncthreads();
                for (int i = tid; i < 640; i += 512) { const int m = i >> 7, c = i & 127; float s = 0.f;
#pragma unroll
                    for (int w = 0; w < 8; ++w) s += red[(w * 5 + m) * 128 + c];
                    MOD[((size_t)l * 5 + m) * ADA + n0 + c] = s + INP(I_BADA)[(size_t)l * ADA + n0 + c]; }
            }
            }
        } else if (PH(15)) {
            LAS float* tb = (LAS float*)(ldsl + wave * 16384);
            float* H2T = (float*)(ws + S_H2T);
            for (int it = (vcu - 192) * 8 + wave; it < 136; it += (G - 192) * 8) {
                const int set = it < 64 ? 0 : (it < 128 ? 1 : 2), r = it - 64 * set, l = (set == 1) ? 1 : 0, n = (set == 2) ? CTXL : SEQ, pos0 = r * 32, li = lane & 31, hh = lane >> 5;
                const float* w1 = INP(I_FW1) + l * 33 * 64; const float* b1 = INP(I_FB1) + l * 64; const float* w2 = INP(I_FW2) + l * 64 * 64; const float* b2 = INP(I_FB2) + l * 64; const float* fr = INP(I_FFREQ) + l * 64;
                constexpr float INV2PI = 0.15915494309189535f;
                const int pos = pos0 + li;
                f32x16 acc[2] = {f32x16{}, f32x16{}};
#pragma unroll
                for (int s = 0; s < 17; ++s) { const int k = 2 * s + hh; float a;
                    if (k == 0) a = (float)pos / (float)(n - 1);
                    else if (k == 33) a = 0.f;
                    else { const int bi = (k - 1) & 15; const float band = 1e-4f + (float)bi * ((15.0f - 1e-4f) / 15.0f); const float rev = (float)pos * band / (float)n;
                        a = (k <= 16) ? __builtin_amdgcn_cosf(rev) : -__builtin_amdgcn_sinf(rev); }
                    const int kc = k < 33 ? k : 32;
#pragma unroll
                    for (int cb = 0; cb < 2; ++cb) { const float b = (k < 33) ? w1[kc * 64 + 32 * cb + li] : 0.f; acc[cb] = __builtin_amdgcn_mfma_f32_32x32x2f32(a, b, acc[cb], 0, 0, 0); } }
#pragma unroll
                for (int cb = 0; cb < 2; ++cb) { const int j = 32 * cb + li; const float frj = fr[j] * INV2PI, bj = b1[j];
#pragma unroll
                    for (int rg = 0; rg < 16; ++rg) { const int prow = (rg & 3) + 8 * (rg >> 2) + 4 * hh; tb[prow * 65 + j] = __builtin_amdgcn_sinf(frj * (acc[cb][rg] + bj)); } }
                asm volatile("s_waitcnt lgkmcnt(0)" ::: "memory");
                acc[0] = f32x16{}; acc[1] = f32x16{};
#pragma unroll 8
                for (int s = 0; s < 32; ++s) { const int k = 2 * s + hh; const float a = tb[li * 65 + k];
#pragma unroll
                    for (int cb = 0; cb < 2; ++cb) acc[cb] = __builtin_amdgcn_mfma_f32_32x32x2f32(a, w2[k * 64 + 32 * cb + li], acc[cb], 0, 0, 0); }
                asm volatile("s_waitcnt lgkmcnt(0)" ::: "memory");
#pragma unroll
                for (int cb = 0; cb < 2; ++cb) { const int j = 32 * cb + li; const float frj = fr[j] * INV2PI, bj = b2[j]; float* o = H2T + (size_t)set * 64 * SEQ + (size_t)j * n + pos0;
#pragma unroll
                    for (int rg = 0; rg < 16; ++rg) { const int prow = (rg & 3) + 8 * (rg >> 2) + 4 * hh; o[prow] = __builtin_amdgcn_sinf(frj * (acc[cb][rg] + bj)); } }
            }
            if (PH(16)) { asm volatile("s_waitcnt lgkmcnt(0)" ::: "memory"); for (int it = (vcu - 192) * 8 + wave; it < W_EARLY; it += (G - 192) * 8) weight_item(0, it, tb, lane, ws); }
        }
    }
    xcd_barrier(xb);
    STAMP();
    {
        DECL_PTRS(0)
        LAS float* scr = (LAS float*)(ldsl + wave * 16384);
        constexpr int I_IN = 32 * (INC / 32), I_UQ = (QLORA / 64) * (1536 / 32), I_UKV = (KVLORA / 64) * (2048 / 32), I_OUT = 32 * 64, I_G = 32 * (FF / 32), I_D = (FF / 64) * 64;
        constexpr int PER_L = I_IN + I_UQ + I_UKV + I_OUT + 2 * I_G + I_D;
        constexpr int N_F3 = 2 * (SEQ / 32) * 8 + (CTXL / 32) * 8, N_TR = (WPER_L - W_EARLY) + 512, N_ALL = N_F3 + N_TR + TOK;
        for (int it0 = gw; it0 < N_ALL; it0 += NGW) {
            int it = it0;
            if (it < N_F3) {
                if (!PH(15)) continue;
                int set, r; if (it < 512) { set = 0; r = it; } else if (it < 1024) { set = 1; r = it - 512; } else { set = 2; r = it - 1024; }
                const int l = (set == 1) ? 1 : 0, n = (set == 2) ? CTXL : SEQ, pos0 = (r >> 3) * 32, c0 = (r & 7) * 128, li = lane & 31, hh = lane >> 5;
                const float* H2T = (const float*)(ws + S_H2T) + (size_t)set * 64 * SEQ + pos0 + li; const float* w3 = INP(I_FW3) + (size_t)l * 64 * 1024 + c0 + li;
                f32x16 acc[4];
#pragma unroll
                for (int cb = 0; cb < 4; ++cb) acc[cb] = f32x16{};
#pragma unroll 8
                for (int s = 0; s < 32; ++s) { const int k = 2 * s + hh; const float a = H2T[(size_t)k * n];
#pragma unroll
                    for (int cb = 0; cb < 4; ++cb) acc[cb] = __builtin_amdgcn_mfma_f32_32x32x2f32(a, w3[k * 1024 + 32 * cb], acc[cb], 0, 0, 0); }
                bf16_t* F = (set == 2) ? FILTC : FILT + (size_t)l * HYW * 2 * FLEN; const int flen = (set == 2) ? FLENC : FLEN;
                const float invn = 1.0f / (float)(n - 1);
#pragma unroll
                for (int cb = 0; cb < 4; ++cb) {
                    const int cabs = c0 + 32 * cb + li, ch = cabs & (HYW - 1);
                    const float delta = fabsf(-15.350567286626973f + (float)ch * ((-3.0701134573253945f + 15.350567286626973f) / 511.0f));
#pragma unroll
                    for (int rg = 0; rg < 16; ++rg) { const int prow = (rg & 3) + 8 * (rg >> 2) + 4 * hh; scr[li * 33 + prow] = acc[cb][rg] * __expf(-(float)(pos0 + prow) * invn * delta); }
                    asm volatile("s_waitcnt lgkmcnt(0)" ::: "memory");
                    const int pos = pos0 + li;
#pragma unroll 4
                    for (int i2 = 0; i2 < 16; ++i2) { const int col = 2 * i2 + hh, c2 = c0 + 32 * cb + col; const bool bwd = c2 >= HYW; const bf16_t kb = f2bf(scr[col * 33 + li]);
                        bf16_t* f0 = F + (size_t)((c2 & (HYW - 1)) * 2) * flen;
                        if (!bwd) { f0[n + 32 - pos] = kb; f0[flen + 4 + n + 32 - pos] = kb; }
                        else if (pos >= 1) { f0[n + 32 + pos] = kb; f0[flen + 4 + n + 32 + pos] = kb; } }
                    asm volatile("s_waitcnt lgkmcnt(0)" ::: "memory");
                }
                continue;
            }
            it -= N_F3;
            if (it < N_TR) {
                if (!PH(16)) continue;
                { if (it < WPER_L - W_EARLY) weight_item(0, it + W_EARLY, scr, lane, ws); else weight_item(1, it - (WPER_L - W_EARLY) + 23936, scr, lane, ws); }
                continue;
            }
            it -= N_TR;
            if (PH(1)) {
                const int row = it; const float* gpre = INP(I_GAPRE);
                const float* src = (row < NLAT) ? INP(I_X) + (size_t)row * DM : INP(I_CTX) + (size_t)(row - NLAT) * DM;
                const int bm = (row < NLAT) ? (row >> 11) : 4; const float* mrow = mod + (size_t)bm * ADA;
                f32x4 v[8]; float ss = 0.f;
#pragma unroll
                for (int j = 0; j < 8; ++j) { v[j] = __builtin_nontemporal_load((const f32x4*)(src + 4 * lane + 256 * j)); ss += pg8::dot4(v[j]); }
                const float rs = 1.0f / sqrtf(wave_sum(ss) * (1.0f / DM) + RMS_EPS);
#pragma unroll
                for (int j = 0; j < 8; ++j) { const int k = 4 * lane + 256 * j; const f32x4 gg = *(const f32x4*)(gpre + k), sh = *(const f32x4*)(mrow + k), sc = *(const f32x4*)(mrow + DM + k);
                    const f32x4 hh = v[j] * rs * gg * (sc + 1.0f) + sh; u32x2 w; w.x = cvt_pk_bf16(hh[0], hh[1]); w.y = cvt_pk_bf16(hh[2], hh[3]); *(u32x2*)(Hb + (size_t)row * DM + k) = w; }
            }
        }
    }
    xcd_barrier(xb); STAMP();

    for (int l = 0; l < 2; ++l) {
        const int MR = (l == 0) ? TOK : NLAT;
        if (PH(2)) {
            DECL_PTRS(l)
            if (l == 0) {
            { pg8::Gemm g{Hb, (const bf16_t*)(wl + W_INR), TOK, PRW, DM, DM, DM}; pg8::StaticOrder S; S.init(TOK, PRW, G, bx); pg8::EpiPR E{PR, SSQ, ROPE}; pg8::gemm_phase(ldsl, g, S, E); }
            { pg8::Gemm g{(const bf16_t*)(wl + W_INH), Hb, 1536, TOK, DM, DM, DM}; pg8::StaticOrder S; S.init(1536, TOK, G, (bx + 176) % G); pg8::EpiBf16 E{PT, TOK}; pg8::gemm_phase(ldsl, g, S, E); }
            if (PH(16) && ((bx >= 40 && bx < 80) || bx >= 176)) { LAS float* scr = (LAS float*)(ldsl + wave * 16384); const int fb = bx < 80 ? bx - 40 : bx - 136;
                for (int it = fb * 8 + wave; it < W_LATE2; it += 120 * 8) weight_item(1, W_LATE + it, scr, lane, ws); }
            } else {
            unsigned* ctl = (unsigned*)(ws + S_CTL);
            if (bx >= 128) { const int row = NLAT + (bx - 128) * 8 + wave; const int l0_ = 0; const float* mod0 = MOD;
                const float* gpost = INP(I_GFPOST) + l0_ * DM; const float* gnext = INP(I_GAPRE) + DM; const float* modn = MOD + (size_t)5 * ADA; const float* mod = mod0; const int l = 0; (void)l;
                const int bm = (row < NLAT) ? (row >> 11) : 4; const float* mrow = mod + (size_t)bm * ADA; const float* mnext = modn + (size_t)bm * ADA;
                f32x4 y[8]; float sy;
                if (row < NLAT) { sy = (lane < 32) ? SSQY[(size_t)row * 32 + lane] : 0.f;
#pragma unroll
                    for (int j = 0; j < 8; ++j) y[j] = ldbf4(YF + (size_t)row * DM + 4 * lane + 256 * j); }
                else { const float* yp = (const float*)(ws + A_YP) + (size_t)(row - NLAT) * DM + 4 * lane; sy = 0.f;
#pragma unroll
                    for (int j = 0; j < 8; ++j) { y[j] = (*(const f32x4*)(yp + 256 * j) + *(const f32x4*)(yp + (size_t)NCTX * DM + 256 * j)) + (*(const f32x4*)(yp + (size_t)2 * NCTX * DM + 256 * j) + *(const f32x4*)(yp + (size_t)3 * NCTX * DM + 256 * j)); sy += pg8::dot4(y[j]); } }
                sy = wave_sum(sy);
                const float rsy = 1.0f / sqrtf(sy * (1.0f / DM) + RMS_EPS);
                f32x4 v[8]; float ss = 0.f;
#pragma unroll
                for (int j = 0; j < 8; ++j) { const int k = 4 * lane + 256 * j; const f32x4 xv = ldbf4(XR + (size_t)row * DM + k), yv = y[j], gg = *(const f32x4*)(gpost + k), gt = *(const f32x4*)(mrow + 5 * DM + k);
                    v[j] = xv + gt * (yv * rsy * gg); ss += pg8::dot4(v[j]); if (l == 0) stbf4(XR + (size_t)row * DM + k, v[j]); else *(f32x4*)((float*)INP(29) + (size_t)row * DM + k) = v[j]; }
                if (l == 0) {
                    const float rs = 1.0f / sqrtf(wave_sum(ss) * (1.0f / DM) + RMS_EPS);
#pragma unroll
                    for (int j = 0; j < 8; ++j) { const int k = 4 * lane + 256 * j; const f32x4 gg = *(const f32x4*)(gnext + k), sh = *(const f32x4*)(mnext + k), sc = *(const f32x4*)(mnext + DM + k);
                        const f32x4 hh = v[j] * rs * gg * (sc + 1.0f) + sh; u32x2 w; w.x = cvt_pk_bf16(hh[0], hh[1]); w.y = cvt_pk_bf16(hh[2], hh[3]); st8_wt(Hb + (size_t)row * DM + k, w); }
                }
                wave_arrive(ctl + CW_ROWS + 64); }
            { pg8::Gemm g{Hb, (const bf16_t*)(wl + W_INR), NLAT, PRW, DM, DM, DM}; pg8::StaticOrder S; S.init(NLAT, PRW, G, bx); pg8::EpiPR E{PR, SSQ, ROPE}; pg8::gemm_phase(ldsl, g, S, E); }
            { pg8::Gemm g{(const bf16_t*)(wl + W_INH), Hb, 1536, NLAT, DM, DM, DM}; pg8::StaticOrder S; S.init(1536, NLAT, G, (bx + 128) % G); pg8::EpiBf16 E{PT, TOK}; pg8::gemm_phase(ldsl, g, S, E); }
            if (bx >= 64 && bx < 100) {
                if (tid < 64) { wave_wait_cnt(ctl + CW_ROWS + 64, 1024u, ctl + CW_TMO); __builtin_amdgcn_fence(__ATOMIC_ACQUIRE, "agent"); asm volatile("s_waitcnt vmcnt(0)" ::: "memory"); }
                __syncthreads();
                pg8::Gemm g{Hb, (const bf16_t*)(wl + W_INR), TOK, PRW, DM, DM, DM}; pg8::CtxUnitOrder S{bx - 64, 9, 3}; pg8::EpiPR E{PR, SSQ, ROPE}; pg8::gemm_phase(ldsl, g, S, E); }
            if (PH(16) && bx >= 128) { LAS float* scr = (LAS float*)(ldsl + wave * 16384); for (int it = (bx - 128) * 8 + wave; it < 4736; it += 128 * 8) weight_item(1, 14080 + it, scr, lane, ws); }
            }
        }
        xcd_barrier(xb); STAMP();
        if (PH(3)) {
            DECL_PTRS(l)
            const int MQ = (l == 0) ? TOK : NLAT;
            { pg8::Gemm g{PR, (const bf16_t*)(wl + W_UQ), MQ, 1536, QLORA, PRW, QLORA}; pg8::StaticOrder S; S.init(MQ, 1536, G, bx); pg8::EpiQ E{Qb, SSQ, ROPE}; pg8::gemm_phase(ldsl, g, S, E); }
            { pg8::Gemm g{PR + QLORA, (const bf16_t*)(wl + W_UKV), TOK, 2048, KVLORA, PRW, KVLORA}; pg8::StaticOrder S; S.init(TOK, 2048, G, (bx + 40) % G); pg8::EpiKV E{KVb, SSQ}; pg8::gemm_phase(ldsl, g, S, E); }
        }
        xcd_barrier(xb); STAMP();
        {
            DECL_PTRS(l)
            char* al = (char*)lds;
#if PROBE_MULT && PROBE_EXP
            if (l == 0) {
                for (int uidx = vcu; uidx < 256; uidx += G) {
                    const int bh = uidx >> 3, qb = uidx & 7, b = bh >> 3, h = bh & 7; const int row0 = b * SEQ + qb * 256;
                    att::Args a; a.Q = Qb + (size_t)row0 * 1536 + h * 192; a.ldq = 1536; a.Kn = KVb + h * 256; a.ldk = 2048; a.Kr = PR + PR_KR; a.ldkr = PRW; a.V = KVb + h * 256 + 128; a.ldv = 2048;
                    a.O = (bf16_t*)(ws + ((size_t)640 << 20)) + (size_t)row0 * DM + 512 + h * 128; a.ldo = DM; a.nt = 36; a.n1 = 32; a.base1 = b * SEQ; a.base2 = NLAT + b * CTXL; a.scale = MLA_SCALE; a.g = 0; a.rlo = 0; a.bias = nullptr;
                    att::unit<192, false, (PROBE_EXP >= 1), PROBE_EXP>(a, al);
                }
                xcd_barrier(xb); STAMP();
            }
#endif
            if (PH(13)) {
                const float* cw = INP(I_HCW) + (size_t)l * 3 * 1536; const float* cb = INP(I_HCB) + (size_t)l * 1536; const float* hbias = INP(I_HBIAS) + (size_t)l * HYW;
                { const int c0h = vcu < 128 ? vcu : 128 + 3 * (vcu - 128), nch = vcu < 128 ? 1 : 3;
                  for (int k4 = 0; k4 < nch; ++k4) { const int c = c0h + k4; hyena_unit<SEQ, 1>(c, 0, PT, FILT + ((size_t)l * HYW + c) * 2 * FLEN, 0, (bf16_t*)(ws + A_YH), cw, cb, hbias, lds); } }
                if (l == 0) for (int u = (vcu + 64) % G; u < HYW / 8; u += G) hyena_unit<CTXL, 8>(8 * u, NLAT, PT, FILTC + (size_t)(8 * u) * 2 * FLENC, 2 * FLENC, (bf16_t*)(ws + A_YH), cw, cb, hbias, lds);
            }
            asm volatile("s_waitcnt vmcnt(0)" ::: "memory"); __syncthreads();
            if (tid == 0) { __builtin_amdgcn_fence(__ATOMIC_RELEASE, "agent"); asm volatile("s_waitcnt vmcnt(0)" ::: "memory"); __hip_atomic_fetch_add((unsigned*)(ws + S_CTL) + CW_HY + 64 * l, 1u, RLX_AGENT); }
            if (PH(10))
            for (int uidx = vcu; uidx < 256; uidx += G) {
                const int bh = uidx >> 3, qb = uidx & 7, b = bh >> 3, h = bh & 7; const int row0 = b * SEQ + qb * 256;
                att::Args a; a.Q = Qb + (size_t)row0 * 1536 + h * 192; a.ldq = 1536; a.Kn = KVb + h * 256; a.ldk = 2048; a.Kr = PR + PR_KR; a.ldkr = PRW; a.V = KVb + h * 256 + 128; a.ldv = 2048;
                a.O = YC + (size_t)row0 * DM + 512 + h * 128; a.ldo = DM; a.nt = 36; a.n1 = 32; a.base1 = b * SEQ; a.base2 = NLAT + b * CTXL; a.scale = MLA_SCALE; a.g = 0; a.rlo = 0; a.bias = nullptr;
                att::unit<192, false>(a, al);
            }
#if PROBE_MULT && PROBE_SUB
            xcd_barrier(xb); STAMP();
#endif
            const float* rpb = INP(I_RPB) + (size_t)l * 4 * 15 * 31;
            if (PH(11))
            for (int uidx = vcu; uidx < 128; uidx += G) {
                const int bh = uidx >> 3, gq = uidx & 7, b = bh >> 2, h = bh & 3; const int row0 = b * SEQ + gq * 256;
                const int rlo = min(max(4 * gq - 4, 0), 24), nr = (gq == 0 || gq == 7) ? 8 : 11;
                att::Args a; a.Q = PR + (size_t)row0 * PRW + PR_NAQ + h * 128; a.ldq = PRW; a.Kn = PR + PR_NAK + h * 128; a.ldk = PRW; a.Kr = nullptr; a.ldkr = 0; a.V = PR + PR_NAV + h * 128; a.ldv = PRW;
                a.O = YC + (size_t)row0 * DM + 1536 + h * 128; a.ldo = DM; a.nt = 4 + nr; a.n1 = 4; a.base1 = NLAT + b * CTXL; a.base2 = b * SEQ + rlo * 64; a.scale = NA_SCALE; a.g = gq; a.rlo = rlo; a.bias = rpb + h * 15 * 31;
                att::unit<128, true>(a, al);
            }
#if PROBE_MULT && PROBE_SUB
            xcd_barrier(xb); STAMP();
#endif
            if (l == 0 && PH(12)) {
                for (int uidx = vcu - 128; uidx >= 0 && uidx < 32; uidx += G) { const int b = uidx >> 3, h = uidx & 7; const int row0 = NLAT + b * CTXL;
                    att::Args a; a.Q = Qb + (size_t)row0 * 1536 + h * 192; a.ldq = 1536; a.Kn = KVb + h * 256; a.ldk = 2048; a.Kr = PR + PR_KR; a.ldkr = PRW; a.V = KVb + h * 256 + 128; a.ldv = 2048;
                    a.O = YC + (size_t)row0 * DM + 512 + h * 128; a.ldo = DM; a.nt = 4; a.n1 = 4; a.base1 = row0; a.base2 = row0; a.scale = MLA_SCALE; a.g = 0; a.rlo = 0; a.bias = nullptr;
                    att::unit<192, false>(a, al); }
                for (int uidx = vcu - 160; uidx >= 0 && uidx < 16; uidx += G) { const int b = uidx >> 2, h = uidx & 3; const int row0 = NLAT + b * CTXL;
                    att::Args a; a.Q = PR + (size_t)row0 * PRW + PR_NAQ + h * 128; a.ldq = PRW; a.Kn = PR + PR_NAK + h * 128; a.ldk = PRW; a.Kr = nullptr; a.ldkr = 0; a.V = PR + PR_NAV + h * 128; a.ldv = PRW;
                    a.O = YC + (size_t)row0 * DM + 1536 + h * 128; a.ldo = DM; a.nt = 4; a.n1 = 4; a.base1 = row0; a.base2 = row0; a.scale = NA_SCALE; a.g = 0; a.rlo = 0; a.bias = nullptr;
                    att::unit<128, false>(a, al); }
            }
#if PROBE_MULT && PROBE_SUB
            xcd_barrier(xb); STAMP();
#endif
            if (tid < 64) { wave_wait_cnt((unsigned*)(ws + S_CTL) + CW_HY + 64 * l, (unsigned)G, (unsigned*)(ws + S_CTL) + CW_TMO); __builtin_amdgcn_fence(__ATOMIC_ACQUIRE, "agent"); asm volatile("s_waitcnt vmcnt(0)" ::: "memory"); }
            __syncthreads();
        }
        STAMP();
        if (PH(13)) {
            DECL_PTRS(l)
            const bf16_t* YH = (const bf16_t*)(ws + A_YH); LAS unsigned short* tt = (LAS unsigned short*)(ldsl + wave * 16384);
            const int ntok = MR / 64;
            for (int it = gw; it < 8 * ntok; it += NGW) { const int cb8 = it / ntok, tb = it % ntok, ch0 = cb8 * 64, t0 = tb * 64;
#pragma unroll
                for (int j = 0; j < 8; ++j) { const int chl = 8 * j + (lane >> 3), tq = (lane & 7) * 8; const u32x4 w = *(const u32x4*)(YH + (size_t)(ch0 + chl) * TOK + t0 + tq);
                    LAS unsigned* d = (LAS unsigned*)(tt + chl * 66 + tq); d[0] = w.x; d[1] = w.y; d[2] = w.z; d[3] = w.w; }
                asm volatile("s_waitcnt lgkmcnt(0)" ::: "memory");
#pragma unroll
                for (int j = 0; j < 8; ++j) { const int tl = 8 * j + (lane >> 3), cq = (lane & 7) * 8; u32x4 o;
                    o.x = (unsigned)tt[(cq + 0) * 66 + tl] | ((unsigned)tt[(cq + 1) * 66 + tl] << 16); o.y = (unsigned)tt[(cq + 2) * 66 + tl] | ((unsigned)tt[(cq + 3) * 66 + tl] << 16);
                    o.z = (unsigned)tt[(cq + 4) * 66 + tl] | ((unsigned)tt[(cq + 5) * 66 + tl] << 16); o.w = (unsigned)tt[(cq + 6) * 66 + tl] | ((unsigned)tt[(cq + 7) * 66 + tl] << 16);
                    *(u32x4*)(YC + (size_t)(t0 + tl) * DM + ch0 + cq) = o; }
                asm volatile("s_waitcnt lgkmcnt(0)" ::: "memory");
            }
        }
        xcd_barrier(xb); STAMP();
        if (PH(5)) { DECL_PTRS(l) { pg8::Gemm g{YC, (const bf16_t*)(wl + W_OUT), NLAT, DM, DM, DM, DM}; pg8::StaticOrder S; S.init(NLAT, DM, G, bx);
              unsigned* ctl = (unsigned*)(ws + S_CTL); f32x4* xbs = (f32x4*)(ws + A_XB); const int set = l * 2 + 0;
              const pg8::RowExchange rx{xbs + (size_t)set * 65536, ctl + CW_XCH + set * 2048, ctl + CW_TMO, DBGP(set)};
              if (l == 0) { pg8::EpiNormRes<true, true> E{INP(I_X), XR, INP(I_GAPOST) + l * DM, mod + 2 * DM, INP(I_GFPRE) + l * DM, mod + 3 * DM, mod + 4 * DM, XR, Hb, nullptr, rx}; pg8::gemm_phase(ldsl, g, S, E); }
              else { pg8::EpiNormRes<false, true> E{nullptr, XR, INP(I_GAPOST) + l * DM, mod + 2 * DM, INP(I_GFPRE) + l * DM, mod + 3 * DM, mod + 4 * DM, XR, Hb, nullptr, rx}; pg8::gemm_phase(ldsl, g, S, E); } }
            if (l == 0) { pg8::Gemm g{YC, (const bf16_t*)(wl + W_OUT), TOK, DM, DM / 4, DM, DM}; pg8::CtxSplitOrder S{bx, DM / 4}; pg8::EpiPart E{(float*)(ws + A_YP), DM / 4}; pg8::gemm_phase(ldsl, g, S, E); } }
        xcd_barrier(xb); STAMP();
        if (PH(7)) { DECL_PTRS(l)
            unsigned* ctl = (unsigned*)(ws + S_CTL);
            if (l == 0) {
                if (bx >= 128) { const int row = NLAT + (bx - 128) * 8 + wave; const float* gpost = INP(I_GAPOST) + l * DM; const float* gfpre = INP(I_GFPRE) + l * DM;
                const float* xs = (row < NLAT) ? INP(I_X) + (size_t)row * DM : INP(I_CTX) + (size_t)(row - NLAT) * DM;
                const int bm = (row < NLAT) ? (row >> 11) : 4; const float* mrow = mod + (size_t)bm * ADA;
                f32x4 y[8]; float sy;
                if (row < NLAT) { sy = (lane < 32) ? SSQY[(size_t)row * 32 + lane] : 0.f;
#pragma unroll
                    for (int j = 0; j < 8; ++j) y[j] = ldbf4(YF + (size_t)row * DM + 4 * lane + 256 * j); }
                else { const float* yp = (const float*)(ws + A_YP) + (size_t)(row - NLAT) * DM + 4 * lane; sy = 0.f;
#pragma unroll
                    for (int j = 0; j < 8; ++j) { y[j] = (*(const f32x4*)(yp + 256 * j) + *(const f32x4*)(yp + (size_t)NCTX * DM + 256 * j)) + (*(const f32x4*)(yp + (size_t)2 * NCTX * DM + 256 * j) + *(const f32x4*)(yp + (size_t)3 * NCTX * DM + 256 * j)); sy += pg8::dot4(y[j]); } }
                sy = wave_sum(sy);
                const float rsy = 1.0f / sqrtf(sy * (1.0f / DM) + RMS_EPS);
                f32x4 v[8]; float ss = 0.f;
#pragma unroll
                for (int j = 0; j < 8; ++j) { const int k = 4 * lane + 256 * j; const f32x4 xv = (l == 0) ? *(const f32x4*)(xs + k) : ldbf4(XR + (size_t)row * DM + k), yv = y[j], gg = *(const f32x4*)(gpost + k), gt = *(const f32x4*)(mrow + 2 * DM + k);
                    v[j] = xv + gt * (yv * rsy * gg); ss += pg8::dot4(v[j]); stbf4(XR + (size_t)row * DM + k, v[j]); }
                const float rs = 1.0f / sqrtf(wave_sum(ss) * (1.0f / DM) + RMS_EPS);
#pragma unroll
                for (int j = 0; j < 8; ++j) { const int k = 4 * lane + 256 * j; const f32x4 gg = *(const f32x4*)(gfpre + k), sh = *(const f32x4*)(mrow + 3 * DM + k), sc = *(const f32x4*)(mrow + 4 * DM + k);
                    const f32x4 hh = v[j] * rs * gg * (sc + 1.0f) + sh; u32x2 w; w.x = cvt_pk_bf16(hh[0], hh[1]); w.y = cvt_pk_bf16(hh[2], hh[3]); st8_wt(Hb + (size_t)row * DM + k, w); }
                    wave_arrive(ctl + CW_ROWS + 64 * l); }
                { pg8::Gemm g{Hb, (const bf16_t*)(wl + W_GU), NLAT, 2 * FF, DM, DM, DM}; pg8::StaticOrder S; S.init(NLAT, 2 * FF, G, bx); pg8::EpiSwiGLU E{ACT}; pg8::gemm_phase(ldsl, g, S, E); }
                if (bx >= 128) {
                    if (tid < 64) wave_wait_cnt(ctl + CW_ROWS + 64 * l, 1024u, ctl + CW_TMO);
                    __syncthreads();
                    pg8::Gemm g{Hb, (const bf16_t*)(wl + W_GU), TOK, 2 * FF, DM, DM, DM}; pg8::CtxUnitOrder S{bx - 128, 44, 0}; pg8::EpiSwiGLU E{ACT}; pg8::gemm_phase<pg8::EpiSwiGLU, pg8::CtxUnitOrder, 16>(ldsl, g, S, E);
                } else if (bx < 48) {
                    if (tid < 64) { wave_wait_cnt(ctl + CW_ROWS + 64 * l, 1024u, ctl + CW_TMO); __builtin_amdgcn_fence(__ATOMIC_ACQUIRE, "agent"); asm volatile("s_waitcnt vmcnt(0)" ::: "memory"); }
                    __syncthreads();
                    pg8::Gemm g{Hb, (const bf16_t*)(wl + W_GU), TOK, 2 * FF, DM, DM, DM}; pg8::CtxUnitOrder S{128 + bx, 44, 0}; pg8::EpiSwiGLU E{ACT}; pg8::gemm_phase(ldsl, g, S, E);
                }
            } else { pg8::Gemm g{Hb, (const bf16_t*)(wl + W_GU), MR, 2 * FF, DM, DM, DM}; pg8::StaticOrder S; S.init(MR, 2 * FF, G, bx); pg8::EpiSwiGLU E{ACT}; pg8::gemm_phase(ldsl, g, S, E); }
            if (l == 0 && PH(16) && bx >= 48) { LAS float* scr = (LAS float*)(ldsl + wave * 16384); for (int it = (bx - 48) * 8 + wave; it < W_LATE; it += (G - 48) * 8) weight_item(1, it, scr, lane, ws); }
            if (l == 1 && PH(16) && bx >= 128) { LAS float* scr = (LAS float*)(ldsl + wave * 16384); for (int it = (bx - 128) * 8 + wave; it < 5120; it += 128 * 8) weight_item(1, 18816 + it, scr, lane, ws); } }
        xcd_barrier(xb); STAMP();
        if (PH(8)) { DECL_PTRS(l) { pg8::Gemm g{ACT, (const bf16_t*)(wl + W_DN), NLAT, DM, FF, FF, FF}; pg8::StaticOrder S; S.init(NLAT, DM, G, bx);
              unsigned* ctl = (unsigned*)(ws + S_CTL); f32x4* xbs = (f32x4*)(ws + A_XB); const int set = l * 2 + 1; const float* modn = MOD + (size_t)5 * ADA;
              const pg8::RowExchange rx{xbs + (size_t)set * 65536, ctl + CW_XCH + set * 2048, ctl + CW_TMO, DBGP(set)};
              if (l == 0) { pg8::EpiNormRes<false, true> E{nullptr, XR, INP(I_GFPOST) + l * DM, mod + 5 * DM, INP(I_GAPRE) + DM, modn, modn + DM, XR, Hb, nullptr, rx}; pg8::gemm_phase(ldsl, g, S, E); }
              else { pg8::EpiNormRes<false, false> E{nullptr, XR, INP(I_GFPOST) + l * DM, mod + 5 * DM, nullptr, modn, modn, XR, Hb, (float*)INP(29), rx}; pg8::gemm_phase(ldsl, g, S, E); } }
            if (l == 0) { pg8::Gemm g{ACT, (const bf16_t*)(wl + W_DN), TOK, DM, FF / 4, FF, FF}; pg8::CtxSplitOrder S{bx, FF / 4}; pg8::EpiPart E{(float*)(ws + A_YP), FF / 4}; pg8::gemm_phase(ldsl, g, S, E); } }
        xcd_barrier(xb); STAMP();
    }
#if PROBE_MULT
    STAMP();
    if (bx0 == 0 && threadIdx.x == 0) { const unsigned long long q1 = (stamps[PROBE_B1] - stamps[PROBE_B0] + PROBE_UNIT / 2) / PROBE_UNIT, q2 = (stamps[PROBE_C1] - stamps[PROBE_C0] + PROBE_UNIT / 2) / PROBE_UNIT; const unsigned long long d = (q1 > 99 ? 99 : q1) * 400000ull + (q2 > 99 ? 99 : q2) * 4000ull, t0 = __builtin_amdgcn_s_memrealtime(); while (__builtin_amdgcn_s_memrealtime() - t0 < d) __builtin_amdgcn_s_sleep(8); }
#endif
}

extern "C" void kernel_launch(void* const* d_in, const int* in_sizes, int n_in, void* d_out, int out_size, void* d_ws, size_t ws_size, hipStream_t stream) {
    static int grid = 0;
    if (grid == 0) {
        if (n_in != 29 || out_size != NLAT * DM || ws_size < WS_NEED) { fprintf(stderr, "kernel_launch: unexpected shapes: n_in %d out %d ws %zu\n", n_in, out_size, ws_size); grid = -1; return; }
        int dev = 0, cus = 0, per_cu = 0;
        (void)hipGetDevice(&dev); (void)hipDeviceGetAttribute(&cus, hipDeviceAttributeMultiprocessorCount, dev);
        (void)hipFuncSetAttribute((const void*)fwd_mega, hipFuncAttributeMaxDynamicSharedMemorySize, LDS_BYTES);
        (void)hipOccupancyMaxActiveBlocksPerMultiprocessor(&per_cu, (const void*)fwd_mega, 512, LDS_BYTES);
        if (per_cu < 1) { fprintf(stderr, "kernel_launch: occupancy query reports %d blocks per CU\n", per_cu); }
        grid = cus;
    }
    if (grid < 0) return;
    if (hipMemsetAsync((unsigned char*)d_ws + S_CTL, 0, (size_t)CW_END * 4, stream) != hipSuccess) { fprintf(stderr, "kernel_launch: hipMemsetAsync of the control words failed\n"); return; }
    Params p{};
    for (int i = 0; i < 29; ++i) p.in[i] = (const float*)d_in[i];
    p.out = (float*)d_out; p.ws = (unsigned char*)d_ws;
    void* args[] = {&p};
    hipError_t e = hipLaunchCooperativeKernel((const void*)fwd_mega, dim3(grid), dim3(512), args, LDS_BYTES, stream);
    if (e != hipSuccess) fprintf(stderr, "cooperative launch failed: %s (grid %d)\n", hipGetErrorString(e), grid);
}
```
